# Optimizing an MI355X kernel written in HIP

```python
import jax, jax.numpy as jnp
from jax import lax
import numpy as np

D_MODEL = 1024
BATCH = 8
SEQ = 8192
DEPTH = 1

PLE_DIM = 256
CONV_DIM = D_MODEL
CONV_K = 3
RET_HEADS = 8
RET_DK = D_MODEL // 16
RET_DV = 2 * RET_DK
QK_W = RET_HEADS * RET_DK
V_W = RET_HEADS * RET_DV
RET_CHUNK = 128
ROPE_BASE = 10000.0
N_GROUPS = 4
EXPERTS_PER_GROUP = 8
N_EXPERTS = N_GROUPS * EXPERTS_PER_GROUP
TOP_K_IN_GROUP = 2
D_EXPERT = D_MODEL // 2
MOE_BLOCK = 128
EPS = 1e-6
W_IN_WIDTHS = (CONV_DIM, CONV_DIM, CONV_DIM, QK_W, QK_W, V_W, V_W, D_MODEL, D_MODEL)
W_IN_TOTAL = sum(W_IN_WIDTHS)

kernel_name = 'hybrid_conv_retention_hmoe'


def rmsnorm(t, g):
    tf = t.astype(jnp.float32)
    tf = tf * lax.rsqrt(jnp.mean(tf * tf, axis=-1, keepdims=True) + EPS)
    return (tf * g.astype(jnp.float32)).astype(t.dtype)


def rope_tables(s_len):
    inv = ROPE_BASE ** (-jnp.arange(0, RET_DK, 2, dtype=jnp.float32) / RET_DK)
    ang = jnp.arange(s_len, dtype=jnp.float32)[:, None] * inv[None, :]
    return jnp.cos(ang), jnp.sin(ang)


def rope(t, cos, sin):
    t1, t2 = jnp.split(t, 2, axis=-1)
    c = cos[None, :, None, :]
    s = sin[None, :, None, :]
    return jnp.concatenate([t1 * c - t2 * s, t1 * s + t2 * c], axis=-1).astype(t.dtype)


def causal_dwconv(u, w):
    k_w = w.shape[0]
    s_len = u.shape[1]
    up = jnp.pad(u, ((0, 0), (k_w - 1, 0), (0, 0)))
    return sum(up[:, j:j + s_len] * w[j] for j in range(k_w))


def retention(q, k, v):
    b_, s_len, h_, dk = q.shape
    dv = v.shape[-1]
    n_chunks = s_len // RET_CHUNK
    log_gamma = jnp.log1p(-jnp.exp2(-5.0 - jnp.arange(h_, dtype=jnp.float32)))
    pos = jnp.arange(RET_CHUNK, dtype=jnp.float32)
    diff = pos[:, None] - pos[None, :]
    decay_mask = jnp.where((diff >= 0)[None],
                           jnp.exp(log_gamma[:, None, None] * jnp.maximum(diff, 0.0)[None]), 0.0)
    q_decay = jnp.exp(log_gamma[:, None] * (pos[None, :] + 1.0))
    k_decay = jnp.exp(log_gamma[:, None] * (RET_CHUNK - 1.0 - pos[None, :]))
    chunk_decay = jnp.exp(log_gamma * RET_CHUNK)

    def to_chunks(t):
        return t.astype(jnp.float32).reshape(b_, n_chunks, RET_CHUNK, h_, t.shape[-1]).transpose(1, 0, 3, 2, 4)

    qc, kc, vc = to_chunks(q), to_chunks(k), to_chunks(v)

    def step(state, inp):
        qb, kb, vb = inp
        scores = jnp.einsum('bhid,bhjd->bhij', qb, kb) * decay_mask
        inner = jnp.einsum('bhij,bhjv->bhiv', scores, vb)
        cross = jnp.einsum('bhid,bhdv->bhiv', qb, state) * q_decay[None, :, :, None]
        state = state * chunk_decay[None, :, None, None] + jnp.einsum(
            'bhjd,bhjv->bhdv', kb * k_decay[None, :, :, None], vb)
        return state, inner + cross

    s0 = jnp.zeros((b_, h_, dk, dv), jnp.float32)
    _, out = lax.scan(step, s0, (qc, kc, vc))
    return out.transpose(1, 0, 3, 2, 4).reshape(b_, s_len, h_, dv).astype(v.dtype)


def hier_moe(h, w_rg, b_rg, w_re, b_re, w_gate, w_up, w_down):
    b_, s_len, d = h.shape
    n_tok = b_ * s_len
    xt = h.reshape(n_tok, d)
    g_logits = (xt @ w_rg).astype(jnp.float32) + b_rg
    g_probs = jax.nn.softmax(g_logits, axis=-1)
    grp = jnp.argmax(g_logits, axis=-1).astype(jnp.int32)
    g_w = jnp.take_along_axis(g_probs, grp[:, None], axis=-1)
    e_logits = ((xt @ w_re).astype(jnp.float32) + b_re).reshape(n_tok, N_GROUPS, EXPERTS_PER_GROUP)
    e_in = jnp.take_along_axis(e_logits, grp[:, None, None], axis=1)[:, 0]
    top_l, top_i = lax.top_k(e_in, TOP_K_IN_GROUP)
    e_w = jax.nn.softmax(top_l, axis=-1) * g_w
    expert_ids = grp[:, None] * EXPERTS_PER_GROUP + top_i.astype(jnp.int32)

    n_asg = n_tok * TOP_K_IN_GROUP
    flat_e = expert_ids.reshape(n_asg)
    flat_tok = jnp.repeat(jnp.arange(n_tok, dtype=jnp.int32), TOP_K_IN_GROUP)
    flat_w = e_w.reshape(n_asg)
    order = jnp.argsort(flat_e)
    se, stok, sw = flat_e[order], flat_tok[order], flat_w[order]
    counts = jnp.bincount(se, length=N_EXPERTS).astype(jnp.int32)
    starts = jnp.cumsum(counts) - counts
    padded = (counts + MOE_BLOCK - 1) // MOE_BLOCK * MOE_BLOCK
    pends = jnp.cumsum(padded)
    pstarts = pends - padded
    dest = pstarts[se] + jnp.arange(n_asg, dtype=jnp.int32) - starts[se]
    n_blocks = (n_asg + N_EXPERTS * (MOE_BLOCK - 1) + MOE_BLOCK - 1) // MOE_BLOCK
    n_rows = n_blocks * MOE_BLOCK
    row_tok = jnp.full((n_rows,), n_tok, jnp.int32).at[dest].set(stok)
    row_w = jnp.zeros((n_rows,), jnp.float32).at[dest].set(sw)
    blk_e = jnp.minimum(jnp.searchsorted(pends, jnp.arange(n_blocks, dtype=jnp.int32) * MOE_BLOCK,
                                         side='right'), N_EXPERTS - 1).astype(jnp.int32)
    x_pad = jnp.concatenate([xt, jnp.zeros((1, d), xt.dtype)], axis=0)

    def expert_block(args):
        tok, e = args
        xb = x_pad[tok]
        hid = jax.nn.silu(xb @ w_gate[e]) * (xb @ w_up[e])
        return hid @ w_down[e]

    yb = lax.map(expert_block, (row_tok.reshape(n_blocks, MOE_BLOCK), blk_e))
    y = (yb.reshape(n_rows, d) * row_w[:, None].astype(yb.dtype)).astype(h.dtype)
    out = jnp.zeros((n_tok + 1, d), h.dtype).at[row_tok].add(y)
    return out[:n_tok].reshape(b_, s_len, d)


def setup_inputs(seed: int = 0) -> dict:
    key = jax.random.key(seed)
    ks = jax.random.split(key, 24)
    f32 = jnp.float32

    def nrm(k, shape, scale):
        return jax.random.normal(k, shape, f32) * scale

    def gain(k, shape):
        return 1.0 + 0.02 * jax.random.normal(k, shape, f32)

    L = DEPTH
    return {
        'x': nrm(ks[0], (BATCH, SEQ, D_MODEL), 1.0),
        'p': nrm(ks[1], (DEPTH, BATCH, SEQ, PLE_DIM), 1.0),
        'g_mix': gain(ks[2], (L, D_MODEL)),
        'w_in': nrm(ks[3], (L, D_MODEL, W_IN_TOTAL), D_MODEL ** -0.5),
        'conv_w': nrm(ks[4], (L, CONV_K, CONV_DIM), CONV_K ** -0.5),
        'g_ret': gain(ks[5], (L, V_W)),
        'w_out_conv': nrm(ks[6], (L, CONV_DIM, D_MODEL), CONV_DIM ** -0.5),
        'w_out_ret': nrm(ks[7], (L, V_W, D_MODEL), V_W ** -0.5),
        'w_o': nrm(ks[8], (L, D_MODEL, D_MODEL), D_MODEL ** -0.5),
        'g_moe': gain(ks[9], (L, D_MODEL)),
        'w_rg': nrm(ks[10], (L, D_MODEL, N_GROUPS), D_MODEL ** -0.5),
        'b_rg': nrm(ks[11], (L, N_GROUPS), 0.01),
        'w_re': nrm(ks[12], (L, D_MODEL, N_EXPERTS), D_MODEL ** -0.5),
        'b_re': nrm(ks[13], (L, N_EXPERTS), 0.01),
        'w_exp_gate': nrm(ks[14], (L, N_EXPERTS, D_MODEL, D_EXPERT), D_MODEL ** -0.5),
        'w_exp_up': nrm(ks[15], (L, N_EXPERTS, D_MODEL, D_EXPERT), D_MODEL ** -0.5),
        'w_exp_down': nrm(ks[16], (L, N_EXPERTS, D_EXPERT, D_MODEL), D_EXPERT ** -0.5),
        'g_ple_in': gain(ks[17], (L, D_MODEL)),
        'w_ple_gate': nrm(ks[18], (L, D_MODEL, D_MODEL), D_MODEL ** -0.5),
        'w_ple_proj': nrm(ks[19], (L, PLE_DIM, D_MODEL), PLE_DIM ** -0.5),
        'g_ple_post': gain(ks[20], (L, D_MODEL)),
        'g_final': gain(ks[21], (D_MODEL,)),
    }


def reference(x, p, g_mix, w_in, conv_w, g_ret, w_out_conv, w_out_ret, w_o, g_moe, w_rg, b_rg, w_re, b_re,
              w_exp_gate, w_exp_up, w_exp_down, g_ple_in, w_ple_gate, w_ple_proj, g_ple_post, g_final):
    b_, s_len, _ = x.shape
    cos, sin = rope_tables(s_len)
    splits = [int(s) for s in np.cumsum(W_IN_WIDTHS)[:-1]]
    for i in range(DEPTH):
        h = rmsnorm(x, g_mix[i])
        u, c_g, b_g, q, k, v, sg, m_c, m_r = jnp.split(h @ w_in[i], splits, axis=-1)
        y_conv = (b_g * causal_dwconv(c_g * u, conv_w[i])) @ w_out_conv[i]
        q = rope(q.reshape(b_, s_len, RET_HEADS, RET_DK), cos, sin)
        k = rope(k.reshape(b_, s_len, RET_HEADS, RET_DK), cos, sin) * (RET_DK ** -0.5)
        o = retention(q, k, v.reshape(b_, s_len, RET_HEADS, RET_DV))
        o = rmsnorm(o, g_ret[i].reshape(RET_HEADS, RET_DV)).reshape(b_, s_len, V_W)
        y_ret = (jax.nn.silu(sg) * o) @ w_out_ret[i]
        mixed = jax.nn.sigmoid(m_c) * y_conv + jax.nn.sigmoid(m_r) * y_ret
        x = x + mixed @ w_o[i]
        x = x + hier_moe(rmsnorm(x, g_moe[i]), w_rg[i], b_rg[i], w_re[i], b_re[i],
                         w_exp_gate[i], w_exp_up[i], w_exp_down[i])
        ple = rmsnorm(p[i] @ w_ple_proj[i], g_ple_post[i])
        x = x + jax.nn.sigmoid(rmsnorm(x, g_ple_in[i]) @ w_ple_gate[i]) * ple
    return rmsnorm(x, g_final)
```

```cpp
#include <hip/hip_runtime.h>
#include <cstdio>
#include <cstdint>

#define LAS __attribute__((address_space(3)))
#define GAS __attribute__((address_space(1)))
typedef unsigned short bf16;
typedef short bf16x8 __attribute__((ext_vector_type(8)));
typedef short s16x4 __attribute__((ext_vector_type(4)));
typedef float f32x4 __attribute__((ext_vector_type(4)));
typedef float f32x2 __attribute__((ext_vector_type(2)));
typedef unsigned u32x4 __attribute__((ext_vector_type(4)));
typedef unsigned u32x2 __attribute__((ext_vector_type(2)));
typedef GAS unsigned gu32;
#define RLX_AGENT __ATOMIC_RELAXED, __HIP_MEMORY_SCOPE_AGENT

constexpr int D = 1024, NB = 8, SEQ = 8192, T = NB * SEQ, PLE = 256;
constexpr int NH = 8, DK = 64, DV = 128, CH = 128, NCH = SEQ / CH;
constexpr int NE = 32, DE = 512;
constexpr int NIN = 8192;
constexpr float EPS = 1e-6f;
constexpr int NWAVES = 8, NTHR = 512;

constexpr size_t MiB = 1u << 20;
constexpr size_t WS_CTL = 0, CTL_ZERO_BYTES = 1 * MiB;
constexpr size_t WS_ROUTE = 1 * MiB;
constexpr size_t WS_ROPE = 2 * MiB;
constexpr size_t WS_SSQ1 = 4 * MiB;
constexpr size_t WS_SSQP = 8 * MiB;
constexpr size_t WS_SSQ3 = 12 * MiB;
constexpr size_t WS_LIST = 16 * MiB;
constexpr size_t WS_W = 32 * MiB;
constexpr size_t W_IN = WS_W;
constexpr size_t W_OC = W_IN + 16 * MiB;
constexpr size_t W_OR = W_OC + 2 * MiB;
constexpr size_t W_O = W_OR + 2 * MiB;
constexpr size_t W_PG = W_O + 2 * MiB;
constexpr size_t W_PP = W_PG + 2 * MiB;
constexpr size_t W_R = W_PP + 1 * MiB;
constexpr size_t W_GU = W_R + 1 * MiB;
constexpr size_t W_DN = W_GU + 64 * MiB;
constexpr size_t WS_RSTD2 = W_DN + 32 * MiB;
constexpr size_t WS_A = 155 * MiB;
constexpr size_t WS_PB = 283 * MiB;
constexpr size_t WS_Q = 315 * MiB;
constexpr size_t WS_K = 379 * MiB;
constexpr size_t WS_V = 443 * MiB;
constexpr size_t WS_SG = 571 * MiB;
constexpr size_t WS_MC = 699 * MiB;
constexpr size_t WS_MR = 827 * MiB;
constexpr size_t WS_S = 955 * MiB;
constexpr size_t WS_END = 1019 * MiB;
static_assert(WS_RSTD2 + (size_t)T * 4 <= WS_A, "ws map");

constexpr int CW_CNT = 64;
constexpr int CW_BAR = 4096;

constexpr int RING_BYTES = 131072;
constexpr int MISC_OFF = RING_BYTES;
constexpr int TB_OFF = RING_BYTES + 256;
constexpr int CN_OFF = RING_BYTES + 512;
constexpr int HS_OFF = RING_BYTES + 768;
constexpr int LDS_BYTES = 147456;

__device__ __forceinline__ unsigned cvt_pk_bf16(float lo, float hi) { unsigned r; asm volatile("v_cvt_pk_bf16_f32 %0, %1, %2" : "=v"(r) : "v"(lo), "v"(hi)); return r; }
__device__ __forceinline__ float bf_lo(unsigned u) { return __uint_as_float(u << 16); }
__device__ __forceinline__ float bf_hi(unsigned u) { return __uint_as_float(u & 0xffff0000u); }
__device__ __forceinline__ float bf2f(bf16 b) { return __uint_as_float(((unsigned)b) << 16); }
__device__ __forceinline__ bf16 f2bf(float f) { unsigned u = __float_as_uint(f); return (bf16)((u + 0x7fffu + ((u >> 16) & 1u)) >> 16); }
__device__ __forceinline__ u32x4 pack8(const f32x4 a, const f32x4 b) { u32x4 w; w.x = cvt_pk_bf16(a[0], a[1]); w.y = cvt_pk_bf16(a[2], a[3]); w.z = cvt_pk_bf16(b[0], b[1]); w.w = cvt_pk_bf16(b[2], b[3]); return w; }
__device__ __forceinline__ void unpack8(const u32x4 w, f32x4& a, f32x4& b) { a = (f32x4){bf_lo(w.x), bf_hi(w.x), bf_lo(w.y), bf_hi(w.y)}; b = (f32x4){bf_lo(w.z), bf_hi(w.z), bf_lo(w.w), bf_hi(w.w)}; }
__device__ __forceinline__ float sigmoidf_(float x) { return 1.0f / (1.0f + __expf(-x)); }
__device__ __forceinline__ float siluf_(float x) { return x / (1.0f + __expf(-x)); }
__device__ __forceinline__ float wave_sum(float v) {
#pragma unroll
    for (int o = 1; o < 64; o <<= 1) v += __shfl_xor(v, o);
    return v;
}
__device__ __forceinline__ s16x4 tr_read(LAS const char* p) { return __builtin_bit_cast(s16x4, __builtin_amdgcn_ds_read_tr16_b64_v4i16((LAS s16x4*)p)); }

__constant__ float c_inv_freq[32] = {1.000000000e+00f, 7.498942018e-01f, 5.623413324e-01f, 4.216965139e-01f, 3.162277639e-01f, 2.371373773e-01f, 1.778279394e-01f, 1.333521456e-01f, 1.000000015e-01f, 7.498942316e-02f, 5.623413250e-02f, 4.216964915e-02f, 3.162277490e-02f, 2.371373773e-02f, 1.778279431e-02f, 1.333521400e-02f, 9.999999776e-03f, 7.498942316e-03f, 5.623413250e-03f, 4.216964822e-03f, 3.162277630e-03f, 2.371373819e-03f, 1.778279431e-03f, 1.333521446e-03f, 1.000000047e-03f, 7.498941850e-04f, 5.623413017e-04f, 4.216965172e-04f, 3.162277571e-04f, 2.371373703e-04f, 1.778279402e-04f, 1.333521504e-04f};
__device__ __forceinline__ float lg2_gamma(int h) {
    const float t[8] = {-4.580368961312e-02f, -2.272007650008e-02f, -1.131531322783e-02f, -5.646563141142e-03f, -2.820519062379e-03f, -1.409570254671e-03f, -7.046129765894e-04f, -3.522634716290e-04f};
    float r = t[0];
#pragma unroll
    for (int i = 1; i < 8; ++i) r = (h == i) ? t[i] : r;
    return r;
}

namespace pg8 {
constexpr int BM = 256, BK = 64, HALF = 128, HTB = HALF * BK * 2, STAGE_BYTES = 8 * HTB, NXCD = 8, WGM = 8;
__host__ __device__ __forceinline__ int lds_byte(int r, int c) { const int st = (r >> 4) * 2 + (c >> 5), rr = r & 15, cc = c & 31, ob = rr * 64 + cc * 2; return st * 1024 + (ob ^ (((ob >> 9) & 1) << 5)); }
__host__ __device__ __forceinline__ void stage_rc(int b, int& R, int& C) { const int st = b / 1024, sb = b % 1024, swz = sb ^ (((sb >> 9) & 1) << 5); R = (st >> 1) * 16 + swz / 64; C = (st & 1) * 32 + (swz % 64) / 2; }
__host__ __device__ __forceinline__ int perm32(int rho) { const int n = rho >> 4, i = rho & 15; return 8 * (i >> 2) + 4 * n + (i & 3); }

struct Unit { int pm, pn, aux; };

struct StaticOrder {
    static constexpr bool GATHER = false;
    int nM, nN, nwg, G, c; const char* A; const char* B; size_t tstep;
    __device__ void init(const void* A_, const void* B_, int M, int N, int K, int G_, int c_) { nM = M / BM; nN = N / BM; nwg = nM * nN; G = G_; c = c_; A = (const char*)A_; B = (const char*)B_; tstep = (size_t)BM * K * 2; }
    __device__ bool next(int i, Unit& u) const {
        const long L = (long)i * G + c; if (L >= nwg) return false;
        int wgid = (int)L; { const int q = nwg / NXCD, r = nwg % NXCD, xcd = wgid % NXCD, off = wgid / NXCD; wgid = (xcd < r ? xcd * (q + 1) : r * (q + 1) + (xcd - r) * q) + off; }
        const int nig = WGM * nN, gid = wgid / nig, fm = gid * WGM, gsz = (nM - fm) < WGM ? (nM - fm) : WGM;
        u.pm = fm + ((wgid % nig) % gsz); u.pn = (wgid % nig) / gsz; u.aux = 0; return true;
    }
    __device__ __forceinline__ void ptrs(const Unit& u, const char*& a, const char*& b) const { a = A + (size_t)u.pm * tstep; b = B + (size_t)u.pn * tstep; }
    __device__ __forceinline__ void goff(const Unit&, int, int, int, int, unsigned (&)[2][2]) const {}
};

#define PG8_SA(b, h) (((b) * 2 + (h)) * HTB)
#define PG8_SB(b, h) ((4 + (b) * 2 + (h)) * HTB)
#define PG8_GLDS(src, dstoff) __builtin_amdgcn_global_load_lds((const unsigned*)(src), (LAS unsigned*)(lds + (dstoff)), 16, 0, 0)
#define PG8_STAGE_B(bufoff, gbase, h) do { _Pragma("unroll") for (int _i = 0; _i < 2; ++_i) PG8_GLDS((gbase) + (size_t)(h) * hstep + voffB[_i], (bufoff) + ldsw + _i * 8192); } while (0)
#define PG8_STAGE_A(bufoff, gbase, h) do { if constexpr (Sched::GATHER) { _Pragma("unroll") for (int _i = 0; _i < 2; ++_i) PG8_GLDS((gbase) + vg[h][_i], (bufoff) + ldsw + _i * 8192); } \
        else { _Pragma("unroll") for (int _i = 0; _i < 2; ++_i) PG8_GLDS((gbase) + (size_t)(h) * hstep + voffA[_i], (bufoff) + ldsw + _i * 8192); } } while (0)
#define PG8_LDA(dst, b, h) do { _Pragma("unroll") for (int m = 0; m < 4; ++m) _Pragma("unroll") for (int k = 0; k < 2; ++k) dst[m][k] = *(const LAS bf16x8*)(lds + PG8_SA(b, h) + aoff + m * 2048 + k * 1024); } while (0)
#define PG8_LDB(dst, b, h) do { _Pragma("unroll") for (int n = 0; n < 2; ++n) _Pragma("unroll") for (int k = 0; k < 2; ++k) dst[n][k] = *(const LAS bf16x8*)(lds + PG8_SB(b, h) + boff + n * 2048 + k * 1024); } while (0)
#define PG8_MMA(ai, bj, At, Bt) do { __builtin_amdgcn_s_setprio(1); _Pragma("unroll") for (int m = 0; m < 4; ++m) _Pragma("unroll") for (int n = 0; n < 2; ++n) _Pragma("unroll") for (int k = 0; k < 2; ++k) \
        acc[ai][bj][m][n] = __builtin_amdgcn_mfma_f32_16x16x32_bf16(Bt[n][k], At[m][k], acc[ai][bj][m][n], 0, 0, 0); __builtin_amdgcn_s_setprio(0); } while (0)
#define PG8_WAIT_V(n) asm volatile("s_waitcnt vmcnt(" #n ")" ::: "memory")
#define PG8_WAIT_L(n) asm volatile("s_waitcnt lgkmcnt(" #n ")" ::: "memory")
#define PG8_BAR __builtin_amdgcn_s_barrier()
#define PG8_SCHED __builtin_amdgcn_sched_barrier(0)

template <class Epi, class Sched>
__device__ __forceinline__ void gemm_phase(LAS unsigned char* lds, const int K, const Sched& S, const Epi& E) {
    const int tid = threadIdx.x, wid = __builtin_amdgcn_readfirstlane(tid >> 6), lane = tid & 63, wr = wid >> 2, wc = wid & 3, fr = lane & 15, fq = lane >> 4;
    const int nt = K / BK;
    unsigned voffA[2], voffB[2]; int Rr[2], Cc[2];
#pragma unroll
    for (int i = 0; i < 2; ++i) { int R, C; stage_rc(tid * 16 + i * 8192, R, C); const int Rb = (R & ~31) + perm32(R & 31); Rr[i] = R; Cc[i] = C;
        voffA[i] = (unsigned)(R * K + C) * 2u; voffB[i] = (unsigned)(Rb * K + C) * 2u; }
    const size_t kstep = (size_t)(BK * 2);
    const size_t hstep = (size_t)HALF * K * 2;
    const unsigned ldsw = (unsigned)wid * 1024u;
    const int aoff = lds_byte(wr * 64 + fr, fq * 8), boff = lds_byte(wc * 32 + fr, fq * 8);
    Unit cur, nxt; int ui = 0;
    if (!S.next(0, cur)) return;
    f32x4 acc[2][2][4][2];
#pragma unroll
    for (int a = 0; a < 2; ++a)
#pragma unroll
        for (int b = 0; b < 2; ++b)
#pragma unroll
            for (int m = 0; m < 4; ++m)
#pragma unroll
                for (int n = 0; n < 2; ++n) acc[a][b][m][n] = (f32x4){0.f, 0.f, 0.f, 0.f};
    bf16x8 At[4][2], B0[2][2], B1[2][2];
    const char *cA, *cB; S.ptrs(cur, cA, cB);
    unsigned vg[2][2] = {{0u, 0u}, {0u, 0u}}, vn[2][2] = {{0u, 0u}, {0u, 0u}};
    if constexpr (Sched::GATHER) S.goff(cur, Rr[0], Rr[1], Cc[0], Cc[1], vg);
    PG8_STAGE_B(PG8_SB(0, 0), cB, 0); PG8_STAGE_B(PG8_SB(0, 1), cB, 1); PG8_STAGE_A(PG8_SA(0, 0), cA, 0); PG8_STAGE_A(PG8_SA(0, 1), cA, 1);
    if (wr == 1) PG8_BAR;
    PG8_WAIT_V(2); PG8_BAR;
    PG8_STAGE_B(PG8_SB(1, 0), cB + kstep, 0); PG8_STAGE_A(PG8_SA(1, 0), cA + kstep, 0); PG8_STAGE_B(PG8_SB(1, 1), cB + kstep, 1);
    PG8_WAIT_V(6); PG8_BAR;
    for (;;) {
        const bool has_next = S.next(ui + 1, nxt);
        const char *nA = cA, *nB = cB; if (has_next) S.ptrs(nxt, nA, nB);
        if constexpr (Sched::GATHER) {
#pragma unroll
            for (int h = 0; h < 2; ++h)
#pragma unroll
                for (int i = 0; i < 2; ++i) vn[h][i] = vg[h][i];
            if (has_next) S.goff(nxt, Rr[0], Rr[1], Cc[0], Cc[1], vn);
        }
        for (int t = 0; t < nt; t += 2) {
            const bool last = (t == nt - 2);
            const char* a1 = cA + (size_t)(t + 1) * kstep;
            const char* a2 = last ? nA : cA + (size_t)(t + 2) * kstep; const char* b2 = last ? nB : cB + (size_t)(t + 2) * kstep;
            const char* a3 = a2 + kstep; const char* b3 = b2 + kstep;
            PG8_LDB(B0, 0, 0); PG8_LDB(B1, 0, 1); PG8_SCHED; PG8_LDA(At, 0, 0); PG8_STAGE_A(PG8_SA(1, 1), a1, 1);
            if constexpr (Sched::GATHER) { if (last) {
#pragma unroll
                for (int h = 0; h < 2; ++h)
#pragma unroll
                    for (int i = 0; i < 2; ++i) vg[h][i] = vn[h][i]; } }
            PG8_WAIT_V(8); PG8_WAIT_L(0); PG8_BAR; PG8_MMA(0, 0, At, B0); PG8_MMA(0, 1, At, B1); PG8_BAR; PG8_SCHED;
            PG8_LDA(At, 0, 1); PG8_STAGE_B(PG8_SB(0, 0), b2, 0); PG8_STAGE_B(PG8_SB(0, 1), b2, 1); PG8_STAGE_A(PG8_SA(0, 0), a2, 0);
            PG8_WAIT_V(8); PG8_WAIT_L(0); PG8_BAR; PG8_MMA(1, 0, At, B0); PG8_MMA(1, 1, At, B1); PG8_BAR; PG8_SCHED;
            PG8_LDB(B0, 1, 0); PG8_LDB(B1, 1, 1); PG8_SCHED; PG8_LDA(At, 1, 0); PG8_STAGE_A(PG8_SA(0, 1), a2, 1);
            PG8_WAIT_V(8); PG8_WAIT_L(0); PG8_BAR; PG8_MMA(0, 0, At, B0); PG8_MMA(0, 1, At, B1); PG8_BAR; PG8_SCHED;
            PG8_LDA(At, 1, 1); PG8_STAGE_B(PG8_SB(1, 0), b3, 0); PG8_STAGE_B(PG8_SB(1, 1), b3, 1); PG8_STAGE_A(PG8_SA(1, 0), a3, 0);
            PG8_WAIT_V(8); PG8_WAIT_L(0); PG8_BAR; PG8_MMA(1, 0, At, B0); PG8_MMA(1, 1, At, B1); PG8_BAR; PG8_SCHED;
        }
        if (wr == 0) PG8_BAR;
        E(acc, cur, wr, wc, fr, fq);
        if (!has_next) break;
#pragma unroll
        for (int a = 0; a < 2; ++a)
#pragma unroll
            for (int b = 0; b < 2; ++b)
#pragma unroll
                for (int m = 0; m < 4; ++m)
#pragma unroll
                    for (int n = 0; n < 2; ++n) acc[a][b][m][n] = (f32x4){0.f, 0.f, 0.f, 0.f};
        cur = nxt; cA = nA; cB = nB; ++ui;
        if (wr == 1) PG8_BAR;
    }
    PG8_WAIT_V(0);
    PG8_BAR;
}
}
using pg8::Unit;
typedef f32x4 Acc[2][2][4][2];

#define XB_TMO      128
#define XB_XCNT(j)  (256  + 64 * (j))
#define XB_XSUB(j)  (1280 + 64 * (j))
#define XB_XGEN(j)  (2304 + 64 * (j))
#define XB_TOP      3328
#define XB_TOPGEN   3392
#define XCD_BAR_WORDS 3456
#define XB_SPIN_CAP (1u << 18)
__device__ __forceinline__ unsigned xb_ld(unsigned* p)              { return __hip_atomic_load(p, __ATOMIC_RELAXED, __HIP_MEMORY_SCOPE_AGENT); }
__device__ __forceinline__ unsigned xb_add(unsigned* p, unsigned v) { return __hip_atomic_fetch_add(p, v, __ATOMIC_RELAXED, __HIP_MEMORY_SCOPE_AGENT); }
__device__ __forceinline__ unsigned xb_xcc_id() { return (unsigned)__builtin_amdgcn_s_getreg((3 << 11) | 20) & 0xFu; }
#define XB_SPIN(cond, bar) do { unsigned _sp = 0; while (cond) { __builtin_amdgcn_s_sleep(1); \
    if ((++_sp & 255u) == 0u) { if (xb_ld(&(bar)[XB_TMO])) break; if (_sp > XB_SPIN_CAP) { atomicAdd(&(bar)[XB_TMO], 1u); break; } } } } while (0)
struct XcdBarrier { unsigned* bar; unsigned x; volatile LAS unsigned* st; };
__device__ __forceinline__ XcdBarrier xcd_barrier_post(unsigned* bar, volatile LAS unsigned* st) {
    XcdBarrier b; b.bar = bar; b.x = xb_xcc_id(); b.st = st;
    if (threadIdx.x == 0) (void)xb_add(&bar[XB_XCNT(b.x)], 1u);
    return b;
}
__device__ __forceinline__ void xcd_barrier_complete(unsigned* bar, unsigned x, unsigned& nloc, unsigned& nx) {
    const unsigned G = gridDim.x * gridDim.y * gridDim.z;
    unsigned sum, cnt, mine, sp = 0u;
    for (;;) {
        sum = 0u; cnt = 0u; mine = 0u;
#pragma unroll
        for (unsigned j = 0; j < 16; ++j) { const unsigned c = xb_ld(&bar[XB_XCNT(j)]); sum += c; cnt += (c > 0u) ? 1u : 0u; mine = (j == x) ? c : mine; }
        if (sum == G) break;
        __builtin_amdgcn_s_sleep(1);
        if ((++sp & 255u) == 0u) { if (xb_ld(&bar[XB_TMO])) break; if (sp > XB_SPIN_CAP) { atomicAdd(&bar[XB_TMO], 1u); break; } }
    }
    nloc = mine > 0u ? mine : 1u; nx = cnt > 0u ? cnt : 1u;
}
__device__ __forceinline__ void xcd_barrier(const XcdBarrier& b) {
    asm volatile("s_waitcnt vmcnt(0)" ::: "memory");
    __syncthreads();
    if (threadIdx.x == 0) {
        unsigned* bar = b.bar;
        __builtin_amdgcn_s_waitcnt(0);
        unsigned nloc = b.st[0], nx = b.st[1];
        if (nloc == 0u) { xcd_barrier_complete(bar, b.x, nloc, nx); b.st[0] = nloc; b.st[1] = nx; }
        const unsigned old = xb_add(&bar[XB_XSUB(b.x)], 1u);
        const unsigned gen = old / nloc;
        if (old + 1u == (gen + 1u) * nloc) {
            __builtin_amdgcn_fence(__ATOMIC_RELEASE, "agent");
            asm volatile("s_waitcnt vmcnt(0)" ::: "memory");
            const unsigned og = xb_add(&bar[XB_TOP], 1u);
            const unsigned tg = og / nx;
            if (og + 1u == (tg + 1u) * nx) xb_add(&bar[XB_TOPGEN], 1u);
            else XB_SPIN(xb_ld(&bar[XB_TOPGEN]) == tg, bar);
            __builtin_amdgcn_fence(__ATOMIC_ACQUIRE, "agent");
            xb_add(&bar[XB_XGEN(b.x)], 1u);
            asm volatile("s_waitcnt vmcnt(0)" ::: "memory");
        } else {
            XB_SPIN(xb_ld(&bar[XB_XGEN(b.x)]) == gen, bar);
            __builtin_amdgcn_fence(__ATOMIC_ACQUIRE, "agent");
            asm volatile("s_waitcnt vmcnt(0)" ::: "memory");
        }
    }
    __syncthreads();
}

struct Args { const float* in[22]; float* out; unsigned char* ws; int ph_lo, ph_hi; };
struct Frame {
    LAS unsigned char* lds;
    int tid, lane, wave, vcu, G;
    const float* in[22]; unsigned char* ws; unsigned char* out;
};
enum { I_X = 0, I_P, I_GMIX, I_WIN, I_CONVW, I_GRET, I_WOC, I_WOR, I_WO, I_GMOE, I_WRG, I_BRG, I_WRE, I_BRE, I_WG, I_WU, I_WD, I_GPIN, I_WPG, I_WPP, I_GPOST, I_GFIN };

__device__ __forceinline__ void p0_transpose_item(const float* W, int ldw, const float* g, bf16* WT, int ldt, int k0, int n0, int drow, LAS float* scr, int lane) {
#pragma unroll 8
    for (int i = 0; i < 32; ++i) { const int kk = 2 * i + (lane >> 5); float v = W[(size_t)(k0 + kk) * ldw + n0 + (lane & 31)]; if (g) v *= g[k0 + kk]; scr[kk * 33 + (lane & 31)] = v; }
    asm volatile("s_waitcnt lgkmcnt(0)" ::: "memory");
    const int c = lane & 7;
#pragma unroll
    for (int j = 0; j < 4; ++j) { const int n = (lane >> 3) + 8 * j; const LAS float* s = scr + (8 * c) * 33 + n;
        u32x4 o; o.x = cvt_pk_bf16(s[0 * 33], s[1 * 33]); o.y = cvt_pk_bf16(s[2 * 33], s[3 * 33]); o.z = cvt_pk_bf16(s[4 * 33], s[5 * 33]); o.w = cvt_pk_bf16(s[6 * 33], s[7 * 33]);
        *(GAS u32x4*)(WT + (size_t)(drow + n) * ldt + k0 + 8 * c) = o; }
    asm volatile("s_waitcnt lgkmcnt(0)" ::: "memory");
}
__device__ __forceinline__ int win_drow(int n0) {
    if (n0 < 1024) return 256 * (n0 >> 7) + (n0 & 127);
    if (n0 < 2048) { const int c = n0 - 1024; return 256 * (c >> 7) + 128 + (c & 127); }
    if (n0 < 3072) return n0;
    if (n0 < 4096) { const int j = (n0 - 3072) & 511, isk = (n0 - 3072) >> 9, head = j >> 6, d = j & 63;
        return 3072 + isk * 512 + 256 * (head >> 2) + ((d < 32) ? 32 * (head & 3) + d : 128 + 32 * (head & 3) + (d - 32)); }
    return n0;
}
__device__ __forceinline__ void sincos_acc(float angf, float& s, float& c) {
    const double a = (double)angf;
    const double kq = __builtin_rint(a * 0.63661977236758134308);
    double r = __builtin_fma(-kq, 1.5707963267948966, a); r = __builtin_fma(-kq, 6.123233995736766e-17, r);
    const double r2 = r * r;
    const double sp = r * (1.0 + r2 * (-1.0 / 6 + r2 * (1.0 / 120 + r2 * (-1.0 / 5040 + r2 * (1.0 / 362880 + r2 * (-1.0 / 39916800 + r2 * (1.0 / 6227020800.0)))))));
    const double cp = 1.0 + r2 * (-0.5 + r2 * (1.0 / 24 + r2 * (-1.0 / 720 + r2 * (1.0 / 40320 + r2 * (-1.0 / 3628800 + r2 * (1.0 / 479001600.0 + r2 * (-1.0 / 87178291200.0)))))));
    const int q = ((int)(long long)kq) & 3;
    const double ss = (q == 0) ? sp : (q == 1) ? cp : (q == 2) ? -sp : -cp;
    const double cc = (q == 0) ? cp : (q == 1) ? -sp : (q == 2) ? -cp : sp;
    s = (float)ss; c = (float)cc;
}
__device__ __forceinline__ void p0_prologue(Frame& F) {
    LAS float* scr = (LAS float*)(F.lds + F.wave * 16384);
    const int gw = F.vcu * NWAVES + F.wave, NGW = F.G * NWAVES, lane = F.lane;
    unsigned char* ws = F.ws;
    constexpr int I0 = 4096, I1 = 512, I5 = 128, I6 = 8192;
    constexpr int NITEMS = I0 + 4 * I1 + I5 + 3 * I6;
    for (int it = gw; it < NITEMS; it += NGW) {
        int r = it;
        if (r < I0) { const int kb = r >> 8, nb = r & 255; p0_transpose_item(F.in[I_WIN], NIN, F.in[I_GMIX], (bf16*)(ws + W_IN), D, 64 * kb, 32 * nb, win_drow(32 * nb), scr, lane); continue; } r -= I0;
        if (r < I1) { p0_transpose_item(F.in[I_WOC], D, nullptr, (bf16*)(ws + W_OC), D, 64 * (r >> 5), 32 * (r & 31), 32 * (r & 31), scr, lane); continue; } r -= I1;
        if (r < I1) { p0_transpose_item(F.in[I_WOR], D, nullptr, (bf16*)(ws + W_OR), D, 64 * (r >> 5), 32 * (r & 31), 32 * (r & 31), scr, lane); continue; } r -= I1;
        if (r < I1) { p0_transpose_item(F.in[I_WO], D, nullptr, (bf16*)(ws + W_O), D, 64 * (r >> 5), 32 * (r & 31), 32 * (r & 31), scr, lane); continue; } r -= I1;
        if (r < I1) { p0_transpose_item(F.in[I_WPG], D, F.in[I_GPIN], (bf16*)(ws + W_PG), D, 64 * (r >> 5), 32 * (r & 31), 32 * (r & 31), scr, lane); continue; } r -= I1;
        if (r < I5) { p0_transpose_item(F.in[I_WPP], D, nullptr, (bf16*)(ws + W_PP), PLE, 64 * (r >> 5), 32 * (r & 31), 32 * (r & 31), scr, lane); continue; } r -= I5;
        if (r < I6) { const int e = r >> 8, q = r & 255, kb = q >> 4, nb = q & 15, n0 = 32 * nb;
            p0_transpose_item(F.in[I_WG] + (size_t)e * D * DE, DE, F.in[I_GMOE], (bf16*)(ws + W_GU) + (size_t)e * 1024 * 1024, D, 64 * kb, n0, 256 * (n0 >> 7) + (n0 & 127), scr, lane); continue; } r -= I6;
        if (r < I6) { const int e = r >> 8, q = r & 255, kb = q >> 4, nb = q & 15, n0 = 32 * nb;
            p0_transpose_item(F.in[I_WU] + (size_t)e * D * DE, DE, F.in[I_GMOE], (bf16*)(ws + W_GU) + (size_t)e * 1024 * 1024, D, 64 * kb, n0, 256 * (n0 >> 7) + 128 + (n0 & 127), scr, lane); continue; } r -= I6;
        { const int e = r >> 8, q = r & 255, kb = q >> 5, nb = q & 31;
            p0_transpose_item(F.in[I_WD] + (size_t)e * DE * D, D, nullptr, (bf16*)(ws + W_DN) + (size_t)e * 1024 * 512, DE, 64 * kb, 32 * nb, 32 * nb, scr, lane); }
    }
    const int gt = F.vcu * NTHR + F.tid, NGT = F.G * NTHR;
    for (int it = gt; it < 256 * 128; it += NGT) {
        const int row = it >> 7, k0 = (it & 127) * 8; float v[8];
#pragma unroll
        for (int j = 0; j < 8; ++j) { const int k = k0 + j; float x = 0.f;
            if (row < 32) x = F.in[I_WRE][(size_t)k * NE + row] * F.in[I_GMOE][k];
            else if (row >= 128 && row < 132) x = F.in[I_WRG][(size_t)k * 4 + (row - 128)] * F.in[I_GMOE][k];
            v[j] = x; }
        u32x4 o; o.x = cvt_pk_bf16(v[0], v[1]); o.y = cvt_pk_bf16(v[2], v[3]); o.z = cvt_pk_bf16(v[4], v[5]); o.w = cvt_pk_bf16(v[6], v[7]);
        *(GAS u32x4*)((bf16*)(ws + W_R) + (size_t)row * D + k0) = o;
    }
    for (int it = gt; it < SEQ * 32; it += NGT) {
        const int pos = it >> 5, i = it & 31; float s, c; sincos_acc(__fmul_rn((float)pos, c_inv_freq[i]), s, c);
        ((GAS f32x2*)(ws + WS_ROPE))[it] = (f32x2){c, s};
    }
    { const float* p = F.in[I_P]; bf16* pb = (bf16*)(ws + WS_PB);
      for (size_t it = gt; it < (size_t)T * PLE / 8; it += NGT) { const f32x4 a = ((const GAS f32x4*)p)[2 * it], b = ((const GAS f32x4*)p)[2 * it + 1]; ((GAS u32x4*)pb)[it] = pack8(a, b); } }
    { const float* x = F.in[I_X]; bf16* xh = (bf16*)(ws + WS_A);
      for (int m = gw; m < T; m += NGW) {
          const GAS f32x4* xr = (const GAS f32x4*)(x + (size_t)m * D) + lane; f32x4 v[4]; float s = 0.f;
#pragma unroll
          for (int j = 0; j < 4; ++j) { v[j] = xr[64 * j]; s += (v[j].x * v[j].x + v[j].y * v[j].y) + (v[j].z * v[j].z + v[j].w * v[j].w); }
          const float rstd = 1.0f / sqrtf(wave_sum(s) * (1.f / D) + EPS);
          GAS u32x2* o8 = (GAS u32x2*)(xh + (size_t)m * D) + lane;
#pragma unroll
          for (int j = 0; j < 4; ++j) { u32x2 o; o.x = cvt_pk_bf16(v[j].x * rstd, v[j].y * rstd); o.y = cvt_pk_bf16(v[j].z * rstd, v[j].w * rstd); o8[64 * j] = o; }
      } }
}

struct EpiG1 {
    bf16 *cu, *bg, *q, *k, *v, *sg, *mc, *mr; const f32x2* rope;
    template <int ACT> __device__ __forceinline__ void plain(const Acc& acc, bf16* dst, int row0, int col0) const {
#pragma unroll
        for (int ai = 0; ai < 2; ++ai)
#pragma unroll
            for (int m = 0; m < 4; ++m) { bf16* rowp = dst + (size_t)(row0 + ai * 128 + m * 16) * D + col0;
#pragma unroll
                for (int bj = 0; bj < 2; ++bj) { f32x4 v0 = acc[ai][bj][m][0], v1 = acc[ai][bj][m][1];
                    if (ACT == 1) {
#pragma unroll
                        for (int j = 0; j < 4; ++j) { v0[j] = siluf_(v0[j]); v1[j] = siluf_(v1[j]); } }
                    if (ACT == 2) {
#pragma unroll
                        for (int j = 0; j < 4; ++j) { v0[j] = sigmoidf_(v0[j]); v1[j] = sigmoidf_(v1[j]); } }
                    *(GAS u32x4*)(rowp + bj * 128) = pack8(v0, v1); } }
    }
    __device__ __forceinline__ void operator()(const Acc& acc, const Unit& u, int wr, int wc, int fr, int fq) const {
        const int row0 = u.pm * 256 + wr * 64 + fr, pn = u.pn, cl = wc * 32 + 8 * fq;
        if (pn < 8) {
#pragma unroll
            for (int ai = 0; ai < 2; ++ai)
#pragma unroll
                for (int m = 0; m < 4; ++m) { bf16* rowp = cu + (size_t)(row0 + ai * 128 + m * 16) * D + pn * 128 + cl;
                    *(GAS u32x4*)rowp = pack8(acc[ai][0][m][0] * acc[ai][1][m][0], acc[ai][0][m][1] * acc[ai][1][m][1]); }
        } else if (pn < 12) plain<0>(acc, bg, row0, (pn - 8) * 256 + cl);
        else if (pn < 16) {
            const bool isk = pn >= 14; const int head = ((pn - 12) & 1) * 4 + wc; bf16* dst = isk ? k : q;
            const float lg = lg2_gamma(head);
#pragma unroll
            for (int ai = 0; ai < 2; ++ai)
#pragma unroll
                for (int m = 0; m < 4; ++m) { const int r = row0 + ai * 128 + m * 16, pos = r & (SEQ - 1); const float e = (float)((pos & (CH - 1)) + 1) * lg;
                    const float sc = isk ? 0.125f * exp2f(-e) : exp2f(e);
                    const GAS f32x4* rp = (const GAS f32x4*)(rope + (size_t)pos * 32 + 8 * fq);
                    f32x4 o1[2], o2[2];
#pragma unroll
                    for (int n = 0; n < 2; ++n) { const f32x4 cs0 = rp[2 * n], cs1 = rp[2 * n + 1];
                        const f32x4 a = acc[ai][0][m][n], b = acc[ai][1][m][n];
                        o1[n] = (f32x4){(a[0] * cs0[0] - b[0] * cs0[1]) * sc, (a[1] * cs0[2] - b[1] * cs0[3]) * sc, (a[2] * cs1[0] - b[2] * cs1[1]) * sc, (a[3] * cs1[2] - b[3] * cs1[3]) * sc};
                        o2[n] = (f32x4){(a[0] * cs0[1] + b[0] * cs0[0]) * sc, (a[1] * cs0[3] + b[1] * cs0[2]) * sc, (a[2] * cs1[1] + b[2] * cs1[0]) * sc, (a[3] * cs1[3] + b[3] * cs1[2]) * sc}; }
                    bf16* rowp = dst + (size_t)r * 512 + head * 64 + 8 * fq;
                    *(GAS u32x4*)rowp = pack8(o1[0], o1[1]); *(GAS u32x4*)(rowp + 32) = pack8(o2[0], o2[1]); }
        } else if (pn < 20) plain<0>(acc, v, row0, (pn - 16) * 256 + cl);
        else if (pn < 24) plain<1>(acc, sg, row0, (pn - 20) * 256 + cl);
        else if (pn < 28) plain<2>(acc, mc, row0, (pn - 24) * 256 + cl);
        else plain<2>(acc, mr, row0, (pn - 28) * 256 + cl);
    }
};
struct EpiGate {
    const bf16* gate; const bf16* prev; bf16* out; int mode;
    __device__ __forceinline__ void operator()(const Acc& acc, const Unit& u, int wr, int wc, int fr, int fq) const {
        const int row0 = u.pm * 256 + wr * 64 + fr, col0 = u.pn * 256 + wc * 32 + 8 * fq;
#pragma unroll
        for (int ai = 0; ai < 2; ++ai)
#pragma unroll
            for (int m = 0; m < 4; ++m) { const size_t ro = (size_t)(row0 + ai * 128 + m * 16) * D + col0;
#pragma unroll
                for (int bj = 0; bj < 2; ++bj) { f32x4 g0, g1; unpack8(*(const GAS u32x4*)(gate + ro + bj * 128), g0, g1);
                    f32x4 v0 = acc[ai][bj][m][0] * g0, v1 = acc[ai][bj][m][1] * g1;
                    if (mode) { f32x4 p0, p1; unpack8(*(const GAS u32x4*)(prev + ro + bj * 128), p0, p1); v0 += p0; v1 += p1; }
                    *(GAS u32x4*)(out + ro + bj * 128) = pack8(v0, v1); } }
    }
};
struct EpiRes {
    const float* x; float* x1; bf16* xb1; float* ssq;
    __device__ __forceinline__ void operator()(const Acc& acc, const Unit& u, int wr, int wc, int fr, int fq) const {
        const int row0 = u.pm * 256 + wr * 64 + fr, col0 = u.pn * 256 + wc * 32 + 8 * fq;
#pragma unroll
        for (int ai = 0; ai < 2; ++ai)
#pragma unroll
            for (int m = 0; m < 4; ++m) { const int r = row0 + ai * 128 + m * 16; const size_t ro = (size_t)r * D + col0; float s = 0.f;
#pragma unroll
                for (int bj = 0; bj < 2; ++bj) { const GAS f32x4* xp = (const GAS f32x4*)(x + ro + bj * 128);
                    const f32x4 v0 = xp[0] + acc[ai][bj][m][0], v1 = xp[1] + acc[ai][bj][m][1];
                    GAS f32x4* op = (GAS f32x4*)(x1 + ro + bj * 128); op[0] = v0; op[1] = v1;
                    *(GAS u32x4*)(xb1 + ro + bj * 128) = pack8(v0, v1);
                    s += (v0[0] * v0[0] + v0[1] * v0[1]) + (v0[2] * v0[2] + v0[3] * v0[3]) + (v1[0] * v1[0] + v1[1] * v1[1]) + (v1[2] * v1[2] + v1[3] * v1[3]); }
                s += __shfl_xor(s, 16); s += __shfl_xor(s, 32);
                if (fq == 0) ssq[(size_t)r * 16 + u.pn * 4 + wc] = s; }
    }
};
struct EpiRoute {
    const float* ssq; const float* brg; const float* bre; u32x4* route; float* rstd2;
    __device__ __forceinline__ void operator()(const Acc& acc, const Unit& u, int wr, int wc, int fr, int fq) const {
        if (wc != 0) return;
        const int row0 = u.pm * 256 + wr * 64 + fr;
        float be[8], bg4[4];
#pragma unroll
        for (int j = 0; j < 8; ++j) be[j] = bre[8 * fq + j];
#pragma unroll
        for (int j = 0; j < 4; ++j) bg4[j] = brg[j];
#pragma unroll
        for (int ai = 0; ai < 2; ++ai)
#pragma unroll
            for (int m = 0; m < 4; ++m) { const int r = row0 + ai * 128 + m * 16;
                const f32x4 pq = *(const GAS f32x4*)(ssq + (size_t)r * 16 + 4 * fq); float s = (pq[0] + pq[1]) + (pq[2] + pq[3]);
                s += __shfl_xor(s, 16); s += __shfl_xor(s, 32);
                const float rs = 1.0f / sqrtf(s * (1.f / D) + EPS);
                float el[8], gl[4];
#pragma unroll
                for (int j = 0; j < 8; ++j) el[j] = acc[ai][0][m][j >> 2][j & 3] * rs + be[j];
#pragma unroll
                for (int j = 0; j < 4; ++j) gl[j] = __shfl(acc[ai][1][m][0][j] * rs + bg4[j], fr);
                int grp = 0; float best = gl[0];
#pragma unroll
                for (int j = 1; j < 4; ++j) if (gl[j] > best) { best = gl[j]; grp = j; }
                float den = 0.f;
#pragma unroll
                for (int j = 0; j < 4; ++j) den += __expf(gl[j] - best);
                const float gw = 1.0f / den;
                int i1 = 0; float l1 = el[0];
#pragma unroll
                for (int j = 1; j < 8; ++j) if (el[j] > l1) { l1 = el[j]; i1 = j; }
                int i2 = -1; float l2 = -3.0e38f;
#pragma unroll
                for (int j = 0; j < 8; ++j) if (j != i1 && el[j] > l2) { l2 = el[j]; i2 = j; }
                const float w0 = 1.0f / (1.0f + __expf(l2 - l1)), w1 = 1.0f - w0;
                if (fq == grp) { u32x4 o; o.x = (unsigned)(grp * 8 + i1); o.y = (unsigned)(grp * 8 + i2); o.z = __float_as_uint(w0 * gw); o.w = __float_as_uint(w1 * gw);
                    *(GAS u32x4*)(route + r) = o; rstd2[r] = rs; } }
    }
};
template <bool GATH> struct MoeSched {
    static constexpr bool GATHER = GATH;
    const LAS int* tb; const LAS int* cn; const u32x2* lists; const char* A; const char* B; size_t bstride; int K, G, c;
    __device__ bool next(int i, Unit& u) const {
        const int U = i * G + c; if (U >= tb[32] * 4) return false;
        const int rt = U >> 2; int e = 0; while (e < 31 && tb[e + 1] <= rt) ++e;
        u.pm = rt; u.pn = U & 3; u.aux = e; return true;
    }
    __device__ __forceinline__ void ptrs(const Unit& u, const char*& a, const char*& b) const {
        a = GATH ? A : A + (size_t)u.pm * 256 * K * 2; b = B + (size_t)u.aux * bstride + (size_t)u.pn * 256 * K * 2; }
    __device__ __forceinline__ void goff(const Unit& u, int R0, int R1, int C0, int C1, unsigned (&vo)[2][2]) const {
        const int e = u.aux, n = cn[e], base = (u.pm - tb[e]) * 256; const u32x2* L = lists + (size_t)e * T;
#pragma unroll
        for (int h = 0; h < 2; ++h) { const int i0 = base + 128 * h + R0, i1 = base + 128 * h + R1;
            const unsigned t0 = (i0 < n) ? (L[i0].x >> 1) : 0u, t1 = (i1 < n) ? (L[i1].x >> 1) : 0u;
            vo[h][0] = (t0 * (unsigned)D + (unsigned)C0) * 2u; vo[h][1] = (t1 * (unsigned)D + (unsigned)C1) * 2u; }
    }
};
struct EpiHid {
    const LAS int* tb; const LAS int* cn; const u32x2* lists; const float* rstd2; bf16* hid;
    __device__ __forceinline__ void operator()(const Acc& acc, const Unit& u, int wr, int wc, int fr, int fq) const {
        const int e = u.aux, n = cn[e], base = (u.pm - tb[e]) * 256; const u32x2* L = lists + (size_t)e * T;
#pragma unroll
        for (int ai = 0; ai < 2; ++ai)
#pragma unroll
            for (int m = 0; m < 4; ++m) { const int rl = ai * 128 + wr * 64 + m * 16 + fr, idx = base + rl;
                float rs = 0.f; if (idx < n) rs = rstd2[L[idx].x >> 1];
                f32x4 h0, h1;
#pragma unroll
                for (int j = 0; j < 4; ++j) { h0[j] = siluf_(rs * acc[ai][0][m][0][j]) * (rs * acc[ai][1][m][0][j]); h1[j] = siluf_(rs * acc[ai][0][m][1][j]) * (rs * acc[ai][1][m][1][j]); }
                *(GAS u32x4*)(hid + (size_t)(u.pm * 256 + rl) * DE + u.pn * 128 + wc * 32 + 8 * fq) = pack8(h0, h1); }
    }
};
struct EpiDown {
    const LAS int* tb; const LAS int* cn; const u32x2* lists; bf16* Y;
    __device__ __forceinline__ void operator()(const Acc& acc, const Unit& u, int wr, int wc, int fr, int fq) const {
        const int e = u.aux, n = cn[e], base = (u.pm - tb[e]) * 256; const u32x2* L = lists + (size_t)e * T;
#pragma unroll
        for (int ai = 0; ai < 2; ++ai)
#pragma unroll
            for (int m = 0; m < 4; ++m) { const int idx = base + ai * 128 + wr * 64 + m * 16 + fr;
                if (idx < n) { const u32x2 en = L[idx]; const float w = __uint_as_float(en.y);
                    bf16* rowp = Y + (size_t)(en.x & 1u) * T * D + (size_t)(en.x >> 1) * D + u.pn * 256 + wc * 32 + 8 * fq;
#pragma unroll
                    for (int bj = 0; bj < 2; ++bj) *(GAS u32x4*)(rowp + bj * 128) = pack8(acc[ai][bj][m][0] * w, acc[ai][bj][m][1] * w); } }
    }
};
struct EpiPP {
    bf16* pp; float* ssq;
    __device__ __forceinline__ void operator()(const Acc& acc, const Unit& u, int wr, int wc, int fr, int fq) const {
        const int row0 = u.pm * 256 + wr * 64 + fr, col0 = u.pn * 256 + wc * 32 + 8 * fq;
#pragma unroll
        for (int ai = 0; ai < 2; ++ai)
#pragma unroll
            for (int m = 0; m < 4; ++m) { const int r = row0 + ai * 128 + m * 16; float s = 0.f;
#pragma unroll
                for (int bj = 0; bj < 2; ++bj) { const f32x4 v0 = acc[ai][bj][m][0], v1 = acc[ai][bj][m][1];
                    *(GAS u32x4*)(pp + (size_t)r * D + col0 + bj * 128) = pack8(v0, v1);
                    s += (v0[0] * v0[0] + v0[1] * v0[1]) + (v0[2] * v0[2] + v0[3] * v0[3]) + (v1[0] * v1[0] + v1[1] * v1[1]) + (v1[2] * v1[2] + v1[3] * v1[3]); }
                s += __shfl_xor(s, 16); s += __shfl_xor(s, 32);
                if (fq == 0) ssq[(size_t)r * 16 + u.pn * 4 + wc] = s; }
    }
};
struct EpiPle {
    float* x2; const bf16* pp; const float* ssqp; const float* gpost; float* ssq3;
    __device__ __forceinline__ void operator()(const Acc& acc, const Unit& u, int wr, int wc, int fr, int fq) const {
        const int row0 = u.pm * 256 + wr * 64 + fr, col0 = u.pn * 256 + wc * 32 + 8 * fq;
#pragma unroll
        for (int ai = 0; ai < 2; ++ai)
#pragma unroll
            for (int m = 0; m < 4; ++m) { const int r = row0 + ai * 128 + m * 16; const size_t ro = (size_t)r * D + col0;
                const f32x4 pq = *(const GAS f32x4*)(ssqp + (size_t)r * 16 + 4 * fq); float sp = (pq[0] + pq[1]) + (pq[2] + pq[3]);
                sp += __shfl_xor(sp, 16); sp += __shfl_xor(sp, 32);
                const float rp = 1.0f / sqrtf(sp * (1.f / D) + EPS); float s = 0.f;
#pragma unroll
                for (int bj = 0; bj < 2; ++bj) { f32x4 p0, p1; unpack8(*(const GAS u32x4*)(pp + ro + bj * 128), p0, p1);
                    const GAS f32x4* gp = (const GAS f32x4*)(gpost + col0 + bj * 128); const f32x4 g0 = gp[0], g1 = gp[1];
                    GAS f32x4* xp = (GAS f32x4*)(x2 + ro + bj * 128); f32x4 v0 = xp[0], v1 = xp[1];
#pragma unroll
                    for (int j = 0; j < 4; ++j) { v0[j] += sigmoidf_(acc[ai][bj][m][0][j]) * (p0[j] * rp * g0[j]); v1[j] += sigmoidf_(acc[ai][bj][m][1][j]) * (p1[j] * rp * g1[j]); }
                    xp[0] = v0; xp[1] = v1;
                    s += (v0[0] * v0[0] + v0[1] * v0[1]) + (v0[2] * v0[2] + v0[3] * v0[3]) + (v1[0] * v1[0] + v1[1] * v1[1]) + (v1[2] * v1[2] + v1[3] * v1[3]); }
                s += __shfl_xor(s, 16); s += __shfl_xor(s, 32);
                if (fq == 0) ssq3[(size_t)r * 16 + u.pn * 4 + wc] = s; }
    }
};

__device__ __forceinline__ void conv_pass(Frame& F, const bf16* cu, const bf16* bg, bf16* ypre) {
    const int gw = F.vcu * NWAVES + F.wave, NGW = F.G * NWAVES, lane = F.lane;
    const float* cw = F.in[I_CONVW];
    for (int un = gw; un < (T / 64) * 2; un += NGW) {
        const int hc = un & 1, t0 = (un >> 1) * 64, ch = hc * 512 + lane * 8;
        f32x4 w0a = *(const GAS f32x4*)(cw + ch), w0b = *(const GAS f32x4*)(cw + ch + 4), w1a = *(const GAS f32x4*)(cw + D + ch), w1b = *(const GAS f32x4*)(cw + D + ch + 4),
              w2a = *(const GAS f32x4*)(cw + 2 * D + ch), w2b = *(const GAS f32x4*)(cw + 2 * D + ch + 4);
        f32x4 p2a = {0.f, 0.f, 0.f, 0.f}, p2b = p2a, p1a = p2a, p1b = p2a;
        if ((t0 & (SEQ - 1)) != 0) { unpack8(*(const GAS u32x4*)(cu + (size_t)(t0 - 2) * D + ch), p2a, p2b); unpack8(*(const GAS u32x4*)(cu + (size_t)(t0 - 1) * D + ch), p1a, p1b); }
#pragma unroll 4
        for (int i = 0; i < 64; ++i) { const size_t ro = (size_t)(t0 + i) * D + ch; f32x4 ca, cb, ba, bb;
            unpack8(*(const GAS u32x4*)(cu + ro), ca, cb); unpack8(*(const GAS u32x4*)(bg + ro), ba, bb);
            const f32x4 ya = ba * (w0a * p2a + w1a * p1a + w2a * ca), yb = bb * (w0b * p2b + w1b * p1b + w2b * cb);
            *(GAS u32x4*)(ypre + ro) = pack8(ya, yb);
            p2a = p1a; p2b = p1b; p1a = ca; p1b = cb; }
    }
}
__device__ __forceinline__ void state_scan(Frame& F, const bf16* kk, const bf16* vv, bf16* S) {
    LAS char* lds = (LAS char*)F.lds;
    constexpr int KST = 144, VST = 80, KBUF = 128 * KST, VBUF = 128 * VST;
    const int tid = F.tid, lane = F.lane, w = F.wave, g = lane >> 4, li = lane & 15, q4 = li >> 2, p4 = li & 3, vt = w >> 2, dt = w & 3;
    for (int un = blockIdx.x; un < 64 * 4; un += F.G) {
        const int bh = un >> 2, vq = un & 3, b = bh >> 3, h = bh & 7;
        const float g128 = exp2f(128.0f * lg2_gamma(h));
        f32x4 Sacc = {0.f, 0.f, 0.f, 0.f};
        __syncthreads();
        u32x4 rk[2], rv;
        { const size_t tok0 = (size_t)b * SEQ;
#pragma unroll
          for (int j = 0; j < 2; ++j) { const int piece = tid + 512 * j, row = piece >> 3, ch = piece & 7; rk[j] = *(const GAS u32x4*)(kk + (tok0 + row) * 512 + h * 64 + ch * 8); }
          { const int row = tid >> 2, ch = tid & 3; rv = *(const GAS u32x4*)(vv + (tok0 + row) * D + h * 128 + vq * 32 + ch * 8); }
#pragma unroll
          for (int j = 0; j < 2; ++j) { const int piece = tid + 512 * j, row = piece >> 3, ch = piece & 7; *(LAS u32x4*)(lds + row * KST + ch * 16) = rk[j]; }
          { const int row = tid >> 2, ch = tid & 3; *(LAS u32x4*)(lds + 2 * KBUF + row * VST + ch * 16) = rv; } }
        for (int c = 0; c < NCH; ++c) {
            { u32x2 o; o.x = cvt_pk_bf16(Sacc[0], Sacc[1]); o.y = cvt_pk_bf16(Sacc[2], Sacc[3]);
              *(GAS u32x2*)(S + ((size_t)(bh * NCH + c) * DK + 16 * dt + li) * DV + 32 * vq + 16 * vt + 4 * g) = o; }
            if (c == NCH - 1) break;
            const int cb = c & 1; const bool pre = (c + 1 < NCH - 1);
            if (pre) { const size_t tok0 = (size_t)b * SEQ + (size_t)(c + 1) * CH;
#pragma unroll
                for (int j = 0; j < 2; ++j) { const int piece = tid + 512 * j, row = piece >> 3, ch = piece & 7; rk[j] = *(const GAS u32x4*)(kk + (tok0 + row) * 512 + h * 64 + ch * 8); }
                { const int row = tid >> 2, ch = tid & 3; rv = *(const GAS u32x4*)(vv + (tok0 + row) * D + h * 128 + vq * 32 + ch * 8); } }
            __syncthreads();
            const LAS char* kb = lds + cb * KBUF; const LAS char* vb = lds + 2 * KBUF + cb * VBUF;
            f32x4 a4 = Sacc;
#pragma unroll
            for (int s = 0; s < 4; ++s) {
                const int r0 = 32 * s + 8 * g + q4;
                const s16x4 alo = tr_read(vb + r0 * VST + (16 * vt + 4 * p4) * 2), ahi = tr_read(vb + (r0 + 4) * VST + (16 * vt + 4 * p4) * 2);
                const s16x4 blo = tr_read(kb + r0 * KST + (16 * dt + 4 * p4) * 2), bhi = tr_read(kb + (r0 + 4) * KST + (16 * dt + 4 * p4) * 2);
                const bf16x8 af = __builtin_shufflevector(alo, ahi, 0, 1, 2, 3, 4, 5, 6, 7), bf = __builtin_shufflevector(blo, bhi, 0, 1, 2, 3, 4, 5, 6, 7);
                a4 = __builtin_amdgcn_mfma_f32_16x16x32_bf16(af, bf, a4, 0, 0, 0);
            }
            Sacc = a4 * g128;
            if (pre) { const int nb = cb ^ 1;
#pragma unroll
                for (int j = 0; j < 2; ++j) { const int piece = tid + 512 * j, row = piece >> 3, ch = piece & 7; *(LAS u32x4*)(lds + nb * KBUF + row * KST + ch * 16) = rk[j]; }
                { const int row = tid >> 2, ch = tid & 3; *(LAS u32x4*)(lds + 2 * KBUF + nb * VBUF + row * VST + ch * 16) = rv; } }
        }
    }
    __syncthreads();
}

__device__ __forceinline__ void ret_out(Frame& F, const bf16* qq, const bf16* kk, const bf16* vv, const bf16* S, const bf16* sgs, bf16* og) {
    LAS char* lds = (LAS char*)F.lds;
    constexpr int VST = 288, KST = 144, KOFF = 192 * VST;
    const int tid = F.tid, lane = F.lane, w = F.wave, g = lane >> 4, li = lane & 15, q4 = li >> 2, p4 = li & 3;
    const float* gret = F.in[I_GRET];
    for (int un = blockIdx.x; un < NB * NH * NCH; un += F.G) {
        const int bh = un >> 6, c = un & 63, b = bh >> 3, h = bh & 7;
        const size_t tok0 = (size_t)b * SEQ + (size_t)c * CH;
        __syncthreads();
#pragma unroll
        for (int j = 0; j < 4; ++j) { const int piece = tid + 512 * j, row = piece >> 4, ch = piece & 15;
            *(LAS u32x4*)(lds + row * VST + ch * 16) = *(const GAS u32x4*)(vv + (tok0 + row) * D + h * 128 + ch * 8); }
        if (c > 0) {
#pragma unroll
            for (int j = 0; j < 2; ++j) { const int piece = tid + 512 * j, row = piece >> 4, ch = piece & 15;
                *(LAS u32x4*)(lds + (128 + row) * VST + ch * 16) = *(const GAS u32x4*)(S + ((size_t)(bh * NCH + c) * DK + row) * DV + ch * 8); } }
#pragma unroll
        for (int j = 0; j < 2; ++j) { const int piece = tid + 512 * j, row = piece >> 3, ch = piece & 7;
            *(LAS u32x4*)(lds + KOFF + row * KST + ch * 16) = *(const GAS u32x4*)(kk + (tok0 + row) * 512 + h * 64 + ch * 8); }
        bf16x8 qf[2];
#pragma unroll
        for (int s = 0; s < 2; ++s) qf[s] = *(const GAS bf16x8*)(qq + (tok0 + 16 * w + li) * 512 + h * 64 + 32 * s + 8 * g);
        __syncthreads();
        f32x4 pt[8];
#pragma unroll
        for (int t = 0; t < 8; ++t) {
            pt[t] = (f32x4){0.f, 0.f, 0.f, 0.f};
            if (t <= w) {
                const bf16x8 k0 = *(const LAS bf16x8*)(lds + KOFF + (16 * t + li) * KST + (8 * g) * 2), k1 = *(const LAS bf16x8*)(lds + KOFF + (16 * t + li) * KST + (32 + 8 * g) * 2);
                pt[t] = __builtin_amdgcn_mfma_f32_16x16x32_bf16(k0, qf[0], pt[t], 0, 0, 0);
                pt[t] = __builtin_amdgcn_mfma_f32_16x16x32_bf16(k1, qf[1], pt[t], 0, 0, 0);
                if (t == w) {
#pragma unroll
                    for (int r = 0; r < 4; ++r) if (4 * g + r > li) pt[t][r] = 0.f; }
            }
        }
        f32x4 acc[8];
#pragma unroll
        for (int n = 0; n < 8; ++n) acc[n] = (f32x4){0.f, 0.f, 0.f, 0.f};
#pragma unroll
        for (int s2 = 0; s2 < 4; ++s2) {
            if (2 * s2 <= w) {
                u32x4 pw; pw.x = cvt_pk_bf16(pt[2 * s2][0], pt[2 * s2][1]); pw.y = cvt_pk_bf16(pt[2 * s2][2], pt[2 * s2][3]);
                pw.z = cvt_pk_bf16(pt[2 * s2 + 1][0], pt[2 * s2 + 1][1]); pw.w = cvt_pk_bf16(pt[2 * s2 + 1][2], pt[2 * s2 + 1][3]);
                const bf16x8 pa = __builtin_bit_cast(bf16x8, pw);
#pragma unroll
                for (int n = 0; n < 8; ++n) {
                    const s16x4 lo = tr_read(lds + (32 * s2 + 4 * g + q4) * VST + (16 * n + 4 * p4) * 2), hi = tr_read(lds + (32 * s2 + 16 + 4 * g + q4) * VST + (16 * n + 4 * p4) * 2);
                    const bf16x8 vf = __builtin_shufflevector(lo, hi, 0, 1, 2, 3, 4, 5, 6, 7);
                    acc[n] = __builtin_amdgcn_mfma_f32_16x16x32_bf16(pa, vf, acc[n], 0, 0, 0);
                }
            }
        }
        if (c > 0) {
#pragma unroll
            for (int s = 0; s < 2; ++s)
#pragma unroll
                for (int n = 0; n < 8; ++n) {
                    const s16x4 lo = tr_read(lds + (128 + 32 * s + 8 * g + q4) * VST + (16 * n + 4 * p4) * 2), hi = tr_read(lds + (128 + 32 * s + 8 * g + 4 + q4) * VST + (16 * n + 4 * p4) * 2);
                    const bf16x8 sf = __builtin_shufflevector(lo, hi, 0, 1, 2, 3, 4, 5, 6, 7);
                    acc[n] = __builtin_amdgcn_mfma_f32_16x16x32_bf16(qf[s], sf, acc[n], 0, 0, 0);
                }
        }
        float rs[4];
#pragma unroll
        for (int r = 0; r < 4; ++r) { float s = 0.f;
#pragma unroll
            for (int n = 0; n < 8; ++n) s += acc[n][r] * acc[n][r];
            s += __shfl_xor(s, 1); s += __shfl_xor(s, 2); s += __shfl_xor(s, 4); s += __shfl_xor(s, 8);
            rs[r] = 1.0f / sqrtf(s * (1.f / DV) + EPS); }
#pragma unroll
        for (int n = 0; n < 8; ++n) { const int col = h * 128 + 16 * n + li; const float gr = gret[col];
#pragma unroll
            for (int r = 0; r < 4; ++r) { const size_t o = (tok0 + 16 * w + 4 * g + r) * D + col;
                og[o] = f2bf(acc[n][r] * rs[r] * gr * bf2f(sgs[o])); } }
    }
    __syncthreads();
}

__device__ __forceinline__ void bucket_phase(Frame& F, const u32x4* route, u32x2* lists, unsigned* gcnt) {
    LAS int* hist = (LAS int*)(F.lds + HS_OFF); LAS int* base = hist + 32;
    for (int ch = blockIdx.x; ch < T / NTHR; ch += F.G) {
        __syncthreads();
        if (F.tid < 32) hist[F.tid] = 0;
        __syncthreads();
        const int tok = ch * NTHR + F.tid; const u32x4 ro = route[tok];
        const int r0 = atomicAdd((int*)&hist[ro.x], 1), r1 = atomicAdd((int*)&hist[ro.y], 1);
        __syncthreads();
        if (F.tid < 32) base[F.tid] = (int)__hip_atomic_fetch_add(gcnt + F.tid, (unsigned)hist[F.tid], RLX_AGENT);
        __syncthreads();
        lists[(size_t)ro.x * T + base[ro.x] + r0] = (u32x2){(unsigned)tok * 2u, ro.z};
        lists[(size_t)ro.y * T + base[ro.y] + r1] = (u32x2){(unsigned)tok * 2u + 1u, ro.w};
    }
}
__device__ __forceinline__ void moe_tables(Frame& F, unsigned* gcnt) {
    LAS int* tb = (LAS int*)(F.lds + TB_OFF); LAS int* cn = (LAS int*)(F.lds + CN_OFF);
    __syncthreads();
    if (F.tid < 32) cn[F.tid] = (int)__hip_atomic_load(gcnt + F.tid, RLX_AGENT);
    __syncthreads();
    if (F.tid == 0) { int a = 0; for (int e = 0; e < 32; ++e) { tb[e] = a; a += (cn[e] + 255) >> 8; } tb[32] = a; }
    __syncthreads();
}
__device__ __forceinline__ void combine_pass(Frame& F, float* x1, const bf16* Y, bf16* xh3) {
    const int gw = F.vcu * NWAVES + F.wave, NGW = F.G * NWAVES, lane = F.lane;
    for (int m = gw; m < T; m += NGW) {
        GAS f32x4* xr = (GAS f32x4*)(x1 + (size_t)m * D) + lane; const GAS u32x2* y0 = (const GAS u32x2*)(Y + (size_t)m * D) + lane; const GAS u32x2* y1 = (const GAS u32x2*)(Y + (size_t)T * D + (size_t)m * D) + lane;
        f32x4 v[4]; float s = 0.f;
#pragma unroll
        for (int j = 0; j < 4; ++j) { v[j] = xr[64 * j]; const u32x2 a = y0[64 * j], b = y1[64 * j];
            v[j] += (f32x4){bf_lo(a.x), bf_hi(a.x), bf_lo(a.y), bf_hi(a.y)} + (f32x4){bf_lo(b.x), bf_hi(b.x), bf_lo(b.y), bf_hi(b.y)};
            s += (v[j].x * v[j].x + v[j].y * v[j].y) + (v[j].z * v[j].z + v[j].w * v[j].w); xr[64 * j] = v[j]; }
        const float rstd = 1.0f / sqrtf(wave_sum(s) * (1.f / D) + EPS);
        GAS u32x2* o8 = (GAS u32x2*)(xh3 + (size_t)m * D) + lane;
#pragma unroll
        for (int j = 0; j < 4; ++j) { u32x2 o; o.x = cvt_pk_bf16(v[j].x * rstd, v[j].y * rstd); o.y = cvt_pk_bf16(v[j].z * rstd, v[j].w * rstd); o8[64 * j] = o; }
    }
}
__device__ __forceinline__ void final_pass(Frame& F, const float* x3, const float* ssq3, float* out) {
    const int gw = F.vcu * NWAVES + F.wave, NGW = F.G * NWAVES, lane = F.lane;
    const float* gf = F.in[I_GFIN];
    f32x4 gv[4];
#pragma unroll
    for (int j = 0; j < 4; ++j) gv[j] = ((const GAS f32x4*)gf)[lane + 64 * j];
    for (int m = gw; m < T; m += NGW) {
        const float s = wave_sum(lane < 16 ? ssq3[(size_t)m * 16 + lane] : 0.f);
        const float rstd = 1.0f / sqrtf(s * (1.f / D) + EPS);
        const GAS f32x4* xr = (const GAS f32x4*)(x3 + (size_t)m * D) + lane; GAS f32x4* o = (GAS f32x4*)(out + (size_t)m * D) + lane;
#pragma unroll
        for (int j = 0; j < 4; ++j) o[64 * j] = xr[64 * j] * rstd * gv[j];
    }
}

constexpr int N_PHASES = 14;
__global__ void __launch_bounds__(NTHR, 2) hyb_fwd(Args args) {
    extern __shared__ __attribute__((aligned(16))) unsigned char lds_raw[];
    Frame F;
    F.lds = (LAS unsigned char*)lds_raw;
    F.tid = threadIdx.x; F.lane = F.tid & 63; F.wave = __builtin_amdgcn_readfirstlane(F.tid >> 6);
    F.G = gridDim.x; { const int bx = blockIdx.x; F.vcu = (F.G % 8 == 0) ? (bx % 8) * (F.G / 8) + bx / 8 : bx; }
#pragma unroll
    for (int i = 0; i < 22; ++i) F.in[i] = args.in[i];
    F.ws = args.ws; F.out = (unsigned char*)args.out;
    unsigned char* ws = args.ws;
    volatile LAS unsigned* MISC = (volatile LAS unsigned*)(F.lds + MISC_OFF);
    for (int u = F.tid; u < (LDS_BYTES - RING_BYTES) / 4; u += NTHR) ((LAS unsigned*)(F.lds + RING_BYTES))[u] = 0u;
    __syncthreads();
    unsigned* ctl = (unsigned*)(ws + WS_CTL);
    const int lo = args.ph_lo, hi = args.ph_hi;
    const bool multi = (hi - lo) > 1;
    XcdBarrier bar; bar.bar = ctl + CW_BAR; bar.x = 0; bar.st = nullptr;
    if (multi) bar = xcd_barrier_post(ctl + CW_BAR, MISC + 8);
#define IN(k) (lo <= (k) && (k) < hi)
#define SEAM(k) do { if (IN(k) && IN((k) + 1)) xcd_barrier(bar); } while (0)

    bf16* const bufA = (bf16*)(ws + WS_A);
    bf16* const cu = (bf16*)F.out; bf16* const bgb = (bf16*)F.out + (size_t)T * D;
    bf16* const og = (bf16*)F.out; bf16* const mixc = (bf16*)F.out + (size_t)T * D;
    bf16* const Yb = (bf16*)F.out;
    bf16* const qb = (bf16*)(ws + WS_Q); bf16* const kb = (bf16*)(ws + WS_K); bf16* const vb = (bf16*)(ws + WS_V); bf16* const sgb = (bf16*)(ws + WS_SG);
    bf16* const mcb = (bf16*)(ws + WS_MC); bf16* const mrb = (bf16*)(ws + WS_MR); bf16* const Sb = (bf16*)(ws + WS_S);
    bf16* const mixed = (bf16*)(ws + WS_Q); bf16* const ppb = (bf16*)(ws + WS_Q);
    float* const x1 = (float*)(ws + WS_V); bf16* const hid = (bf16*)(ws + WS_MC);
    float* const ssq1 = (float*)(ws + WS_SSQ1); float* const ssqp = (float*)(ws + WS_SSQP); float* const ssq3 = (float*)(ws + WS_SSQ3);
    u32x4* const route = (u32x4*)(ws + WS_ROUTE); u32x2* const lists = (u32x2*)(ws + WS_LIST); float* const rstd2 = (float*)(ws + WS_RSTD2);
    unsigned* const gcnt = ctl + CW_CNT;
    const LAS int* tb = (const LAS int*)(F.lds + TB_OFF); const LAS int* cn = (const LAS int*)(F.lds + CN_OFF);

    if (IN(0)) { p0_prologue(F); } SEAM(0);
    if (IN(1)) { pg8::StaticOrder S; S.init(bufA, ws + W_IN, T, NIN, D, F.G, (int)blockIdx.x);
        EpiG1 E{cu, bgb, qb, kb, vb, sgb, mcb, mrb, (const f32x2*)(ws + WS_ROPE)};
        pg8::gemm_phase(F.lds, D, S, E); } SEAM(1);
    if (IN(2)) { conv_pass(F, cu, bgb, bufA); state_scan(F, kb, vb, Sb); } SEAM(2);
    if (IN(3)) { ret_out(F, qb, kb, vb, Sb, sgb, og);
        pg8::StaticOrder S; S.init(bufA, ws + W_OC, T, D, D, F.G, (int)blockIdx.x);
        EpiGate E{mcb, nullptr, mixc, 0};
        pg8::gemm_phase(F.lds, D, S, E); } SEAM(3);
    if (IN(4)) { pg8::StaticOrder S; S.init(og, ws + W_OR, T, D, D, F.G, (int)blockIdx.x);
        EpiGate E{mrb, mixc, mixed, 1};
        pg8::gemm_phase(F.lds, D, S, E); } SEAM(4);
    if (IN(5)) { pg8::StaticOrder S; S.init(mixed, ws + W_O, T, D, D, F.G, (int)blockIdx.x);
        EpiRes E{F.in[I_X], x1, bufA, ssq1};
        pg8::gemm_phase(F.lds, D, S, E); } SEAM(5);
    if (IN(6)) { pg8::StaticOrder S; S.init(bufA, ws + W_R, T, 256, D, F.G, (int)blockIdx.x);
        EpiRoute E{ssq1, F.in[I_BRG], F.in[I_BRE], route, rstd2};
        pg8::gemm_phase(F.lds, D, S, E); } SEAM(6);
    if (IN(7)) { bucket_phase(F, route, lists, gcnt); } SEAM(7);
    if (IN(8)) { moe_tables(F, gcnt);
        MoeSched<true> S{tb, cn, lists, (const char*)bufA, (const char*)(ws + W_GU), (size_t)1024 * 1024 * 2, D, F.G, F.vcu};
        EpiHid E{tb, cn, lists, rstd2, hid};
        pg8::gemm_phase(F.lds, D, S, E); } SEAM(8);
    if (IN(9)) { moe_tables(F, gcnt);
        MoeSched<false> S{tb, cn, lists, (const char*)hid, (const char*)(ws + W_DN), (size_t)1024 * 512 * 2, DE, F.G, F.vcu};
        EpiDown E{tb, cn, lists, Yb};
        pg8::gemm_phase(F.lds, DE, S, E); } SEAM(9);
    if (IN(10)) { combine_pass(F, x1, Yb, bufA);
        pg8::StaticOrder S; S.init(ws + WS_PB, ws + W_PP, T, D, PLE, F.G, (int)blockIdx.x);
        EpiPP E{ppb, ssqp};
        pg8::gemm_phase(F.lds, PLE, S, E); } SEAM(10);
    if (IN(11)) { pg8::StaticOrder S; S.init(bufA, ws + W_PG, T, D, D, F.G, (int)blockIdx.x);
        EpiPle E{x1, ppb, ssqp, F.in[I_GPOST], ssq3};
        pg8::gemm_phase(F.lds, D, S, E); } SEAM(11);
    if (IN(12)) { final_pass(F, x1, ssq3, (float*)F.out); }
#undef IN
#undef SEAM
}

#ifndef N_LAUNCHES
#define N_LAUNCHES 13
#endif
extern "C" void kernel_launch(void* const* d_in, const int* in_sizes, int n_in, void* d_out, int out_size, void* d_ws, size_t ws_size, hipStream_t stream) {
    static int grid = 0;
    if (grid == 0) {
        if (n_in != 22 || in_sizes[0] != T * D || out_size != T * D || ws_size < WS_END) { fprintf(stderr, "kernel_launch: unexpected shapes / workspace (ws %zu, need %zu)\n", ws_size, (size_t)WS_END); grid = -1; return; }
        int dev = 0, cus = 0, per_cu = 0;
        if (hipGetDevice(&dev) != hipSuccess || hipDeviceGetAttribute(&cus, hipDeviceAttributeMultiprocessorCount, dev) != hipSuccess) { grid = -1; return; }
        if (hipFuncSetAttribute((const void*)hyb_fwd, hipFuncAttributeMaxDynamicSharedMemorySize, LDS_BYTES) != hipSuccess) { fprintf(stderr, "kernel_launch: hipFuncSetAttribute failed\n"); grid = -1; return; }
        if (hipOccupancyMaxActiveBlocksPerMultiprocessor(&per_cu, (const void*)hyb_fwd, NTHR, LDS_BYTES) != hipSuccess || per_cu < 1) { fprintf(stderr, "kernel_launch: occupancy query says %d\n", per_cu); }
        (void)hipGetLastError();
        grid = cus;
    }
    if (grid < 0) return;
    if (hipMemsetAsync((char*)d_ws + WS_CTL, 0, CTL_ZERO_BYTES, stream) != hipSuccess) return;
    Args a{};
    for (int i = 0; i < 22; ++i) a.in[i] = (const float*)d_in[i];
    a.out = (float*)d_out; a.ws = (unsigned char*)d_ws;
#if N_LAUNCHES == 1
    a.ph_lo = 0; a.ph_hi = N_PHASES;
    hipLaunchKernelGGL(hyb_fwd, dim3(grid), dim3(NTHR), LDS_BYTES, stream, a);
#else
    for (int p = 0; p < 13; ++p) { a.ph_lo = p; a.ph_hi = p + 1; hipLaunchKernelGGL(hyb_fwd, dim3(grid), dim3(NTHR), LDS_BYTES, stream, a); }
#endif
}
```

```cpp
#include <hip/hip_runtime.h>
#include <cstdio>
#include <cstdint>

#define LAS __attribute__((address_space(3)))
#define GAS __attribute__((address_space(1)))
typedef unsigned short bf16;
typedef short bf16x8 __attribute__((ext_vector_type(8)));
typedef short s16x4 __attribute__((ext_vector_type(4)));
typedef float f32x4 __attribute__((ext_vector_type(4)));
typedef float f32x2 __attribute__((ext_vector_type(2)));
typedef unsigned u32x4 __attribute__((ext_vector_type(4)));
typedef unsigned u32x2 __attribute__((ext_vector_type(2)));
typedef GAS unsigned gu32;
#define RLX_AGENT __ATOMIC_RELAXED, __HIP_MEMORY_SCOPE_AGENT

constexpr int D = 1024, NB = 8, SEQ = 8192, T = NB * SEQ, PLE = 256;
constexpr int NH = 8, DK = 64, DV = 128, CH = 128, NCH = SEQ / CH;
constexpr int NE = 32, DE = 512;
constexpr int NIN = 8192;
constexpr float EPS = 1e-6f;
constexpr int NWAVES = 8, NTHR = 512;

constexpr size_t MiB = 1u << 20;
constexpr size_t WS_CTL = 0, CTL_ZERO_BYTES = 1 * MiB;
constexpr size_t WS_ROUTE = 1 * MiB;
constexpr size_t WS_ROPE = 2 * MiB;
constexpr size_t WS_SSQ1 = 4 * MiB;
constexpr size_t WS_SSQP = 8 * MiB;
constexpr size_t WS_SSQ3 = 12 * MiB;
constexpr size_t WS_LIST = 16 * MiB;
constexpr size_t WS_W = 32 * MiB;
constexpr size_t W_IN = WS_W;
constexpr size_t W_OC = W_IN + 16 * MiB;
constexpr size_t W_OR = W_OC + 2 * MiB;
constexpr size_t W_O = W_OR + 2 * MiB;
constexpr size_t W_PG = W_O + 2 * MiB;
constexpr size_t W_PP = W_PG + 2 * MiB;
constexpr size_t W_R = W_PP + 1 * MiB;
constexpr size_t W_GU = W_R + 1 * MiB;
constexpr size_t W_DN = W_GU + 64 * MiB;
constexpr size_t WS_RSTD2 = W_DN + 32 * MiB;
constexpr size_t WS_A = 155 * MiB;
constexpr size_t WS_PB = 283 * MiB;
constexpr size_t WS_Q = 315 * MiB;
constexpr size_t WS_K = 379 * MiB;
constexpr size_t WS_V = 443 * MiB;
constexpr size_t WS_SG = 571 * MiB;
constexpr size_t WS_MC = 699 * MiB;
constexpr size_t WS_MR = 827 * MiB;
constexpr size_t WS_S = 955 * MiB;
constexpr size_t WS_END = 1019 * MiB;
static_assert(WS_RSTD2 + (size_t)T * 4 <= WS_A, "ws map");

constexpr int CW_CNT = 64;
constexpr int CW_BAR = 4096;

constexpr int RING_BYTES = 131072;
constexpr int MISC_OFF = RING_BYTES;
constexpr int TB_OFF = RING_BYTES + 256;
constexpr int CN_OFF = RING_BYTES + 512;
constexpr int HS_OFF = RING_BYTES + 768;
constexpr int LDS_BYTES = 147456;

__device__ __forceinline__ unsigned cvt_pk_bf16(float lo, float hi) { unsigned r; asm volatile("v_cvt_pk_bf16_f32 %0, %1, %2" : "=v"(r) : "v"(lo), "v"(hi)); return r; }
__device__ __forceinline__ float bf_lo(unsigned u) { return __uint_as_float(u << 16); }
__device__ __forceinline__ float bf_hi(unsigned u) { return __uint_as_float(u & 0xffff0000u); }
__device__ __forceinline__ float bf2f(bf16 b) { return __uint_as_float(((unsigned)b) << 16); }
__device__ __forceinline__ bf16 f2bf(float f) { unsigned u = __float_as_uint(f); return (bf16)((u + 0x7fffu + ((u >> 16) & 1u)) >> 16); }
__device__ __forceinline__ u32x4 pack8(const f32x4 a, const f32x4 b) { u32x4 w; w.x = cvt_pk_bf16(a[0], a[1]); w.y = cvt_pk_bf16(a[2], a[3]); w.z = cvt_pk_bf16(b[0], b[1]); w.w = cvt_pk_bf16(b[2], b[3]); return w; }
__device__ __forceinline__ void unpack8(const u32x4 w, f32x4& a, f32x4& b) { a = (f32x4){bf_lo(w.x), bf_hi(w.x), bf_lo(w.y), bf_hi(w.y)}; b = (f32x4){bf_lo(w.z), bf_hi(w.z), bf_lo(w.w), bf_hi(w.w)}; }
__device__ __forceinline__ float sigmoidf_(float x) { return 1.0f / (1.0f + __expf(-x)); }
__device__ __forceinline__ float siluf_(float x) { return x / (1.0f + __expf(-x)); }
__device__ __forceinline__ float wave_sum(float v) {
#pragma unroll
    for (int o = 1; o < 64; o <<= 1) v += __shfl_xor(v, o);
    return v;
}
__device__ __forceinline__ s16x4 tr_read(LAS const char* p) { return __builtin_bit_cast(s16x4, __builtin_amdgcn_ds_read_tr16_b64_v4i16((LAS s16x4*)p)); }

__constant__ float c_inv_freq[32] = {1.000000000e+00f, 7.498942018e-01f, 5.623413324e-01f, 4.216965139e-01f, 3.162277639e-01f, 2.371373773e-01f, 1.778279394e-01f, 1.333521456e-01f, 1.000000015e-01f, 7.498942316e-02f, 5.623413250e-02f, 4.216964915e-02f, 3.162277490e-02f, 2.371373773e-02f, 1.778279431e-02f, 1.333521400e-02f, 9.999999776e-03f, 7.498942316e-03f, 5.623413250e-03f, 4.216964822e-03f, 3.162277630e-03f, 2.371373819e-03f, 1.778279431e-03f, 1.333521446e-03f, 1.000000047e-03f, 7.498941850e-04f, 5.623413017e-04f, 4.216965172e-04f, 3.162277571e-04f, 2.371373703e-04f, 1.778279402e-04f, 1.333521504e-04f};
__device__ __forceinline__ float lg2_gamma(int h) {
    const float t[8] = {-4.580368961312e-02f, -2.272007650008e-02f, -1.131531322783e-02f, -5.646563141142e-03f, -2.820519062379e-03f, -1.409570254671e-03f, -7.046129765894e-04f, -3.522634716290e-04f};
    float r = t[0];
#pragma unroll
    for (int i = 1; i < 8; ++i) r = (h == i) ? t[i] : r;
    return r;
}

namespace pg8 {
constexpr int BM = 256, BK = 64, HALF = 128, HTB = HALF * BK * 2, STAGE_BYTES = 8 * HTB, NXCD = 8, WGM = 8;
__host__ __device__ __forceinline__ int lds_byte(int r, int c) { const int st = (r >> 4) * 2 + (c >> 5), rr = r & 15, cc = c & 31, ob = rr * 64 + cc * 2; return st * 1024 + (ob ^ (((ob >> 9) & 1) << 5)); }
__host__ __device__ __forceinline__ void stage_rc(int b, int& R, int& C) { const int st = b / 1024, sb = b % 1024, swz = sb ^ (((sb >> 9) & 1) << 5); R = (st >> 1) * 16 + swz / 64; C = (st & 1) * 32 + (swz % 64) / 2; }
__host__ __device__ __forceinline__ int perm32(int rho) { const int n = rho >> 4, i = rho & 15; return 8 * (i >> 2) + 4 * n + (i & 3); }

struct Unit { int pm, pn, aux; };

struct StaticOrder {
    static constexpr bool GATHER = false;
    int nM, nN, nwg, G, c; const char* A; const char* B; size_t tstep;
    __device__ void init(const void* A_, const void* B_, int M, int N, int K, int G_, int c_) { nM = M / BM; nN = N / BM; nwg = nM * nN; G = G_; c = c_; A = (const char*)A_; B = (const char*)B_; tstep = (size_t)BM * K * 2; }
    __device__ bool next(int i, Unit& u) const {
        const long L = (long)i * G + c; if (L >= nwg) return false;
        int wgid = (int)L; { const int q = nwg / NXCD, r = nwg % NXCD, xcd = wgid % NXCD, off = wgid / NXCD; wgid = (xcd < r ? xcd * (q + 1) : r * (q + 1) + (xcd - r) * q) + off; }
        const int nig = WGM * nN, gid = wgid / nig, fm = gid * WGM, gsz = (nM - fm) < WGM ? (nM - fm) : WGM;
        u.pm = fm + ((wgid % nig) % gsz); u.pn = (wgid % nig) / gsz; u.aux = 0; return true;
    }
    __device__ __forceinline__ void ptrs(const Unit& u, const char*& a, const char*& b) const { a = A + (size_t)u.pm * tstep; b = B + (size_t)u.pn * tstep; }
    __device__ __forceinline__ void goff(const Unit&, int, int, int, int, unsigned (&)[2][2]) const {}
};

#define PG8_SA(b, h) (((b) * 2 + (h)) * HTB)
#define PG8_SB(b, h) ((4 + (b) * 2 + (h)) * HTB)
#define PG8_GLDS(src, dstoff) __builtin_amdgcn_global_load_lds((const unsigned*)(src), (LAS unsigned*)(lds + (dstoff)), 16, 0, 0)
#define PG8_STAGE_B(bufoff, gbase, h) do { _Pragma("unroll") for (int _i = 0; _i < 2; ++_i) PG8_GLDS((gbase) + (size_t)(h) * hstep + voffB[_i], (bufoff) + ldsw + _i * 8192); } while (0)
#define PG8_STAGE_A(bufoff, gbase, h) do { if constexpr (Sched::GATHER) { _Pragma("unroll") for (int _i = 0; _i < 2; ++_i) PG8_GLDS((gbase) + vg[h][_i], (bufoff) + ldsw + _i * 8192); } \
        else { _Pragma("unroll") for (int _i = 0; _i < 2; ++_i) PG8_GLDS((gbase) + (size_t)(h) * hstep + voffA[_i], (bufoff) + ldsw + _i * 8192); } } while (0)
#define PG8_LDA(dst, b, h) do { _Pragma("unroll") for (int m = 0; m < 4; ++m) _Pragma("unroll") for (int k = 0; k < 2; ++k) dst[m][k] = *(const LAS bf16x8*)(lds + PG8_SA(b, h) + aoff + m * 2048 + k * 1024); } while (0)
#define PG8_LDB(dst, b, h) do { _Pragma("unroll") for (int n = 0; n < 2; ++n) _Pragma("unroll") for (int k = 0; k < 2; ++k) dst[n][k] = *(const LAS bf16x8*)(lds + PG8_SB(b, h) + boff + n * 2048 + k * 1024); } while (0)
#define PG8_MMA(ai, bj, At, Bt) do { __builtin_amdgcn_s_setprio(1); _Pragma("unroll") for (int m = 0; m < 4; ++m) _Pragma("unroll") for (int n = 0; n < 2; ++n) _Pragma("unroll") for (int k = 0; k < 2; ++k) \
        acc[ai][bj][m][n] = __builtin_amdgcn_mfma_f32_16x16x32_bf16(Bt[n][k], At[m][k], acc[ai][bj][m][n], 0, 0, 0); __builtin_amdgcn_s_setprio(0); } while (0)
#define PG8_WAIT_V(n) asm volatile("s_waitcnt vmcnt(" #n ")" ::: "memory")
#define PG8_WAIT_L(n) asm volatile("s_waitcnt lgkmcnt(" #n ")" ::: "memory")
#define PG8_BAR __builtin_amdgcn_s_barrier()
#define PG8_SCHED __builtin_amdgcn_sched_barrier(0)

template <class Epi, class Sched>
__device__ __forceinline__ void gemm_phase(LAS unsigned char* lds, const int K, const Sched& S, const Epi& E) {
    const int tid = threadIdx.x, wid = __builtin_amdgcn_readfirstlane(tid >> 6), lane = tid & 63, wr = wid >> 2, wc = wid & 3, fr = lane & 15, fq = lane >> 4;
    const int nt = K / BK;
    unsigned voffA[2], voffB[2]; int Rr[2], Cc[2];
#pragma unroll
    for (int i = 0; i < 2; ++i) { int R, C; stage_rc(tid * 16 + i * 8192, R, C); const int Rb = (R & ~31) + perm32(R & 31); Rr[i] = R; Cc[i] = C;
        voffA[i] = (unsigned)(R * K + C) * 2u; voffB[i] = (unsigned)(Rb * K + C) * 2u; }
    const size_t kstep = (size_t)(BK * 2);
    const size_t hstep = (size_t)HALF * K * 2;
    const unsigned ldsw = (unsigned)wid * 1024u;
    const int aoff = lds_byte(wr * 64 + fr, fq * 8), boff = lds_byte(wc * 32 + fr, fq * 8);
    Unit cur, nxt; int ui = 0;
    if (!S.next(0, cur)) return;
    f32x4 acc[2][2][4][2];
#pragma unroll
    for (int a = 0; a < 2; ++a)
#pragma unroll
        for (int b = 0; b < 2; ++b)
#pragma unroll
            for (int m = 0; m < 4; ++m)
#pragma unroll
                for (int n = 0; n < 2; ++n) acc[a][b][m][n] = (f32x4){0.f, 0.f, 0.f, 0.f};
    bf16x8 At[4][2], B0[2][2], B1[2][2];
    const char *cA, *cB; S.ptrs(cur, cA, cB);
    unsigned vg[2][2] = {{0u, 0u}, {0u, 0u}}, vn[2][2] = {{0u, 0u}, {0u, 0u}};
    if constexpr (Sched::GATHER) S.goff(cur, Rr[0], Rr[1], Cc[0], Cc[1], vg);
    PG8_STAGE_B(PG8_SB(0, 0), cB, 0); PG8_STAGE_B(PG8_SB(0, 1), cB, 1); PG8_STAGE_A(PG8_SA(0, 0), cA, 0); PG8_STAGE_A(PG8_SA(0, 1), cA, 1);
    if (wr == 1) PG8_BAR;
    PG8_WAIT_V(2); PG8_BAR;
    PG8_STAGE_B(PG8_SB(1, 0), cB + kstep, 0); PG8_STAGE_A(PG8_SA(1, 0), cA + kstep, 0); PG8_STAGE_B(PG8_SB(1, 1), cB + kstep, 1);
    PG8_WAIT_V(6); PG8_BAR;
    for (;;) {
        const bool has_next = S.next(ui + 1, nxt);
        const char *nA = cA, *nB = cB; if (has_next) S.ptrs(nxt, nA, nB);
        if constexpr (Sched::GATHER) {
#pragma unroll
            for (int h = 0; h < 2; ++h)
#pragma unroll
                for (int i = 0; i < 2; ++i) vn[h][i] = vg[h][i];
            if (has_next) S.goff(nxt, Rr[0], Rr[1], Cc[0], Cc[1], vn);
        }
        for (int t = 0; t < nt; t += 2) {
            const bool last = (t == nt - 2);
            const char* a1 = cA + (size_t)(t + 1) * kstep;
            const char* a2 = last ? nA : cA + (size_t)(t + 2) * kstep; const char* b2 = last ? nB : cB + (size_t)(t + 2) * kstep;
            const char* a3 = a2 + kstep; const char* b3 = b2 + kstep;
            PG8_LDB(B0, 0, 0); PG8_LDB(B1, 0, 1); PG8_SCHED; PG8_LDA(At, 0, 0); PG8_STAGE_A(PG8_SA(1, 1), a1, 1);
            if constexpr (Sched::GATHER) { if (last) {
#pragma unroll
                for (int h = 0; h < 2; ++h)
#pragma unroll
                    for (int i = 0; i < 2; ++i) vg[h][i] = vn[h][i]; } }
            PG8_WAIT_V(8); PG8_WAIT_L(0); PG8_BAR; PG8_MMA(0, 0, At, B0); PG8_MMA(0, 1, At, B1); PG8_BAR; PG8_SCHED;
            PG8_LDA(At, 0, 1); PG8_STAGE_B(PG8_SB(0, 0), b2, 0); PG8_STAGE_B(PG8_SB(0, 1), b2, 1); PG8_STAGE_A(PG8_SA(0, 0), a2, 0);
            PG8_WAIT_V(8); PG8_WAIT_L(0); PG8_BAR; PG8_MMA(1, 0, At, B0); PG8_MMA(1, 1, At, B1); PG8_BAR; PG8_SCHED;
            PG8_LDB(B0, 1, 0); PG8_LDB(B1, 1, 1); PG8_SCHED; PG8_LDA(At, 1, 0); PG8_STAGE_A(PG8_SA(0, 1), a2, 1);
            PG8_WAIT_V(8); PG8_WAIT_L(0); PG8_BAR; PG8_MMA(0, 0, At, B0); PG8_MMA(0, 1, At, B1); PG8_BAR; PG8_SCHED;
            PG8_LDA(At, 1, 1); PG8_STAGE_B(PG8_SB(1, 0), b3, 0); PG8_STAGE_B(PG8_SB(1, 1), b3, 1); PG8_STAGE_A(PG8_SA(1, 0), a3, 0);
            PG8_WAIT_V(8); PG8_WAIT_L(0); PG8_BAR; PG8_MMA(1, 0, At, B0); PG8_MMA(1, 1, At, B1); PG8_BAR; PG8_SCHED;
        }
        if (wr == 0) PG8_BAR;
        E(acc, cur, wr, wc, fr, fq);
        if (!has_next) break;
#pragma unroll
        for (int a = 0; a < 2; ++a)
#pragma unroll
            for (int b = 0; b < 2; ++b)
#pragma unroll
                for (int m = 0; m < 4; ++m)
#pragma unroll
                    for (int n = 0; n < 2; ++n) acc[a][b][m][n] = (f32x4){0.f, 0.f, 0.f, 0.f};
        cur = nxt; cA = nA; cB = nB; ++ui;
        if (wr == 1) PG8_BAR;
    }
    PG8_WAIT_V(0);
    PG8_BAR;
}
}
using pg8::Unit;
typedef f32x4 Acc[2][2][4][2];

#define XB_TMO      128
#define XB_XCNT(j)  (256  + 64 * (j))
#define XB_XSUB(j)  (1280 + 64 * (j))
#define XB_XGEN(j)  (2304 + 64 * (j))
#define XB_TOP      3328
#define XB_TOPGEN   3392
#define XCD_BAR_WORDS 3456
#define XB_SPIN_CAP (1u << 18)
__device__ __forceinline__ unsigned xb_ld(unsigned* p)              { return __hip_atomic_load(p, __ATOMIC_RELAXED, __HIP_MEMORY_SCOPE_AGENT); }
__device__ __forceinline__ unsigned xb_add(unsigned* p, unsigned v) { return __hip_atomic_fetch_add(p, v, __ATOMIC_RELAXED, __HIP_MEMORY_SCOPE_AGENT); }
__device__ __forceinline__ unsigned xb_xcc_id() { return (unsigned)__builtin_amdgcn_s_getreg((3 << 11) | 20) & 0xFu; }
#define XB_SPIN(cond, bar) do { unsigned _sp = 0; while (cond) { __builtin_amdgcn_s_sleep(1); \
    if ((++_sp & 255u) == 0u) { if (xb_ld(&(bar)[XB_TMO])) break; if (_sp > XB_SPIN_CAP) { atomicAdd(&(bar)[XB_TMO], 1u); break; } } } } while (0)
struct XcdBarrier { unsigned* bar; unsigned x; volatile LAS unsigned* st; };
__device__ __forceinline__ XcdBarrier xcd_barrier_post(unsigned* bar, volatile LAS unsigned* st) {
    XcdBarrier b; b.bar = bar; b.x = xb_xcc_id(); b.st = st;
    if (threadIdx.x == 0) (void)xb_add(&bar[XB_XCNT(b.x)], 1u);
    return b;
}
__device__ __forceinline__ void xcd_barrier_complete(unsigned* bar, unsigned x, unsigned& nloc, unsigned& nx) {
    const unsigned G = gridDim.x * gridDim.y * gridDim.z;
    unsigned sum, cnt, mine, sp = 0u;
    for (;;) {
        sum = 0u; cnt = 0u; mine = 0u;
#pragma unroll
        for (unsigned j = 0; j < 16; ++j) { const unsigned c = xb_ld(&bar[XB_XCNT(j)]); sum += c; cnt += (c > 0u) ? 1u : 0u; mine = (j == x) ? c : mine; }
        if (sum == G) break;
        __builtin_amdgcn_s_sleep(1);
        if ((++sp & 255u) == 0u) { if (xb_ld(&bar[XB_TMO])) break; if (sp > XB_SPIN_CAP) { atomicAdd(&bar[XB_TMO], 1u); break; } }
    }
    nloc = mine > 0u ? mine : 1u; nx = cnt > 0u ? cnt : 1u;
}
__device__ __forceinline__ void xcd_barrier(const XcdBarrier& b) {
    asm volatile("s_waitcnt vmcnt(0)" ::: "memory");
    __syncthreads();
    if (threadIdx.x == 0) {
        unsigned* bar = b.bar;
        __builtin_amdgcn_s_waitcnt(0);
        unsigned nloc = b.st[0], nx = b.st[1];
        if (nloc == 0u) { xcd_barrier_complete(bar, b.x, nloc, nx); b.st[0] = nloc; b.st[1] = nx; }
        const unsigned old = xb_add(&bar[XB_XSUB(b.x)], 1u);
        const unsigned gen = old / nloc;
        if (old + 1u == (gen + 1u) * nloc) {
            __builtin_amdgcn_fence(__ATOMIC_RELEASE, "agent");
            asm volatile("s_waitcnt vmcnt(0)" ::: "memory");
            const unsigned og = xb_add(&bar[XB_TOP], 1u);
            const unsigned tg = og / nx;
            if (og + 1u == (tg + 1u) * nx) xb_add(&bar[XB_TOPGEN], 1u);
            else XB_SPIN(xb_ld(&bar[XB_TOPGEN]) == tg, bar);
            __builtin_amdgcn_fence(__ATOMIC_ACQUIRE, "agent");
            xb_add(&bar[XB_XGEN(b.x)], 1u);
            asm volatile("s_waitcnt vmcnt(0)" ::: "memory");
        } else {
            XB_SPIN(xb_ld(&bar[XB_XGEN(b.x)]) == gen, bar);
            __builtin_amdgcn_fence(__ATOMIC_ACQUIRE, "agent");
            asm volatile("s_waitcnt vmcnt(0)" ::: "memory");
        }
    }
    __syncthreads();
}

struct Args { const float* in[22]; float* out; unsigned char* ws; int ph_lo, ph_hi; };
struct Frame {
    LAS unsigned char* lds;
    int tid, lane, wave, vcu, G;
    const float* in[22]; unsigned char* ws; unsigned char* out;
};
enum { I_X = 0, I_P, I_GMIX, I_WIN, I_CONVW, I_GRET, I_WOC, I_WOR, I_WO, I_GMOE, I_WRG, I_BRG, I_WRE, I_BRE, I_WG, I_WU, I_WD, I_GPIN, I_WPG, I_WPP, I_GPOST, I_GFIN };

__device__ __forceinline__ void p0_transpose_item(const float* W, int ldw, const float* g, bf16* WT, int ldt, int k0, int n0, int drow, LAS float* scr, int lane) {
#pragma unroll 8
    for (int i = 0; i < 32; ++i) { const int kk = 2 * i + (lane >> 5); float v = W[(size_t)(k0 + kk) * ldw + n0 + (lane & 31)]; if (g) v *= g[k0 + kk]; scr[kk * 33 + (lane & 31)] = v; }
    asm volatile("s_waitcnt lgkmcnt(0)" ::: "memory");
    const int c = lane & 7;
#pragma unroll
    for (int j = 0; j < 4; ++j) { const int n = (lane >> 3) + 8 * j; const LAS float* s = scr + (8 * c) * 33 + n;
        u32x4 o; o.x = cvt_pk_bf16(s[0 * 33], s[1 * 33]); o.y = cvt_pk_bf16(s[2 * 33], s[3 * 33]); o.z = cvt_pk_bf16(s[4 * 33], s[5 * 33]); o.w = cvt_pk_bf16(s[6 * 33], s[7 * 33]);
        *(GAS u32x4*)(WT + (size_t)(drow + n) * ldt + k0 + 8 * c) = o; }
    asm volatile("s_waitcnt lgkmcnt(0)" ::: "memory");
}
__device__ __forceinline__ int win_drow(int n0) {
    if (n0 < 1024) return 256 * (n0 >> 7) + (n0 & 127);
    if (n0 < 2048) { const int c = n0 - 1024; return 256 * (c >> 7) + 128 + (c & 127); }
    if (n0 < 3072) return n0;
    if (n0 < 4096) { const int j = (n0 - 3072) & 511, isk = (n0 - 3072) >> 9, head = j >> 6, d = j & 63;
        return 3072 + isk * 512 + 256 * (head >> 2) + ((d < 32) ? 32 * (head & 3) + d : 128 + 32 * (head & 3) + (d - 32)); }
    return n0;
}
__device__ __forceinline__ void sincos_acc(float angf, float& s, float& c) {
    const double a = (double)angf;
    const double kq = __builtin_rint(a * 0.63661977236758134308);
    double r = __builtin_fma(-kq, 1.5707963267948966, a); r = __builtin_fma(-kq, 6.123233995736766e-17, r);
    const double r2 = r * r;
    const double sp = r * (1.0 + r2 * (-1.0 / 6 + r2 * (1.0 / 120 + r2 * (-1.0 / 5040 + r2 * (1.0 / 362880 + r2 * (-1.0 / 39916800 + r2 * (1.0 / 6227020800.0)))))));
    const double cp = 1.0 + r2 * (-0.5 + r2 * (1.0 / 24 + r2 * (-1.0 / 720 + r2 * (1.0 / 40320 + r2 * (-1.0 / 3628800 + r2 * (1.0 / 479001600.0 + r2 * (-1.0 / 87178291200.0)))))));
    const int q = ((int)(long long)kq) & 3;
    const double ss = (q == 0) ? sp : (q == 1) ? cp : (q == 2) ? -sp : -cp;
    const double cc = (q == 0) ? cp : (q == 1) ? -sp : (q == 2) ? -cp : sp;
    s = (float)ss; c = (float)cc;
}
__device__ __forceinline__ void p0_prologue(Frame& F) {
    LAS float* scr = (LAS float*)(F.lds + F.wave * 16384);
    const int gw = F.vcu * NWAVES + F.wave, NGW = F.G * NWAVES, lane = F.lane;
    unsigned char* ws = F.ws;
    constexpr int I0 = 4096, I1 = 512, I5 = 128, I6 = 8192;
    constexpr int NITEMS = I0 + 4 * I1 + I5 + 3 * I6;
    for (int it = gw; it < NITEMS; it += NGW) {
        int r = it;
        if (r < I0) { const int kb = r >> 8, nb = r & 255; p0_transpose_item(F.in[I_WIN], NIN, F.in[I_GMIX], (bf16*)(ws + W_IN), D, 64 * kb, 32 * nb, win_drow(32 * nb), scr, lane); continue; } r -= I0;
        if (r < I1) { p0_transpose_item(F.in[I_WOC], D, nullptr, (bf16*)(ws + W_OC), D, 64 * (r >> 5), 32 * (r & 31), 32 * (r & 31), scr, lane); continue; } r -= I1;
        if (r < I1) { p0_transpose_item(F.in[I_WOR], D, nullptr, (bf16*)(ws + W_OR), D, 64 * (r >> 5), 32 * (r & 31), 32 * (r & 31), scr, lane); continue; } r -= I1;
        if (r < I1) { p0_transpose_item(F.in[I_WO], D, nullptr, (bf16*)(ws + W_O), D, 64 * (r >> 5), 32 * (r & 31), 32 * (r & 31), scr, lane); continue; } r -= I1;
        if (r < I1) { p0_transpose_item(F.in[I_WPG], D, F.in[I_GPIN], (bf16*)(ws + W_PG), D, 64 * (r >> 5), 32 * (r & 31), 32 * (r & 31), scr, lane); continue; } r -= I1;
        if (r < I5) { p0_transpose_item(F.in[I_WPP], D, nullptr, (bf16*)(ws + W_PP), PLE, 64 * (r >> 5), 32 * (r & 31), 32 * (r & 31), scr, lane); continue; } r -= I5;
        if (r < I6) { const int e = r >> 8, q = r & 255, kb = q >> 4, nb = q & 15, n0 = 32 * nb;
            p0_transpose_item(F.in[I_WG] + (size_t)e * D * DE, DE, F.in[I_GMOE], (bf16*)(ws + W_GU) + (size_t)e * 1024 * 1024, D, 64 * kb, n0, 256 * (n0 >> 7) + (n0 & 127), scr, lane); continue; } r -= I6;
        if (r < I6) { const int e = r >> 8, q = r & 255, kb = q >> 4, nb = q & 15, n0 = 32 * nb;
            p0_transpose_item(F.in[I_WU] + (size_t)e * D * DE, DE, F.in[I_GMOE], (bf16*)(ws + W_GU) + (size_t)e * 1024 * 1024, D, 64 * kb, n0, 256 * (n0 >> 7) + 128 + (n0 & 127), scr, lane); continue; } r -= I6;
        { const int e = r >> 8, q = r & 255, kb = q >> 5, nb = q & 31;
            p0_transpose_item(F.in[I_WD] + (size_t)e * DE * D, D, nullptr, (bf16*)(ws + W_DN) + (size_t)e * 1024 * 512, DE, 64 * kb, 32 * nb, 32 * nb, scr, lane); }
    }
    const int gt = F.vcu * NTHR + F.tid, NGT = F.G * NTHR;
    for (int it = gt; it < 256 * 128; it += NGT) {
        const int row = it >> 7, k0 = (it & 127) * 8; float v[8];
#pragma unroll
        for (int j = 0; j < 8; ++j) { const int k = k0 + j; float x = 0.f;
            if (row < 32) x = F.in[I_WRE][(size_t)k * NE + row] * F.in[I_GMOE][k];
            else if (row >= 128 && row < 132) x = F.in[I_WRG][(size_t)k * 4 + (row - 128)] * F.in[I_GMOE][k];
            v[j] = x; }
        u32x4 o; o.x = cvt_pk_bf16(v[0], v[1]); o.y = cvt_pk_bf16(v[2], v[3]); o.z = cvt_pk_bf16(v[4], v[5]); o.w = cvt_pk_bf16(v[6], v[7]);
        *(GAS u32x4*)((bf16*)(ws + W_R) + (size_t)row * D + k0) = o;
    }
    for (int it = gt; it < SEQ * 32; it += NGT) {
        const int pos = it >> 5, i = it & 31; float s, c; sincos_acc(__fmul_rn((float)pos, c_inv_freq[i]), s, c);
        ((GAS f32x2*)(ws + WS_ROPE))[it] = (f32x2){c, s};
    }
    { const float* p = F.in[I_P]; bf16* pb = (bf16*)(ws + WS_PB);
      for (size_t it = gt; it < (size_t)T * PLE / 8; it += NGT) { const f32x4 a = ((const GAS f32x4*)p)[2 * it], b = ((const GAS f32x4*)p)[2 * it + 1]; ((GAS u32x4*)pb)[it] = pack8(a, b); } }
    { const float* x = F.in[I_X]; bf16* xh = (bf16*)(ws + WS_A);
      for (int m = gw; m < T; m += NGW) {
          const GAS f32x4* xr = (const GAS f32x4*)(x + (size_t)m * D) + lane; f32x4 v[4]; float s = 0.f;
#pragma unroll
          for (int j = 0; j < 4; ++j) { v[j] = xr[64 * j]; s += (v[j].x * v[j].x + v[j].y * v[j].y) + (v[j].z * v[j].z + v[j].w * v[j].w); }
          const float rstd = 1.0f / sqrtf(wave_sum(s) * (1.f / D) + EPS);
          GAS u32x2* o8 = (GAS u32x2*)(xh + (size_t)m * D) + lane;
#pragma unroll
          for (int j = 0; j < 4; ++j) { u32x2 o; o.x = cvt_pk_bf16(v[j].x * rstd, v[j].y * rstd); o.y = cvt_pk_bf16(v[j].z * rstd, v[j].w * rstd); o8[64 * j] = o; }
      } }
}

struct EpiG1 {
    bf16 *cu, *bg, *q, *k, *v, *sg, *mc, *mr; const f32x2* rope;
    template <int ACT> __device__ __forceinline__ void plain(const Acc& acc, bf16* dst, int row0, int col0) const {
#pragma unroll
        for (int ai = 0; ai < 2; ++ai)
#pragma unroll
            for (int m = 0; m < 4; ++m) { bf16* rowp = dst + (size_t)(row0 + ai * 128 + m * 16) * D + col0;
#pragma unroll
                for (int bj = 0; bj < 2; ++bj) { f32x4 v0 = acc[ai][bj][m][0], v1 = acc[ai][bj][m][1];
                    if (ACT == 1) {
#pragma unroll
                        for (int j = 0; j < 4; ++j) { v0[j] = siluf_(v0[j]); v1[j] = siluf_(v1[j]); } }
                    if (ACT == 2) {
#pragma unroll
                        for (int j = 0; j < 4; ++j) { v0[j] = sigmoidf_(v0[j]); v1[j] = sigmoidf_(v1[j]); } }
                    *(GAS u32x4*)(rowp + bj * 128) = pack8(v0, v1); } }
    }
    __device__ __forceinline__ void operator()(const Acc& acc, const Unit& u, int wr, int wc, int fr, int fq) const {
        const int row0 = u.pm * 256 + wr * 64 + fr, pn = u.pn, cl = wc * 32 + 8 * fq;
        if (pn < 8) {
#pragma unroll
            for (int ai = 0; ai < 2; ++ai)
#pragma unroll
                for (int m = 0; m < 4; ++m) { bf16* rowp = cu + (size_t)(row0 + ai * 128 + m * 16) * D + pn * 128 + cl;
                    *(GAS u32x4*)rowp = pack8(acc[ai][0][m][0] * acc[ai][1][m][0], acc[ai][0][m][1] * acc[ai][1][m][1]); }
        } else if (pn < 12) plain<0>(acc, bg, row0, (pn - 8) * 256 + cl);
        else if (pn < 16) {
            const bool isk = pn >= 14; const int head = ((pn - 12) & 1) * 4 + wc; bf16* dst = isk ? k : q;
            const float lg = lg2_gamma(head);
#pragma unroll
            for (int ai = 0; ai < 2; ++ai)
#pragma unroll
                for (int m = 0; m < 4; ++m) { const int r = row0 + ai * 128 + m * 16, pos = r & (SEQ - 1); const float e = (float)((pos & (CH - 1)) + 1) * lg;
                    const float sc = isk ? 0.125f * exp2f(-e) : exp2f(e);
                    const GAS f32x4* rp = (const GAS f32x4*)(rope + (size_t)pos * 32 + 8 * fq);
                    f32x4 o1[2], o2[2];
#pragma unroll
                    for (int n = 0; n < 2; ++n) { const f32x4 cs0 = rp[2 * n], cs1 = rp[2 * n + 1];
                        const f32x4 a = acc[ai][0][m][n], b = acc[ai][1][m][n];
                        o1[n] = (f32x4){(a[0] * cs0[0] - b[0] * cs0[1]) * sc, (a[1] * cs0[2] - b[1] * cs0[3]) * sc, (a[2] * cs1[0] - b[2] * cs1[1]) * sc, (a[3] * cs1[2] - b[3] * cs1[3]) * sc};
                        o2[n] = (f32x4){(a[0] * cs0[1] + b[0] * cs0[0]) * sc, (a[1] * cs0[3] + b[1] * cs0[2]) * sc, (a[2] * cs1[1] + b[2] * cs1[0]) * sc, (a[3] * cs1[3] + b[3] * cs1[2]) * sc}; }
                    bf16* rowp = dst + (size_t)r * 512 + head * 64 + 8 * fq;
                    *(GAS u32x4*)rowp = pack8(o1[0], o1[1]); *(GAS u32x4*)(rowp + 32) = pack8(o2[0], o2[1]); }
        } else if (pn < 20) plain<0>(acc, v, row0, (pn - 16) * 256 + cl);
        else if (pn < 24) plain<1>(acc, sg, row0, (pn - 20) * 256 + cl);
        else if (pn < 28) plain<2>(acc, mc, row0, (pn - 24) * 256 + cl);
        else plain<2>(acc, mr, row0, (pn - 28) * 256 + cl);
    }
};
struct EpiGate {
    const bf16* gate; const bf16* prev; bf16* out; int mode;
    __device__ __forceinline__ void operator()(const Acc& acc, const Unit& u, int wr, int wc, int fr, int fq) const {
        const int row0 = u.pm * 256 + wr * 64 + fr, col0 = u.pn * 256 + wc * 32 + 8 * fq;
#pragma unroll
        for (int ai = 0; ai < 2; ++ai)
#pragma unroll
            for (int m = 0; m < 4; ++m) { const size_t ro = (size_t)(row0 + ai * 128 + m * 16) * D + col0;
#pragma unroll
                for (int bj = 0; bj < 2; ++bj) { f32x4 g0, g1; unpack8(*(const GAS u32x4*)(gate + ro + bj * 128), g0, g1);
                    f32x4 v0 = acc[ai][bj][m][0] * g0, v1 = acc[ai][bj][m][1] * g1;
                    if (mode) { f32x4 p0, p1; unpack8(*(const GAS u32x4*)(prev + ro + bj * 128), p0, p1); v0 += p0; v1 += p1; }
                    *(GAS u32x4*)(out + ro + bj * 128) = pack8(v0, v1); } }
    }
};
struct EpiRes {
    const float* x; float* x1; bf16* xb1; float* ssq;
    __device__ __forceinline__ void operator()(const Acc& acc, const Unit& u, int wr, int wc, int fr, int fq) const {
        const int row0 = u.pm * 256 + wr * 64 + fr, col0 = u.pn * 256 + wc * 32 + 8 * fq;
#pragma unroll
        for (int ai = 0; ai < 2; ++ai)
#pragma unroll
            for (int m = 0; m < 4; ++m) { const int r = row0 + ai * 128 + m * 16; const size_t ro = (size_t)r * D + col0; float s = 0.f;
#pragma unroll
                for (int bj = 0; bj < 2; ++bj) { const GAS f32x4* xp = (const GAS f32x4*)(x + ro + bj * 128);
                    const f32x4 v0 = xp[0] + acc[ai][bj][m][0], v1 = xp[1] + acc[ai][bj][m][1];
                    GAS f32x4* op = (GAS f32x4*)(x1 + ro + bj * 128); op[0] = v0; op[1] = v1;
                    *(GAS u32x4*)(xb1 + ro + bj * 128) = pack8(v0, v1);
                    s += (v0[0] * v0[0] + v0[1] * v0[1]) + (v0[2] * v0[2] + v0[3] * v0[3]) + (v1[0] * v1[0] + v1[1] * v1[1]) + (v1[2] * v1[2] + v1[3] * v1[3]); }
                s += __shfl_xor(s, 16); s += __shfl_xor(s, 32);
                if (fq == 0) ssq[(size_t)r * 16 + u.pn * 4 + wc] = s; }
    }
};
struct EpiRoute {
    const float* ssq; const float* brg; const float* bre; u32x4* route; float* rstd2;
    __device__ __forceinline__ void operator()(const Acc& acc, const Unit& u, int wr, int wc, int fr, int fq) const {
        if (wc != 0) return;
        const int row0 = u.pm * 256 + wr * 64 + fr;
        float be[8], bg4[4];
#pragma unroll
        for (int j = 0; j < 8; ++j) be[j] = bre[8 * fq + j];
#pragma unroll
        for (int j = 0; j < 4; ++j) bg4[j] = brg[j];
#pragma unroll
        for (int ai = 0; ai < 2; ++ai)
#pragma unroll
            for (int m = 0; m < 4; ++m) { const int r = row0 + ai * 128 + m * 16;
                const f32x4 pq = *(const GAS f32x4*)(ssq + (size_t)r * 16 + 4 * fq); float s = (pq[0] + pq[1]) + (pq[2] + pq[3]);
                s += __shfl_xor(s, 16); s += __shfl_xor(s, 32);
                const float rs = 1.0f / sqrtf(s * (1.f / D) + EPS);
                float el[8], gl[4];
#pragma unroll
                for (int j = 0; j < 8; ++j) el[j] = acc[ai][0][m][j >> 2][j & 3] * rs + be[j];
#pragma unroll
                for (int j = 0; j < 4; ++j) gl[j] = __shfl(acc[ai][1][m][0][j] * rs + bg4[j], fr);
                int grp = 0; float best = gl[0];
#pragma unroll
                for (int j = 1; j < 4; ++j) if (gl[j] > best) { best = gl[j]; grp = j; }
                float den = 0.f;
#pragma unroll
                for (int j = 0; j < 4; ++j) den += __expf(gl[j] - best);
                const float gw = 1.0f / den;
                int i1 = 0; float l1 = el[0];
#pragma unroll
                for (int j = 1; j < 8; ++j) if (el[j] > l1) { l1 = el[j]; i1 = j; }
                int i2 = -1; float l2 = -3.0e38f;
#pragma unroll
                for (int j = 0; j < 8; ++j) if (j != i1 && el[j] > l2) { l2 = el[j]; i2 = j; }
                const float w0 = 1.0f / (1.0f + __expf(l2 - l1)), w1 = 1.0f - w0;
                if (fq == grp) { u32x4 o; o.x = (unsigned)(grp * 8 + i1); o.y = (unsigned)(grp * 8 + i2); o.z = __float_as_uint(w0 * gw); o.w = __float_as_uint(w1 * gw);
                    *(GAS u32x4*)(route + r) = o; rstd2[r] = rs; } }
    }
};
template <bool GATH> struct MoeSched {
    static constexpr bool GATHER = GATH;
    const LAS int* tb; const LAS int* cn; const u32x2* lists; const char* A; const char* B; size_t bstride; int K, G, c;
    __device__ bool next(int i, Unit& u) const {
        const int U = i * G + c; if (U >= tb[32] * 4) return false;
        const int rt = U >> 2; int e = 0; while (e < 31 && tb[e + 1] <= rt) ++e;
        u.pm = rt; u.pn = U & 3; u.aux = e; return true;
    }
    __device__ __forceinline__ void ptrs(const Unit& u, const char*& a, const char*& b) const {
        a = GATH ? A : A + (size_t)u.pm * 256 * K * 2; b = B + (size_t)u.aux * bstride + (size_t)u.pn * 256 * K * 2; }
    __device__ __forceinline__ void goff(const Unit& u, int R0, int R1, int C0, int C1, unsigned (&vo)[2][2]) const {
        const int e = u.aux, n = cn[e], base = (u.pm - tb[e]) * 256; const u32x2* L = lists + (size_t)e * T;
#pragma unroll
        for (int h = 0; h < 2; ++h) { const int i0 = base + 128 * h + R0, i1 = base + 128 * h + R1;
            const unsigned t0 = (i0 < n) ? (L[i0].x >> 1) : 0u, t1 = (i1 < n) ? (L[i1].x >> 1) : 0u;
            vo[h][0] = (t0 * (unsigned)D + (unsigned)C0) * 2u; vo[h][1] = (t1 * (unsigned)D + (unsigned)C1) * 2u; }
    }
};
struct EpiHid {
    const LAS int* tb; const LAS int* cn; const u32x2* lists; const float* rstd2; bf16* hid;
    __device__ __forceinline__ void operator()(const Acc& acc, const Unit& u, int wr, int wc, int fr, int fq) const {
        const int e = u.aux, n = cn[e], base = (u.pm - tb[e]) * 256; const u32x2* L = lists + (size_t)e * T;
#pragma unroll
        for (int ai = 0; ai < 2; ++ai)
#pragma unroll
            for (int m = 0; m < 4; ++m) { const int rl = ai * 128 + wr * 64 + m * 16 + fr, idx = base + rl;
                float rs = 0.f; if (idx < n) rs = rstd2[L[idx].x >> 1];
                f32x4 h0, h1;
#pragma unroll
                for (int j = 0; j < 4; ++j) { h0[j] = siluf_(rs * acc[ai][0][m][0][j]) * (rs * acc[ai][1][m][0][j]); h1[j] = siluf_(rs * acc[ai][0][m][1][j]) * (rs * acc[ai][1][m][1][j]); }
                *(GAS u32x4*)(hid + (size_t)(u.pm * 256 + rl) * DE + u.pn * 128 + wc * 32 + 8 * fq) = pack8(h0, h1); }
    }
};
struct EpiDown {
    const LAS int* tb; const LAS int* cn; const u32x2* lists; bf16* Y;
    __device__ __forceinline__ void operator()(const Acc& acc, const Unit& u, int wr, int wc, int fr, int fq) const {
        const int e = u.aux, n = cn[e], base = (u.pm - tb[e]) * 256; const u32x2* L = lists + (size_t)e * T;
#pragma unroll
        for (int ai = 0; ai < 2; ++ai)
#pragma unroll
            for (int m = 0; m < 4; ++m) { const int idx = base + ai * 128 + wr * 64 + m * 16 + fr;
                if (idx < n) { const u32x2 en = L[idx]; const float w = __uint_as_float(en.y);
                    bf16* rowp = Y + (size_t)(en.x & 1u) * T * D + (size_t)(en.x >> 1) * D + u.pn * 256 + wc * 32 + 8 * fq;
#pragma unroll
                    for (int bj = 0; bj < 2; ++bj) *(GAS u32x4*)(rowp + bj * 128) = pack8(acc[ai][bj][m][0] * w, acc[ai][bj][m][1] * w); } }
    }
};
struct EpiPP {
    bf16* pp; float* ssq;
    __device__ __forceinline__ void operator()(const Acc& acc, const Unit& u, int wr, int wc, int fr, int fq) const {
        const int row0 = u.pm * 256 + wr * 64 + fr, col0 = u.pn * 256 + wc * 32 + 8 * fq;
#pragma unroll
        for (int ai = 0; ai < 2; ++ai)
#pragma unroll
            for (int m = 0; m < 4; ++m) { const int r = row0 + ai * 128 + m * 16; float s = 0.f;
#pragma unroll
                for (int bj = 0; bj < 2; ++bj) { const f32x4 v0 = acc[ai][bj][m][0], v1 = acc[ai][bj][m][1];
                    *(GAS u32x4*)(pp + (size_t)r * D + col0 + bj * 128) = pack8(v0, v1);
                    s += (v0[0] * v0[0] + v0[1] * v0[1]) + (v0[2] * v0[2] + v0[3] * v0[3]) + (v1[0] * v1[0] + v1[1] * v1[1]) + (v1[2] * v1[2] + v1[3] * v1[3]); }
                s += __shfl_xor(s, 16); s += __shfl_xor(s, 32);
                if (fq == 0) ssq[(size_t)r * 16 + u.pn * 4 + wc] = s; }
    }
};
struct EpiPle {
    float* x2; const bf16* pp; const float* ssqp; const float* gpost; float* ssq3;
    __device__ __forceinline__ void operator()(const Acc& acc, const Unit& u, int wr, int wc, int fr, int fq) const {
        const int row0 = u.pm * 256 + wr * 64 + fr, col0 = u.pn * 256 + wc * 32 + 8 * fq;
#pragma unroll
        for (int ai = 0; ai < 2; ++ai)
#pragma unroll
            for (int m = 0; m < 4; ++m) { const int r = row0 + ai * 128 + m * 16; const size_t ro = (size_t)r * D + col0;
                const f32x4 pq = *(const GAS f32x4*)(ssqp + (size_t)r * 16 + 4 * fq); float sp = (pq[0] + pq[1]) + (pq[2] + pq[3]);
                sp += __shfl_xor(sp, 16); sp += __shfl_xor(sp, 32);
                const float rp = 1.0f / sqrtf(sp * (1.f / D) + EPS); float s = 0.f;
#pragma unroll
                for (int bj = 0; bj < 2; ++bj) { f32x4 p0, p1; unpack8(*(const GAS u32x4*)(pp + ro + bj * 128), p0, p1);
                    const GAS f32x4* gp = (const GAS f32x4*)(gpost + col0 + bj * 128); const f32x4 g0 = gp[0], g1 = gp[1];
                    GAS f32x4* xp = (GAS f32x4*)(x2 + ro + bj * 128); f32x4 v0 = xp[0], v1 = xp[1];
#pragma unroll
                    for (int j = 0; j < 4; ++j) { v0[j] += sigmoidf_(acc[ai][bj][m][0][j]) * (p0[j] * rp * g0[j]); v1[j] += sigmoidf_(acc[ai][bj][m][1][j]) * (p1[j] * rp * g1[j]); }
                    xp[0] = v0; xp[1] = v1;
                    s += (v0[0] * v0[0] + v0[1] * v0[1]) + (v0[2] * v0[2] + v0[3] * v0[3]) + (v1[0] * v1[0] + v1[1] * v1[1]) + (v1[2] * v1[2] + v1[3] * v1[3]); }
                s += __shfl_xor(s, 16); s += __shfl_xor(s, 32);
                if (fq == 0) ssq3[(size_t)r * 16 + u.pn * 4 + wc] = s; }
    }
};

__device__ __forceinline__ void conv_pass(Frame& F, const bf16* cu, const bf16* bg, bf16* ypre) {
    const int gw = F.vcu * NWAVES + F.wave, NGW = F.G * NWAVES, lane = F.lane;
    const float* cw = F.in[I_CONVW];
    for (int un = gw; un < (T / 64) * 2; un += NGW) {
        const int hc = un & 1, t0 = (un >> 1) * 64, ch = hc * 512 + lane * 8;
        f32x4 w0a = *(const GAS f32x4*)(cw + ch), w0b = *(const GAS f32x4*)(cw + ch + 4), w1a = *(const GAS f32x4*)(cw + D + ch), w1b = *(const GAS f32x4*)(cw + D + ch + 4),
              w2a = *(const GAS f32x4*)(cw + 2 * D + ch), w2b = *(const GAS f32x4*)(cw + 2 * D + ch + 4);
        f32x4 p2a = {0.f, 0.f, 0.f, 0.f}, p2b = p2a, p1a = p2a, p1b = p2a;
        if ((t0 & (SEQ - 1)) != 0) { unpack8(*(const GAS u32x4*)(cu + (size_t)(t0 - 2) * D + ch), p2a, p2b); unpack8(*(const GAS u32x4*)(cu + (size_t)(t0 - 1) * D + ch), p1a, p1b); }
#pragma unroll 4
        for (int i = 0; i < 64; ++i) { const size_t ro = (size_t)(t0 + i) * D + ch; f32x4 ca, cb, ba, bb;
            unpack8(*(const GAS u32x4*)(cu + ro), ca, cb); unpack8(*(const GAS u32x4*)(bg + ro), ba, bb);
            const f32x4 ya = ba * (w0a * p2a + w1a * p1a + w2a * ca), yb = bb * (w0b * p2b + w1b * p1b + w2b * cb);
            *(GAS u32x4*)(ypre + ro) = pack8(ya, yb);
            p2a = p1a; p2b = p1b; p1a = ca; p1b = cb; }
    }
}
__device__ __forceinline__ void state_scan(Frame& F, const bf16* kk, const bf16* vv, bf16* S) {
    LAS char* lds = (LAS char*)F.lds;
    constexpr int KST = 144, VST = 80, KBUF = 128 * KST, VBUF = 128 * VST;
    const int tid = F.tid, lane = F.lane, w = F.wave, g = lane >> 4, li = lane & 15, q4 = li >> 2, p4 = li & 3, vt = w >> 2, dt = w & 3;
    for (int un = blockIdx.x; un < 64 * 4; un += F.G) {
        const int bh = un >> 2, vq = un & 3, b = bh >> 3, h = bh & 7;
        const float g128 = exp2f(128.0f * lg2_gamma(h));
        f32x4 Sacc = {0.f, 0.f, 0.f, 0.f};
        __syncthreads();
        u32x4 rk[2], rv;
        { const size_t tok0 = (size_t)b * SEQ;
#pragma unroll
          for (int j = 0; j < 2; ++j) { const int piece = tid + 512 * j, row = piece >> 3, ch = piece & 7; rk[j] = *(const GAS u32x4*)(kk + (tok0 + row) * 512 + h * 64 + ch * 8); }
          { const int row = tid >> 2, ch = tid & 3; rv = *(const GAS u32x4*)(vv + (tok0 + row) * D + h * 128 + vq * 32 + ch * 8); }
#pragma unroll
          for (int j = 0; j < 2; ++j) { const int piece = tid + 512 * j, row = piece >> 3, ch = piece & 7; *(LAS u32x4*)(lds + row * KST + ch * 16) = rk[j]; }
          { const int row = tid >> 2, ch = tid & 3; *(LAS u32x4*)(lds + 2 * KBUF + row * VST + ch * 16) = rv; } }
        for (int c = 0; c < NCH; ++c) {
            { u32x2 o; o.x = cvt_pk_bf16(Sacc[0], Sacc[1]); o.y = cvt_pk_bf16(Sacc[2], Sacc[3]);
              *(GAS u32x2*)(S + ((size_t)(bh * NCH + c) * DK + 16 * dt + li) * DV + 32 * vq + 16 * vt + 4 * g) = o; }
            if (c == NCH - 1) break;
            const int cb = c & 1; const bool pre = (c + 1 < NCH - 1);
            if (pre) { const size_t tok0 = (size_t)b * SEQ + (size_t)(c + 1) * CH;
#pragma unroll
                for (int j = 0; j < 2; ++j) { const int piece = tid + 512 * j, row = piece >> 3, ch = piece & 7; rk[j] = *(const GAS u32x4*)(kk + (tok0 + row) * 512 + h * 64 + ch * 8); }
                { const int row = tid >> 2, ch = tid & 3; rv = *(const GAS u32x4*)(vv + (tok0 + row) * D + h * 128 + vq * 32 + ch * 8); } }
            __syncthreads();
            const LAS char* kb = lds + cb * KBUF; const LAS char* vb = lds + 2 * KBUF + cb * VBUF;
            f32x4 a4 = Sacc;
#pragma unroll
            for (int s = 0; s < 4; ++s) {
                const int r0 = 32 * s + 8 * g + q4;
                const s16x4 alo = tr_read(vb + r0 * VST + (16 * vt + 4 * p4) * 2), ahi = tr_read(vb + (r0 + 4) * VST + (16 * vt + 4 * p4) * 2);
                const s16x4 blo = tr_read(kb + r0 * KST + (16 * dt + 4 * p4) * 2), bhi = tr_read(kb + (r0 + 4) * KST + (16 * dt + 4 * p4) * 2);
                const bf16x8 af = __builtin_shufflevector(alo, ahi, 0, 1, 2, 3, 4, 5, 6, 7), bf = __builtin_shufflevector(blo, bhi, 0, 1, 2, 3, 4, 5, 6, 7);
                a4 = __builtin_amdgcn_mfma_f32_16x16x32_bf16(af, bf, a4, 0, 0, 0);
            }
            Sacc = a4 * g128;
            if (pre) { const int nb = cb ^ 1;
#pragma unroll
                for (int j = 0; j < 2; ++j) { const int piece = tid + 512 * j, row = piece >> 3, ch = piece & 7; *(LAS u32x4*)(lds + nb * KBUF + row * KST + ch * 16) = rk[j]; }
                { const int row = tid >> 2, ch = tid & 3; *(LAS u32x4*)(lds + 2 * KBUF + nb * VBUF + row * VST + ch * 16) = rv; } }
        }
    }
    __syncthreads();
}

__device__ __forceinline__ void ret_out(Frame& F, const bf16* qq, const bf16* kk, const bf16* vv, const bf16* S, const bf16* sgs, bf16* og) {
    LAS char* lds = (LAS char*)F.lds;
    constexpr int VST = 288, KST = 144, KOFF = 192 * VST;
    const int tid = F.tid, lane = F.lane, w = F.wave, g = lane >> 4, li = lane & 15, q4 = li >> 2, p4 = li & 3;
    const float* gret = F.in[I_GRET];
    for (int un = blockIdx.x; un < NB * NH * NCH; un += F.G) {
        const int bh = un >> 6, c = un & 63, b = bh >> 3, h = bh & 7;
        const size_t tok0 = (size_t)b * SEQ + (size_t)c * CH;
        __syncthreads();
#pragma unroll
        for (int j = 0; j < 4; ++j) { const int piece = tid + 512 * j, row = piece >> 4, ch = piece & 15;
            *(LAS u32x4*)(lds + row * VST + ch * 16) = *(const GAS u32x4*)(vv + (tok0 + row) * D + h * 128 + ch * 8); }
        if (c > 0) {
#pragma unroll
            for (int j = 0; j < 2; ++j) { const int piece = tid + 512 * j, row = piece >> 4, ch = piece & 15;
                *(LAS u32x4*)(lds + (128 + row) * VST + ch * 16) = *(const GAS u32x4*)(S + ((size_t)(bh * NCH + c) * DK + row) * DV + ch * 8); } }
#pragma unroll
        for (int j = 0; j < 2; ++j) { const int piece = tid + 512 * j, row = piece >> 3, ch = piece & 7;
            *(LAS u32x4*)(lds + KOFF + row * KST + ch * 16) = *(const GAS u32x4*)(kk + (tok0 + row) * 512 + h * 64 + ch * 8); }
        bf16x8 qf[2];
#pragma unroll
        for (int s = 0; s < 2; ++s) qf[s] = *(const GAS bf16x8*)(qq + (tok0 + 16 * w + li) * 512 + h * 64 + 32 * s + 8 * g);
        __syncthreads();
        f32x4 pt[8];
#pragma unroll
        for (int t = 0; t < 8; ++t) {
            pt[t] = (f32x4){0.f, 0.f, 0.f, 0.f};
            if (t <= w) {
                const bf16x8 k0 = *(const LAS bf16x8*)(lds + KOFF + (16 * t + li) * KST + (8 * g) * 2), k1 = *(const LAS bf16x8*)(lds + KOFF + (16 * t + li) * KST + (32 + 8 * g) * 2);
                pt[t] = __builtin_amdgcn_mfma_f32_16x16x32_bf16(k0, qf[0], pt[t], 0, 0, 0);
                pt[t] = __builtin_amdgcn_mfma_f32_16x16x32_bf16(k1, qf[1], pt[t], 0, 0, 0);
                if (t == w) {
#pragma unroll
                    for (int r = 0; r < 4; ++r) if (4 * g + r > li) pt[t][r] = 0.f; }
            }
        }
        f32x4 acc[8];
#pragma unroll
        for (int n = 0; n < 8; ++n) acc[n] = (f32x4){0.f, 0.f, 0.f, 0.f};
#pragma unroll
        for (int s2 = 0; s2 < 4; ++s2) {
            if (2 * s2 <= w) {
                u32x4 pw; pw.x = cvt_pk_bf16(pt[2 * s2][0], pt[2 * s2][1]); pw.y = cvt_pk_bf16(pt[2 * s2][2], pt[2 * s2][3]);
                pw.z = cvt_pk_bf16(pt[2 * s2 + 1][0], pt[2 * s2 + 1][1]); pw.w = cvt_pk_bf16(pt[2 * s2 + 1][2], pt[2 * s2 + 1][3]);
                const bf16x8 pa = __builtin_bit_cast(bf16x8, pw);
#pragma unroll
                for (int n = 0; n < 8; ++n) {
                    const s16x4 lo = tr_read(lds + (32 * s2 + 4 * g + q4) * VST + (16 * n + 4 * p4) * 2), hi = tr_read(lds + (32 * s2 + 16 + 4 * g + q4) * VST + (16 * n + 4 * p4) * 2);
                    const bf16x8 vf = __builtin_shufflevector(lo, hi, 0, 1, 2, 3, 4, 5, 6, 7);
                    acc[n] = __builtin_amdgcn_mfma_f32_16x16x32_bf16(pa, vf, acc[n], 0, 0, 0);
                }
            }
        }
        if (c > 0) {
#pragma unroll
            for (int s = 0; s < 2; ++s)
#pragma unroll
                for (int n = 0; n < 8; ++n) {
                    const s16x4 lo = tr_read(lds + (128 + 32 * s + 8 * g + q4) * VST + (16 * n + 4 * p4) * 2), hi = tr_read(lds + (128 + 32 * s + 8 * g + 4 + q4) * VST + (16 * n + 4 * p4) * 2);
                    const bf16x8 sf = __builtin_shufflevector(lo, hi, 0, 1, 2, 3, 4, 5, 6, 7);
                    acc[n] = __builtin_amdgcn_mfma_f32_16x16x32_bf16(qf[s], sf, acc[n], 0, 0, 0);
                }
        }
        float rs[4];
#pragma unroll
        for (int r = 0; r < 4; ++r) { float s = 0.f;
#pragma unroll
            for (int n = 0; n < 8; ++n) s += acc[n][r] * acc[n][r];
            s += __shfl_xor(s, 1); s += __shfl_xor(s, 2); s += __shfl_xor(s, 4); s += __shfl_xor(s, 8);
            rs[r] = 1.0f / sqrtf(s * (1.f / DV) + EPS); }
#pragma unroll
        for (int n = 0; n < 8; ++n) { const int col = h * 128 + 16 * n + li; const float gr = gret[col];
#pragma unroll
            for (int r = 0; r < 4; ++r) { const size_t o = (tok0 + 16 * w + 4 * g + r) * D + col;
                og[o] = f2bf(acc[n][r] * rs[r] * gr * bf2f(sgs[o])); } }
    }
    __syncthreads();
}

__device__ __forceinline__ void bucket_phase(Frame& F, const u32x4* route, u32x2* lists, unsigned* gcnt) {
    LAS int* hist = (LAS int*)(F.lds + HS_OFF); LAS int* base = hist + 32;
    for (int ch = blockIdx.x; ch < T / NTHR; ch += F.G) {
        __syncthreads();
        if (F.tid < 32) hist[F.tid] = 0;
        __syncthreads();
        const int tok = ch * NTHR + F.tid; const u32x4 ro = route[tok];
        const int r0 = atomicAdd((int*)&hist[ro.x], 1), r1 = atomicAdd((int*)&hist[ro.y], 1);
        __syncthreads();
        if (F.tid < 32) base[F.tid] = (int)__hip_atomic_fetch_add(gcnt + F.tid, (unsigned)hist[F.tid], RLX_AGENT);
        __syncthreads();
        lists[(size_t)ro.x * T + base[ro.x] + r0] = (u32x2){(unsigned)tok * 2u, ro.z};
        lists[(size_t)ro.y * T + base[ro.y] + r1] = (u32x2){(unsigned)tok * 2u + 1u, ro.w};
    }
}
__device__ __forceinline__ void moe_tables(Frame& F, unsigned* gcnt) {
    LAS int* tb = (LAS int*)(F.lds + TB_OFF); LAS int* cn = (LAS int*)(F.lds + CN_OFF);
    __syncthreads();
    if (F.tid < 32) cn[F.tid] = (int)__hip_atomic_load(gcnt + F.tid, RLX_AGENT);
    __syncthreads();
    if (F.tid == 0) { int a = 0; for (int e = 0; e < 32; ++e) { tb[e] = a; a += (cn[e] + 255) >> 8; } tb[32] = a; }
    __syncthreads();
}
__device__ __forceinline__ void combine_pass(Frame& F, float* x1, const bf16* Y, bf16* xh3) {
    const int gw = F.vcu * NWAVES + F.wave, NGW = F.G * NWAVES, lane = F.lane;
    for (int m = gw; m < T; m += NGW) {
        GAS f32x4* xr = (GAS f32x4*)(x1 + (size_t)m * D) + lane; const GAS u32x2* y0 = (const GAS u32x2*)(Y + (size_t)m * D) + lane; const GAS u32x2* y1 = (const GAS u32x2*)(Y + (size_t)T * D + (size_t)m * D) + lane;
        f32x4 v[4]; float s = 0.f;
#pragma unroll
        for (int j = 0; j < 4; ++j) { v[j] = xr[64 * j]; const u32x2 a = y0[64 * j], b = y1[64 * j];
            v[j] += (f32x4){bf_lo(a.x), bf_hi(a.x), bf_lo(a.y), bf_hi(a.y)} + (f32x4){bf_lo(b.x), bf_hi(b.x), bf_lo(b.y), bf_hi(b.y)};
            s += (v[j].x * v[j].x + v[j].y * v[j].y) + (v[j].z * v[j].z + v[j].w * v[j].w); xr[64 * j] = v[j]; }
        const float rstd = 1.0f / sqrtf(wave_sum(s) * (1.f / D) + EPS);
        GAS u32x2* o8 = (GAS u32x2*)(xh3 + (size_t)m * D) + lane;
#pragma unroll
        for (int j = 0; j < 4; ++j) { u32x2 o; o.x = cvt_pk_bf16(v[j].x * rstd, v[j].y * rstd); o.y = cvt_pk_bf16(v[j].z * rstd, v[j].w * rstd); o8[64 * j] = o; }
    }
}
__device__ __forceinline__ void final_pass(Frame& F, const float* x3, const float* ssq3, float* out) {
    const int gw = F.vcu * NWAVES + F.wave, NGW = F.G * NWAVES, lane = F.lane;
    const float* gf = F.in[I_GFIN];
    f32x4 gv[4];
#pragma unroll
    for (int j = 0; j < 4; ++j) gv[j] = ((const GAS f32x4*)gf)[lane + 64 * j];
    for (int m = gw; m < T; m += NGW) {
        const float s = wave_sum(lane < 16 ? ssq3[(size_t)m * 16 + lane] : 0.f);
        const float rstd = 1.0f / sqrtf(s * (1.f / D) + EPS);
        const GAS f32x4* xr = (const GAS f32x4*)(x3 + (size_t)m * D) + lane; GAS f32x4* o = (GAS f32x4*)(out + (size_t)m * D) + lane;
#pragma unroll
        for (int j = 0; j < 4; ++j) o[64 * j] = xr[64 * j] * rstd * gv[j];
    }
}

constexpr int N_PHASES = 14;
__global__ void __launch_bounds__(NTHR, 2) hyb_fwd(Args args) {
    extern __shared__ __attribute__((aligned(16))) unsigned char lds_raw[];
    Frame F;
    F.lds = (LAS unsigned char*)lds_raw;
    F.tid = threadIdx.x; F.lane = F.tid & 63; F.wave = __builtin_amdgcn_readfirstlane(F.tid >> 6);
    F.G = gridDim.x; { const int bx = blockIdx.x; F.vcu = (F.G % 8 == 0) ? (bx % 8) * (F.G / 8) + bx / 8 : bx; }
#pragma unroll
    for (int i = 0; i < 22; ++i) F.in[i] = args.in[i];
    F.ws = args.ws; F.out = (unsigned char*)args.out;
    unsigned char* ws = args.ws;
    volatile LAS unsigned* MISC = (volatile LAS unsigned*)(F.lds + MISC_OFF);
    for (int u = F.tid; u < (LDS_BYTES - RING_BYTES) / 4; u += NTHR) ((LAS unsigned*)(F.lds + RING_BYTES))[u] = 0u;
    __syncthreads();
    unsigned* ctl = (unsigned*)(ws + WS_CTL);
    const int lo = args.ph_lo, hi = args.ph_hi;
    const bool multi = (hi - lo) > 1;
    XcdBarrier bar; bar.bar = ctl + CW_BAR; bar.x = 0; bar.st = nullptr;
    if (multi) bar = xcd_barrier_post(ctl + CW_BAR, MISC + 8);
#define IN(k) (lo <= (k) && (k) < hi)
#define SEAM(k) do { if (IN(k) && IN((k) + 1)) xcd_barrier(bar); } while (0)

    bf16* const bufA = (bf16*)(ws + WS_A);
    bf16* const cu = (bf16*)F.out; bf16* const bgb = (bf16*)F.out + (size_t)T * D;
    bf16* const og = (bf16*)F.out; bf16* const mixc = (bf16*)F.out + (size_t)T * D;
    bf16* const Yb = (bf16*)F.out;
    bf16* const qb = (bf16*)(ws + WS_Q); bf16* const kb = (bf16*)(ws + WS_K); bf16* const vb = (bf16*)(ws + WS_V); bf16* const sgb = (bf16*)(ws + WS_SG);
    bf16* const mcb = (bf16*)(ws + WS_MC); bf16* const mrb = (bf16*)(ws + WS_MR); bf16* const Sb = (bf16*)(ws + WS_S);
    bf16* const mixed = (bf16*)(ws + WS_Q); bf16* const ppb = (bf16*)(ws + WS_Q);
    float* const x1 = (float*)(ws + WS_V); bf16* const hid = (bf16*)(ws + WS_MC);
    float* const ssq1 = (float*)(ws + WS_SSQ1); float* const ssqp = (float*)(ws + WS_SSQP); float* const ssq3 = (float*)(ws + WS_SSQ3);
    u32x4* const route = (u32x4*)(ws + WS_ROUTE); u32x2* const lists = (u32x2*)(ws + WS_LIST); float* const rstd2 = (float*)(ws + WS_RSTD2);
    unsigned* const gcnt = ctl + CW_CNT;
    const LAS int* tb = (const LAS int*)(F.lds + TB_OFF); const LAS int* cn = (const LAS int*)(F.lds + CN_OFF);

    if (IN(0)) { p0_prologue(F); } SEAM(0);
    if (IN(1)) { pg8::StaticOrder S; S.init(bufA, ws + W_IN, T, NIN, D, F.G, (int)blockIdx.x);
        EpiG1 E{cu, bgb, qb, kb, vb, sgb, mcb, mrb, (const f32x2*)(ws + WS_ROPE)};
        pg8::gemm_phase(F.lds, D, S, E); } SEAM(1);
    if (IN(2)) { conv_pass(F, cu, bgb, bufA); state_scan(F, kb, vb, Sb); } SEAM(2);
    if (IN(3)) { ret_out(F, qb, kb, vb, Sb, sgb, og);
        pg8::StaticOrder S; S.init(bufA, ws + W_OC, T, D, D, F.G, (int)blockIdx.x);
        EpiGate E{mcb, nullptr, mixc, 0};
        pg8::gemm_phase(F.lds, D, S, E); } SEAM(3);
    if (IN(4)) { pg8::StaticOrder S; S.init(og, ws + W_OR, T, D, D, F.G, (int)blockIdx.x);
        EpiGate E{mrb, mixc, mixed, 1};
        pg8::gemm_phase(F.lds, D, S, E); } SEAM(4);
    if (IN(5)) { pg8::StaticOrder S; S.init(mixed, ws + W_O, T, D, D, F.G, (int)blockIdx.x);
        EpiRes E{F.in[I_X], x1, bufA, ssq1};
        pg8::gemm_phase(F.lds, D, S, E); } SEAM(5);
    if (IN(6)) { pg8::StaticOrder S; S.init(bufA, ws + W_R, T, 256, D, F.G, (int)blockIdx.x);
        EpiRoute E{ssq1, F.in[I_BRG], F.in[I_BRE], route, rstd2};
        pg8::gemm_phase(F.lds, D, S, E); } SEAM(6);
    if (IN(7)) { bucket_phase(F, route, lists, gcnt); } SEAM(7);
    if (IN(8)) { moe_tables(F, gcnt);
        MoeSched<true> S{tb, cn, lists, (const char*)bufA, (const char*)(ws + W_GU), (size_t)1024 * 1024 * 2, D, F.G, F.vcu};
        EpiHid E{tb, cn, lists, rstd2, hid};
        pg8::gemm_phase(F.lds, D, S, E); } SEAM(8);
    if (IN(9)) { moe_tables(F, gcnt);
        MoeSched<false> S{tb, cn, lists, (const char*)hid, (const char*)(ws + W_DN), (size_t)1024 * 512 * 2, DE, F.G, F.vcu};
        EpiDown E{tb, cn, lists, Yb};
        pg8::gemm_phase(F.lds, DE, S, E); } SEAM(9);
    if (IN(10)) { combine_pass(F, x1, Yb, bufA);
        pg8::StaticOrder S; S.init(ws + WS_PB, ws + W_PP, T, D, PLE, F.G, (int)blockIdx.x);
        EpiPP E{ppb, ssqp};
        pg8::gemm_phase(F.lds, PLE, S, E); } SEAM(10);
    if (IN(11)) { pg8::StaticOrder S; S.init(bufA, ws + W_PG, T, D, D, F.G, (int)blockIdx.x);
        EpiPle E{x1, ppb, ssqp, F.in[I_GPOST], ssq3};
        pg8::gemm_phase(F.lds, D, S, E); } SEAM(11);
    if (IN(12)) { final_pass(F, x1, ssq3, (float*)F.out); }
#undef IN
#undef SEAM
}

#ifndef N_LAUNCHES
#define N_LAUNCHES 1
#endif
extern "C" void kernel_launch(void* const* d_in, const int* in_sizes, int n_in, void* d_out, int out_size, void* d_ws, size_t ws_size, hipStream_t stream) {
    static int grid = 0;
    if (grid == 0) {
        if (n_in != 22 || in_sizes[0] != T * D || out_size != T * D || ws_size < WS_END) { fprintf(stderr, "kernel_launch: unexpected shapes / workspace (ws %zu, need %zu)\n", ws_size, (size_t)WS_END); grid = -1; return; }
        int dev = 0, cus = 0, per_cu = 0;
        if (hipGetDevice(&dev) != hipSuccess || hipDeviceGetAttribute(&cus, hipDeviceAttributeMultiprocessorCount, dev) != hipSuccess) { grid = -1; return; }
        if (hipFuncSetAttribute((const void*)hyb_fwd, hipFuncAttributeMaxDynamicSharedMemorySize, LDS_BYTES) != hipSuccess) { fprintf(stderr, "kernel_launch: hipFuncSetAttribute failed\n"); grid = -1; return; }
        if (hipOccupancyMaxActiveBlocksPerMultiprocessor(&per_cu, (const void*)hyb_fwd, NTHR, LDS_BYTES) != hipSuccess || per_cu < 1) { fprintf(stderr, "kernel_launch: occupancy query says %d\n", per_cu); }
        (void)hipGetLastError();
        grid = cus;
    }
    if (grid < 0) return;
    if (hipMemsetAsync((char*)d_ws + WS_CTL, 0, CTL_ZERO_BYTES, stream) != hipSuccess) return;
    Args a{};
    for (int i = 0; i < 22; ++i) a.in[i] = (const float*)d_in[i];
    a.out = (float*)d_out; a.ws = (unsigned char*)d_ws;
#if N_LAUNCHES == 1
    a.ph_lo = 0; a.ph_hi = N_PHASES;
    hipLaunchKernelGGL(hyb_fwd, dim3(grid), dim3(NTHR), LDS_BYTES, stream, a);
#else
    for (int p = 0; p < 13; ++p) { a.ph_lo = p; a.ph_hi = p + 1; hipLaunchKernelGGL(hyb_fwd, dim3(grid), dim3(NTHR), LDS_BYTES, stream, a); }
#endif
}
```

```cpp
#include <hip/hip_runtime.h>
#include <cstdio>
#include <cstdint>

#define LAS __attribute__((address_space(3)))
#define GAS __attribute__((address_space(1)))
typedef unsigned short bf16;
typedef short bf16x8 __attribute__((ext_vector_type(8)));
typedef short s16x4 __attribute__((ext_vector_type(4)));
typedef float f32x4 __attribute__((ext_vector_type(4)));
typedef float f32x2 __attribute__((ext_vector_type(2)));
typedef unsigned u32x4 __attribute__((ext_vector_type(4)));
typedef unsigned u32x2 __attribute__((ext_vector_type(2)));
typedef GAS unsigned gu32;
#define RLX_AGENT __ATOMIC_RELAXED, __HIP_MEMORY_SCOPE_AGENT

constexpr int D = 1024, NB = 8, SEQ = 8192, T = NB * SEQ, PLE = 256;
constexpr int NH = 8, DK = 64, DV = 128, CH = 128, NCH = SEQ / CH;
constexpr int NE = 32, DE = 512;
constexpr int NIN = 8192;
constexpr float EPS = 1e-6f;
constexpr int NWAVES = 8, NTHR = 512;

constexpr size_t MiB = 1u << 20;
constexpr size_t WS_CTL = 0, CTL_ZERO_BYTES = 1 * MiB;
constexpr size_t WS_ROUTE = 1 * MiB;
constexpr size_t WS_ROPE = 2 * MiB;
constexpr size_t WS_SSQ1 = 4 * MiB;
constexpr size_t WS_SSQP = 8 * MiB;
constexpr size_t WS_SSQ3 = 12 * MiB;
constexpr size_t WS_LIST = 16 * MiB;
constexpr size_t WS_W = 32 * MiB;
constexpr size_t W_IN = WS_W;
constexpr size_t W_OC = W_IN + 16 * MiB;
constexpr size_t W_OR = W_OC + 2 * MiB;
constexpr size_t W_O = W_OR + 2 * MiB;
constexpr size_t W_PG = W_O + 2 * MiB;
constexpr size_t W_PP = W_PG + 2 * MiB;
constexpr size_t W_R = W_PP + 1 * MiB;
constexpr size_t W_GU = W_R + 1 * MiB;
constexpr size_t W_DN = W_GU + 64 * MiB;
constexpr size_t WS_RSTD2 = W_DN + 32 * MiB;
constexpr size_t WS_A = 155 * MiB;
constexpr size_t WS_PB = 283 * MiB;
constexpr size_t WS_Q = 315 * MiB;
constexpr size_t WS_K = 379 * MiB;
constexpr size_t WS_V = 443 * MiB;
constexpr size_t WS_SG = 571 * MiB;
constexpr size_t WS_MC = 699 * MiB;
constexpr size_t WS_MR = 827 * MiB;
constexpr size_t WS_S = 955 * MiB;
constexpr size_t WS_END = 1019 * MiB;
static_assert(WS_RSTD2 + (size_t)T * 4 <= WS_A, "ws map");

constexpr int CW_CNT = 64;
constexpr int CW_BAR = 4096;

constexpr int RING_BYTES = 131072;
constexpr int MISC_OFF = RING_BYTES;
constexpr int TB_OFF = RING_BYTES + 256;
constexpr int CN_OFF = RING_BYTES + 512;
constexpr int HS_OFF = RING_BYTES + 768;
constexpr int LDS_BYTES = 147456;

__device__ __forceinline__ unsigned cvt_pk_bf16(float lo, float hi) { unsigned r; asm volatile("v_cvt_pk_bf16_f32 %0, %1, %2" : "=v"(r) : "v"(lo), "v"(hi)); return r; }
__device__ __forceinline__ float bf_lo(unsigned u) { return __uint_as_float(u << 16); }
__device__ __forceinline__ float bf_hi(unsigned u) { return __uint_as_float(u & 0xffff0000u); }
__device__ __forceinline__ float bf2f(bf16 b) { return __uint_as_float(((unsigned)b) << 16); }
__device__ __forceinline__ bf16 f2bf(float f) { unsigned u = __float_as_uint(f); return (bf16)((u + 0x7fffu + ((u >> 16) & 1u)) >> 16); }
__device__ __forceinline__ u32x4 pack8(const f32x4 a, const f32x4 b) { u32x4 w; w.x = cvt_pk_bf16(a[0], a[1]); w.y = cvt_pk_bf16(a[2], a[3]); w.z = cvt_pk_bf16(b[0], b[1]); w.w = cvt_pk_bf16(b[2], b[3]); return w; }
__device__ __forceinline__ void unpack8(const u32x4 w, f32x4& a, f32x4& b) { a = (f32x4){bf_lo(w.x), bf_hi(w.x), bf_lo(w.y), bf_hi(w.y)}; b = (f32x4){bf_lo(w.z), bf_hi(w.z), bf_lo(w.w), bf_hi(w.w)}; }
__device__ __forceinline__ float sigmoidf_(float x) { return 1.0f / (1.0f + __expf(-x)); }
__device__ __forceinline__ float siluf_(float x) { return x / (1.0f + __expf(-x)); }
__device__ __forceinline__ float wave_sum(float v) {
#pragma unroll
    for (int o = 1; o < 64; o <<= 1) v += __shfl_xor(v, o);
    return v;
}
__device__ __forceinline__ s16x4 tr_read(LAS const char* p) { return __builtin_bit_cast(s16x4, __builtin_amdgcn_ds_read_tr16_b64_v4i16((LAS s16x4*)p)); }

__constant__ float c_inv_freq[32] = {1.000000000e+00f, 7.498942018e-01f, 5.623413324e-01f, 4.216965139e-01f, 3.162277639e-01f, 2.371373773e-01f, 1.778279394e-01f, 1.333521456e-01f, 1.000000015e-01f, 7.498942316e-02f, 5.623413250e-02f, 4.216964915e-02f, 3.162277490e-02f, 2.371373773e-02f, 1.778279431e-02f, 1.333521400e-02f, 9.999999776e-03f, 7.498942316e-03f, 5.623413250e-03f, 4.216964822e-03f, 3.162277630e-03f, 2.371373819e-03f, 1.778279431e-03f, 1.333521446e-03f, 1.000000047e-03f, 7.498941850e-04f, 5.623413017e-04f, 4.216965172e-04f, 3.162277571e-04f, 2.371373703e-04f, 1.778279402e-04f, 1.333521504e-04f};
__device__ __forceinline__ float lg2_gamma(int h) {
    const float t[8] = {-4.580368961312e-02f, -2.272007650008e-02f, -1.131531322783e-02f, -5.646563141142e-03f, -2.820519062379e-03f, -1.409570254671e-03f, -7.046129765894e-04f, -3.522634716290e-04f};
    float r = t[0];
#pragma unroll
    for (int i = 1; i < 8; ++i) r = (h == i) ? t[i] : r;
    return r;
}

namespace pg8 {
constexpr int BM = 256, BK = 64, HALF = 128, HTB = HALF * BK * 2, STAGE_BYTES = 8 * HTB, NXCD = 8, WGM = 8;
__host__ __device__ __forceinline__ int lds_byte(int r, int c) { const int st = (r >> 4) * 2 + (c >> 5), rr = r & 15, cc = c & 31, ob = rr * 64 + cc * 2; return st * 1024 + (ob ^ (((ob >> 9) & 1) << 5)); }
__host__ __device__ __forceinline__ void stage_rc(int b, int& R, int& C) { const int st = b / 1024, sb = b % 1024, swz = sb ^ (((sb >> 9) & 1) << 5); R = (st >> 1) * 16 + swz / 64; C = (st & 1) * 32 + (swz % 64) / 2; }
__host__ __device__ __forceinline__ int perm32(int rho) { const int n = rho >> 4, i = rho & 15; return 8 * (i >> 2) + 4 * n + (i & 3); }

struct Unit { int pm, pn, aux; };

struct StaticOrder {
    static constexpr bool GATHER = false;
    int nM, nN, nwg, G, c; const char* A; const char* B; size_t tstep;
    __device__ void init(const void* A_, const void* B_, int M, int N, int K, int G_, int c_) { nM = M / BM; nN = N / BM; nwg = nM * nN; G = G_; c = c_; A = (const char*)A_; B = (const char*)B_; tstep = (size_t)BM * K * 2; }
    __device__ bool next(int i, Unit& u) const {
        const long L = (long)i * G + c; if (L >= nwg) return false;
        int wgid = (int)L; { const int q = nwg / NXCD, r = nwg % NXCD, xcd = wgid % NXCD, off = wgid / NXCD; wgid = (xcd < r ? xcd * (q + 1) : r * (q + 1) + (xcd - r) * q) + off; }
        const int nig = WGM * nN, gid = wgid / nig, fm = gid * WGM, gsz = (nM - fm) < WGM ? (nM - fm) : WGM;
        u.pm = fm + ((wgid % nig) % gsz); u.pn = (wgid % nig) / gsz; u.aux = 0; return true;
    }
    __device__ __forceinline__ void ptrs(const Unit& u, const char*& a, const char*& b) const { a = A + (size_t)u.pm * tstep; b = B + (size_t)u.pn * tstep; }
    __device__ __forceinline__ void goff(const Unit&, int, int, int, int, unsigned (&)[2][2]) const {}
};

#define PG8_SA(b, h) (((b) * 2 + (h)) * HTB)
#define PG8_SB(b, h) ((4 + (b) * 2 + (h)) * HTB)
#define PG8_GLDS(src, dstoff) __builtin_amdgcn_global_load_lds((const unsigned*)(src), (LAS unsigned*)(lds + (dstoff)), 16, 0, 0)
#define PG8_STAGE_B(bufoff, gbase, h) do { _Pragma("unroll") for (int _i = 0; _i < 2; ++_i) PG8_GLDS((gbase) + (size_t)(h) * hstep + voffB[_i], (bufoff) + ldsw + _i * 8192); } while (0)
#define PG8_STAGE_A(bufoff, gbase, h) do { if constexpr (Sched::GATHER) { _Pragma("unroll") for (int _i = 0; _i < 2; ++_i) PG8_GLDS((gbase) + vg[h][_i], (bufoff) + ldsw + _i * 8192); } \
        else { _Pragma("unroll") for (int _i = 0; _i < 2; ++_i) PG8_GLDS((gbase) + (size_t)(h) * hstep + voffA[_i], (bufoff) + ldsw + _i * 8192); } } while (0)
#define PG8_LDA(dst, b, h) do { _Pragma("unroll") for (int m = 0; m < 4; ++m) _Pragma("unroll") for (int k = 0; k < 2; ++k) dst[m][k] = *(const LAS bf16x8*)(lds + PG8_SA(b, h) + aoff + m * 2048 + k * 1024); } while (0)
#define PG8_LDB(dst, b, h) do { _Pragma("unroll") for (int n = 0; n < 2; ++n) _Pragma("unroll") for (int k = 0; k < 2; ++k) dst[n][k] = *(const LAS bf16x8*)(lds + PG8_SB(b, h) + boff + n * 2048 + k * 1024); } while (0)
#define PG8_MMA(ai, bj, At, Bt) do { __builtin_amdgcn_s_setprio(1); _Pragma("unroll") for (int m = 0; m < 4; ++m) _Pragma("unroll") for (int n = 0; n < 2; ++n) _Pragma("unroll") for (int k = 0; k < 2; ++k) \
        acc[ai][bj][m][n] = __builtin_amdgcn_mfma_f32_16x16x32_bf16(Bt[n][k], At[m][k], acc[ai][bj][m][n], 0, 0, 0); __builtin_amdgcn_s_setprio(0); } while (0)
#define PG8_WAIT_V(n) asm volatile("s_waitcnt vmcnt(" #n ")" ::: "memory")
#define PG8_WAIT_L(n) asm volatile("s_waitcnt lgkmcnt(" #n ")" ::: "memory")
#define PG8_BAR __builtin_amdgcn_s_barrier()
#define PG8_SCHED __builtin_amdgcn_sched_barrier(0)

template <class Epi, class Sched>
__device__ __forceinline__ void gemm_phase(LAS unsigned char* lds, const int K, const Sched& S, const Epi& E) {
    const int tid = threadIdx.x, wid = __builtin_amdgcn_readfirstlane(tid >> 6), lane = tid & 63, wr = wid >> 2, wc = wid & 3, fr = lane & 15, fq = lane >> 4;
    const int nt = K / BK;
    unsigned voffA[2], voffB[2]; int Rr[2], Cc[2];
#pragma unroll
    for (int i = 0; i < 2; ++i) { int R, C; stage_rc(tid * 16 + i * 8192, R, C); const int Rb = (R & ~31) + perm32(R & 31); Rr[i] = R; Cc[i] = C;
        voffA[i] = (unsigned)(R * K + C) * 2u; voffB[i] = (unsigned)(Rb * K + C) * 2u; }
    const size_t kstep = (size_t)(BK * 2);
    const size_t hstep = (size_t)HALF * K * 2;
    const unsigned ldsw = (unsigned)wid * 1024u;
    const int aoff = lds_byte(wr * 64 + fr, fq * 8), boff = lds_byte(wc * 32 + fr, fq * 8);
    Unit cur, nxt; int ui = 0;
    if (!S.next(0, cur)) return;
    f32x4 acc[2][2][4][2];
#pragma unroll
    for (int a = 0; a < 2; ++a)
#pragma unroll
        for (int b = 0; b < 2; ++b)
#pragma unroll
            for (int m = 0; m < 4; ++m)
#pragma unroll
                for (int n = 0; n < 2; ++n) acc[a][b][m][n] = (f32x4){0.f, 0.f, 0.f, 0.f};
    bf16x8 At[4][2], B0[2][2], B1[2][2];
    const char *cA, *cB; S.ptrs(cur, cA, cB);
    unsigned vg[2][2] = {{0u, 0u}, {0u, 0u}}, vn[2][2] = {{0u, 0u}, {0u, 0u}};
    if constexpr (Sched::GATHER) S.goff(cur, Rr[0], Rr[1], Cc[0], Cc[1], vg);
    PG8_STAGE_B(PG8_SB(0, 0), cB, 0); PG8_STAGE_B(PG8_SB(0, 1), cB, 1); PG8_STAGE_A(PG8_SA(0, 0), cA, 0); PG8_STAGE_A(PG8_SA(0, 1), cA, 1);
    if (wr == 1) PG8_BAR;
    PG8_WAIT_V(2); PG8_BAR;
    PG8_STAGE_B(PG8_SB(1, 0), cB + kstep, 0); PG8_STAGE_A(PG8_SA(1, 0), cA + kstep, 0); PG8_STAGE_B(PG8_SB(1, 1), cB + kstep, 1);
    PG8_WAIT_V(6); PG8_BAR;
    for (;;) {
        const bool has_next = S.next(ui + 1, nxt);
        const char *nA = cA, *nB = cB; if (has_next) S.ptrs(nxt, nA, nB);
        if constexpr (Sched::GATHER) {
#pragma unroll
            for (int h = 0; h < 2; ++h)
#pragma unroll
                for (int i = 0; i < 2; ++i) vn[h][i] = vg[h][i];
            if (has_next) S.goff(nxt, Rr[0], Rr[1], Cc[0], Cc[1], vn);
        }
        for (int t = 0; t < nt; t += 2) {
            const bool last = (t == nt - 2);
            const char* a1 = cA + (size_t)(t + 1) * kstep;
            const char* a2 = last ? nA : cA + (size_t)(t + 2) * kstep; const char* b2 = last ? nB : cB + (size_t)(t + 2) * kstep;
            const char* a3 = a2 + kstep; const char* b3 = b2 + kstep;
            PG8_LDB(B0, 0, 0); PG8_LDB(B1, 0, 1); PG8_SCHED; PG8_LDA(At, 0, 0); PG8_STAGE_A(PG8_SA(1, 1), a1, 1);
            if constexpr (Sched::GATHER) { if (last) {
#pragma unroll
                for (int h = 0; h < 2; ++h)
#pragma unroll
                    for (int i = 0; i < 2; ++i) vg[h][i] = vn[h][i]; } }
            PG8_WAIT_V(8); PG8_WAIT_L(0); PG8_BAR; PG8_MMA(0, 0, At, B0); PG8_MMA(0, 1, At, B1); PG8_BAR; PG8_SCHED;
            PG8_LDA(At, 0, 1); PG8_STAGE_B(PG8_SB(0, 0), b2, 0); PG8_STAGE_B(PG8_SB(0, 1), b2, 1); PG8_STAGE_A(PG8_SA(0, 0), a2, 0);
            PG8_WAIT_V(8); PG8_WAIT_L(0); PG8_BAR; PG8_MMA(1, 0, At, B0); PG8_MMA(1, 1, At, B1); PG8_BAR; PG8_SCHED;
            PG8_LDB(B0, 1, 0); PG8_LDB(B1, 1, 1); PG8_SCHED; PG8_LDA(At, 1, 0); PG8_STAGE_A(PG8_SA(0, 1), a2, 1);
            PG8_WAIT_V(8); PG8_WAIT_L(0); PG8_BAR; PG8_MMA(0, 0, At, B0); PG8_MMA(0, 1, At, B1); PG8_BAR; PG8_SCHED;
            PG8_LDA(At, 1, 1); PG8_STAGE_B(PG8_SB(1, 0), b3, 0); PG8_STAGE_B(PG8_SB(1, 1), b3, 1); PG8_STAGE_A(PG8_SA(1, 0), a3, 0);
            PG8_WAIT_V(8); PG8_WAIT_L(0); PG8_BAR; PG8_MMA(1, 0, At, B0); PG8_MMA(1, 1, At, B1); PG8_BAR; PG8_SCHED;
        }
        if (wr == 0) PG8_BAR;
        E(acc, cur, wr, wc, fr, fq);
        if (!has_next) break;
#pragma unroll
        for (int a = 0; a < 2; ++a)
#pragma unroll
            for (int b = 0; b < 2; ++b)
#pragma unroll
                for (int m = 0; m < 4; ++m)
#pragma unroll
                    for (int n = 0; n < 2; ++n) acc[a][b][m][n] = (f32x4){0.f, 0.f, 0.f, 0.f};
        cur = nxt; cA = nA; cB = nB; ++ui;
        if (wr == 1) PG8_BAR;
    }
    PG8_WAIT_V(0);
    PG8_BAR;
}
}
using pg8::Unit;
typedef f32x4 Acc[2][2][4][2];

#define XB_TMO      128
#define XB_XCNT(j)  (256  + 64 * (j))
#define XB_XSUB(j)  (1280 + 64 * (j))
#define XB_XGEN(j)  (2304 + 64 * (j))
#define XB_TOP      3328
#define XB_TOPGEN   3392
#define XCD_BAR_WORDS 3456
#define XB_SPIN_CAP (1u << 18)
__device__ __forceinline__ unsigned xb_ld(unsigned* p)              { return __hip_atomic_load(p, __ATOMIC_RELAXED, __HIP_MEMORY_SCOPE_AGENT); }
__device__ __forceinline__ unsigned xb_add(unsigned* p, unsigned v) { return __hip_atomic_fetch_add(p, v, __ATOMIC_RELAXED, __HIP_MEMORY_SCOPE_AGENT); }
__device__ __forceinline__ unsigned xb_xcc_id() { return (unsigned)__builtin_amdgcn_s_getreg((3 << 11) | 20) & 0xFu; }
#define XB_SPIN(cond, bar) do { unsigned _sp = 0; while (cond) { __builtin_amdgcn_s_sleep(1); \
    if ((++_sp & 255u) == 0u) { if (xb_ld(&(bar)[XB_TMO])) break; if (_sp > XB_SPIN_CAP) { atomicAdd(&(bar)[XB_TMO], 1u); break; } } } } while (0)
struct XcdBarrier { unsigned* bar; unsigned x; volatile LAS unsigned* st; };
__device__ __forceinline__ XcdBarrier xcd_barrier_post(unsigned* bar, volatile LAS unsigned* st) {
    XcdBarrier b; b.bar = bar; b.x = xb_xcc_id(); b.st = st;
    if (threadIdx.x == 0) (void)xb_add(&bar[XB_XCNT(b.x)], 1u);
    return b;
}
__device__ __forceinline__ void xcd_barrier_complete(unsigned* bar, unsigned x, unsigned& nloc, unsigned& nx) {
    const unsigned G = gridDim.x * gridDim.y * gridDim.z;
    unsigned sum, cnt, mine, sp = 0u;
    for (;;) {
        sum = 0u; cnt = 0u; mine = 0u;
#pragma unroll
        for (unsigned j = 0; j < 16; ++j) { const unsigned c = xb_ld(&bar[XB_XCNT(j)]); sum += c; cnt += (c > 0u) ? 1u : 0u; mine = (j == x) ? c : mine; }
        if (sum == G) break;
        __builtin_amdgcn_s_sleep(1);
        if ((++sp & 255u) == 0u) { if (xb_ld(&bar[XB_TMO])) break; if (sp > XB_SPIN_CAP) { atomicAdd(&bar[XB_TMO], 1u); break; } }
    }
    nloc = mine > 0u ? mine : 1u; nx = cnt > 0u ? cnt : 1u;
}
__device__ __forceinline__ void xcd_barrier(const XcdBarrier& b) {
    asm volatile("s_waitcnt vmcnt(0)" ::: "memory");
    __syncthreads();
    if (threadIdx.x == 0) {
        unsigned* bar = b.bar;
        __builtin_amdgcn_s_waitcnt(0);
        unsigned nloc = b.st[0], nx = b.st[1];
        if (nloc == 0u) { xcd_barrier_complete(bar, b.x, nloc, nx); b.st[0] = nloc; b.st[1] = nx; }
        const unsigned old = xb_add(&bar[XB_XSUB(b.x)], 1u);
        const unsigned gen = old / nloc;
        if (old + 1u == (gen + 1u) * nloc) {
            __builtin_amdgcn_fence(__ATOMIC_RELEASE, "agent");
            asm volatile("s_waitcnt vmcnt(0)" ::: "memory");
            const unsigned og = xb_add(&bar[XB_TOP], 1u);
            const unsigned tg = og / nx;
            if (og + 1u == (tg + 1u) * nx) xb_add(&bar[XB_TOPGEN], 1u);
            else XB_SPIN(xb_ld(&bar[XB_TOPGEN]) == tg, bar);
            __builtin_amdgcn_fence(__ATOMIC_ACQUIRE, "agent");
            xb_add(&bar[XB_XGEN(b.x)], 1u);
            asm volatile("s_waitcnt vmcnt(0)" ::: "memory");
        } else {
            XB_SPIN(xb_ld(&bar[XB_XGEN(b.x)]) == gen, bar);
            __builtin_amdgcn_fence(__ATOMIC_ACQUIRE, "agent");
            asm volatile("s_waitcnt vmcnt(0)" ::: "memory");
        }
    }
    __syncthreads();
}

struct Args { const float* in[22]; float* out; unsigned char* ws; int ph_lo, ph_hi, li, pad; };
struct Frame {
    LAS unsigned char* lds;
    int tid, lane, wave, vcu, G;
    const float* in[22]; unsigned char* ws; unsigned char* out;
};
enum { I_X = 0, I_P, I_GMIX, I_WIN, I_CONVW, I_GRET, I_WOC, I_WOR, I_WO, I_GMOE, I_WRG, I_BRG, I_WRE, I_BRE, I_WG, I_WU, I_WD, I_GPIN, I_WPG, I_WPP, I_GPOST, I_GFIN };

__device__ __forceinline__ void p0_transpose_item(const float* W, int ldw, const float* g, bf16* WT, int ldt, int k0, int n0, int drow, LAS float* scr, int lane) {
#pragma unroll 8
    for (int i = 0; i < 32; ++i) { const int kk = 2 * i + (lane >> 5); float v = W[(size_t)(k0 + kk) * ldw + n0 + (lane & 31)]; if (g) v *= g[k0 + kk]; scr[kk * 33 + (lane & 31)] = v; }
    asm volatile("s_waitcnt lgkmcnt(0)" ::: "memory");
    const int c = lane & 7;
#pragma unroll
    for (int j = 0; j < 4; ++j) { const int n = (lane >> 3) + 8 * j; const LAS float* s = scr + (8 * c) * 33 + n;
        u32x4 o; o.x = cvt_pk_bf16(s[0 * 33], s[1 * 33]); o.y = cvt_pk_bf16(s[2 * 33], s[3 * 33]); o.z = cvt_pk_bf16(s[4 * 33], s[5 * 33]); o.w = cvt_pk_bf16(s[6 * 33], s[7 * 33]);
        *(GAS u32x4*)(WT + (size_t)(drow + n) * ldt + k0 + 8 * c) = o; }
    asm volatile("s_waitcnt lgkmcnt(0)" ::: "memory");
}
__device__ __forceinline__ int win_drow(int n0) {
    if (n0 < 1024) return 256 * (n0 >> 7) + (n0 & 127);
    if (n0 < 2048) { const int c = n0 - 1024; return 256 * (c >> 7) + 128 + (c & 127); }
    if (n0 < 3072) return n0;
    if (n0 < 4096) { const int j = (n0 - 3072) & 511, isk = (n0 - 3072) >> 9, head = j >> 6, d = j & 63;
        return 3072 + isk * 512 + 256 * (head >> 2) + ((d < 32) ? 32 * (head & 3) + d : 128 + 32 * (head & 3) + (d - 32)); }
    return n0;
}
__device__ __forceinline__ void sincos_acc(float angf, float& s, float& c) {
    const double a = (double)angf;
    const double kq = __builtin_rint(a * 0.63661977236758134308);
    double r = __builtin_fma(-kq, 1.5707963267948966, a); r = __builtin_fma(-kq, 6.123233995736766e-17, r);
    const double r2 = r * r;
    const double sp = r * (1.0 + r2 * (-1.0 / 6 + r2 * (1.0 / 120 + r2 * (-1.0 / 5040 + r2 * (1.0 / 362880 + r2 * (-1.0 / 39916800 + r2 * (1.0 / 6227020800.0)))))));
    const double cp = 1.0 + r2 * (-0.5 + r2 * (1.0 / 24 + r2 * (-1.0 / 720 + r2 * (1.0 / 40320 + r2 * (-1.0 / 3628800 + r2 * (1.0 / 479001600.0 + r2 * (-1.0 / 87178291200.0)))))));
    const int q = ((int)(long long)kq) & 3;
    const double ss = (q == 0) ? sp : (q == 1) ? cp : (q == 2) ? -sp : -cp;
    const double cc = (q == 0) ? cp : (q == 1) ? -sp : (q == 2) ? -cp : sp;
    s = (float)ss; c = (float)cc;
}
__device__ __forceinline__ void p0_prologue(Frame& F) {
    LAS float* scr = (LAS float*)(F.lds + F.wave * 16384);
    const int gw = F.vcu * NWAVES + F.wave, NGW = F.G * NWAVES, lane = F.lane;
    unsigned char* ws = F.ws;
    constexpr int I0 = 4096, I1 = 512, I5 = 128, I6 = 8192;
    constexpr int NITEMS = I0 + 4 * I1 + I5 + 3 * I6;
    for (int it = gw; it < NITEMS; it += NGW) {
        int r = it;
        if (r < I0) { const int kb = r >> 8, nb = r & 255; p0_transpose_item(F.in[I_WIN], NIN, F.in[I_GMIX], (bf16*)(ws + W_IN), D, 64 * kb, 32 * nb, win_drow(32 * nb), scr, lane); continue; } r -= I0;
        if (r < I1) { p0_transpose_item(F.in[I_WOC], D, nullptr, (bf16*)(ws + W_OC), D, 64 * (r >> 5), 32 * (r & 31), 32 * (r & 31), scr, lane); continue; } r -= I1;
        if (r < I1) { p0_transpose_item(F.in[I_WOR], D, nullptr, (bf16*)(ws + W_OR), D, 64 * (r >> 5), 32 * (r & 31), 32 * (r & 31), scr, lane); continue; } r -= I1;
        if (r < I1) { p0_transpose_item(F.in[I_WO], D, nullptr, (bf16*)(ws + W_O), D, 64 * (r >> 5), 32 * (r & 31), 32 * (r & 31), scr, lane); continue; } r -= I1;
        if (r < I1) { p0_transpose_item(F.in[I_WPG], D, F.in[I_GPIN], (bf16*)(ws + W_PG), D, 64 * (r >> 5), 32 * (r & 31), 32 * (r & 31), scr, lane); continue; } r -= I1;
        if (r < I5) { p0_transpose_item(F.in[I_WPP], D, nullptr, (bf16*)(ws + W_PP), PLE, 64 * (r >> 5), 32 * (r & 31), 32 * (r & 31), scr, lane); continue; } r -= I5;
        if (r < I6) { const int e = r >> 8, q = r & 255, kb = q >> 4, nb = q & 15, n0 = 32 * nb;
            p0_transpose_item(F.in[I_WG] + (size_t)e * D * DE, DE, F.in[I_GMOE], (bf16*)(ws + W_GU) + (size_t)e * 1024 * 1024, D, 64 * kb, n0, 256 * (n0 >> 7) + (n0 & 127), scr, lane); continue; } r -= I6;
        if (r < I6) { const int e = r >> 8, q = r & 255, kb = q >> 4, nb = q & 15, n0 = 32 * nb;
            p0_transpose_item(F.in[I_WU] + (size_t)e * D * DE, DE, F.in[I_GMOE], (bf16*)(ws + W_GU) + (size_t)e * 1024 * 1024, D, 64 * kb, n0, 256 * (n0 >> 7) + 128 + (n0 & 127), scr, lane); continue; } r -= I6;
        { const int e = r >> 8, q = r & 255, kb = q >> 5, nb = q & 31;
            p0_transpose_item(F.in[I_WD] + (size_t)e * DE * D, D, nullptr, (bf16*)(ws + W_DN) + (size_t)e * 1024 * 512, DE, 64 * kb, 32 * nb, 32 * nb, scr, lane); }
    }
    const int gt = F.vcu * NTHR + F.tid, NGT = F.G * NTHR;
    for (int it = gt; it < 256 * 128; it += NGT) {
        const int row = it >> 7, k0 = (it & 127) * 8; float v[8];
#pragma unroll
        for (int j = 0; j < 8; ++j) { const int k = k0 + j; float x = 0.f;
            if (row < 32) x = F.in[I_WRE][(size_t)k * NE + row] * F.in[I_GMOE][k];
            else if (row >= 128 && row < 132) x = F.in[I_WRG][(size_t)k * 4 + (row - 128)] * F.in[I_GMOE][k];
            v[j] = x; }
        u32x4 o; o.x = cvt_pk_bf16(v[0], v[1]); o.y = cvt_pk_bf16(v[2], v[3]); o.z = cvt_pk_bf16(v[4], v[5]); o.w = cvt_pk_bf16(v[6], v[7]);
        *(GAS u32x4*)((bf16*)(ws + W_R) + (size_t)row * D + k0) = o;
    }
    for (int it = gt; it < SEQ * 32; it += NGT) {
        const int pos = it >> 5, i = it & 31; float s, c; sincos_acc(__fmul_rn((float)pos, c_inv_freq[i]), s, c);
        ((GAS f32x2*)(ws + WS_ROPE))[it] = (f32x2){c, s};
    }
    { const float* p = F.in[I_P]; bf16* pb = (bf16*)(ws + WS_PB);
      for (size_t it = gt; it < (size_t)T * PLE / 8; it += NGT) { const f32x4 a = ((const GAS f32x4*)p)[2 * it], b = ((const GAS f32x4*)p)[2 * it + 1]; ((GAS u32x4*)pb)[it] = pack8(a, b); } }
    { const float* x = F.in[I_X]; bf16* xh = (bf16*)(ws + WS_A);
      for (int m = gw; m < T; m += NGW) {
          const GAS f32x4* xr = (const GAS f32x4*)(x + (size_t)m * D) + lane; f32x4 v[4]; float s = 0.f;
#pragma unroll
          for (int j = 0; j < 4; ++j) { v[j] = xr[64 * j]; s += (v[j].x * v[j].x + v[j].y * v[j].y) + (v[j].z * v[j].z + v[j].w * v[j].w); }
          const float rstd = 1.0f / sqrtf(wave_sum(s) * (1.f / D) + EPS);
          GAS u32x2* o8 = (GAS u32x2*)(xh + (size_t)m * D) + lane;
#pragma unroll
          for (int j = 0; j < 4; ++j) { u32x2 o; o.x = cvt_pk_bf16(v[j].x * rstd, v[j].y * rstd); o.y = cvt_pk_bf16(v[j].z * rstd, v[j].w * rstd); o8[64 * j] = o; }
      } }
}

struct EpiG1 {
    bf16 *cu, *bg, *q, *k, *v, *sg, *mc, *mr; const f32x2* rope;
    template <int ACT> __device__ __forceinline__ void plain(const Acc& acc, bf16* dst, int row0, int col0) const {
#pragma unroll
        for (int ai = 0; ai < 2; ++ai)
#pragma unroll
            for (int m = 0; m < 4; ++m) { bf16* rowp = dst + (size_t)(row0 + ai * 128 + m * 16) * D + col0;
#pragma unroll
                for (int bj = 0; bj < 2; ++bj) { f32x4 v0 = acc[ai][bj][m][0], v1 = acc[ai][bj][m][1];
                    if (ACT == 1) {
#pragma unroll
                        for (int j = 0; j < 4; ++j) { v0[j] = siluf_(v0[j]); v1[j] = siluf_(v1[j]); } }
                    if (ACT == 2) {
#pragma unroll
                        for (int j = 0; j < 4; ++j) { v0[j] = sigmoidf_(v0[j]); v1[j] = sigmoidf_(v1[j]); } }
                    *(GAS u32x4*)(rowp + bj * 128) = pack8(v0, v1); } }
    }
    __device__ __forceinline__ void operator()(const Acc& acc, const Unit& u, int wr, int wc, int fr, int fq) const {
        const int row0 = u.pm * 256 + wr * 64 + fr, pn = u.pn, cl = wc * 32 + 8 * fq;
        if (pn < 8) {
#pragma unroll
            for (int ai = 0; ai < 2; ++ai)
#pragma unroll
                for (int m = 0; m < 4; ++m) { bf16* rowp = cu + (size_t)(row0 + ai * 128 + m * 16) * D + pn * 128 + cl;
                    *(GAS u32x4*)rowp = pack8(acc[ai][0][m][0] * acc[ai][1][m][0], acc[ai][0][m][1] * acc[ai][1][m][1]); }
        } else if (pn < 12) plain<0>(acc, bg, row0, (pn - 8) * 256 + cl);
        else if (pn < 16) {
            const bool isk = pn >= 14; const int head = ((pn - 12) & 1) * 4 + wc; bf16* dst = isk ? k : q;
            const float lg = lg2_gamma(head);
#pragma unroll
            for (int ai = 0; ai < 2; ++ai) {
                f32x4 cs[4][4];
#pragma unroll
                for (int m = 0; m < 4; ++m) { const int pos = (row0 + ai * 128 + m * 16) & (SEQ - 1); const GAS f32x4* rp = (const GAS f32x4*)(rope + (size_t)pos * 32 + 8 * fq);
#pragma unroll
                    for (int j = 0; j < 4; ++j) cs[m][j] = rp[j]; }
#pragma unroll
                for (int m = 0; m < 4; ++m) { const int r = row0 + ai * 128 + m * 16, pos = r & (SEQ - 1); const float e = (float)((pos & (CH - 1)) + 1) * lg;
                    const float sc = isk ? 0.125f * exp2f(-e) : exp2f(e);
                    f32x4 o1[2], o2[2];
#pragma unroll
                    for (int n = 0; n < 2; ++n) { const f32x4 cs0 = cs[m][2 * n], cs1 = cs[m][2 * n + 1];
                        const f32x4 a = acc[ai][0][m][n], b = acc[ai][1][m][n];
                        o1[n] = (f32x4){(a[0] * cs0[0] - b[0] * cs0[1]) * sc, (a[1] * cs0[2] - b[1] * cs0[3]) * sc, (a[2] * cs1[0] - b[2] * cs1[1]) * sc, (a[3] * cs1[2] - b[3] * cs1[3]) * sc};
                        o2[n] = (f32x4){(a[0] * cs0[1] + b[0] * cs0[0]) * sc, (a[1] * cs0[3] + b[1] * cs0[2]) * sc, (a[2] * cs1[1] + b[2] * cs1[0]) * sc, (a[3] * cs1[3] + b[3] * cs1[2]) * sc}; }
                    bf16* rowp = dst + (size_t)r * 512 + head * 64 + 8 * fq;
                    *(GAS u32x4*)rowp = pack8(o1[0], o1[1]); *(GAS u32x4*)(rowp + 32) = pack8(o2[0], o2[1]); } }
        } else if (pn < 20) plain<0>(acc, v, row0, (pn - 16) * 256 + cl);
        else if (pn < 24) plain<1>(acc, sg, row0, (pn - 20) * 256 + cl);
        else if (pn < 28) plain<2>(acc, mc, row0, (pn - 24) * 256 + cl);
        else plain<2>(acc, mr, row0, (pn - 28) * 256 + cl);
    }
};
template <int MODE> struct EpiGate {
    const bf16* gate; const bf16* prev; bf16* out;
    __device__ __forceinline__ void operator()(const Acc& acc, const Unit& u, int wr, int wc, int fr, int fq) const {
        const int row0 = u.pm * 256 + wr * 64 + fr, col0 = u.pn * 256 + wc * 32 + 8 * fq;
#pragma unroll
        for (int ai = 0; ai < 2; ++ai) {
            u32x4 gt[4][2], pv[4][2];
#pragma unroll
            for (int m = 0; m < 4; ++m)
#pragma unroll
                for (int bj = 0; bj < 2; ++bj) { const size_t ro = (size_t)(row0 + ai * 128 + m * 16) * D + col0 + bj * 128;
                    gt[m][bj] = *(const GAS u32x4*)(gate + ro); if (MODE) pv[m][bj] = *(const GAS u32x4*)(prev + ro); }
#pragma unroll
            for (int m = 0; m < 4; ++m)
#pragma unroll
                for (int bj = 0; bj < 2; ++bj) { const size_t ro = (size_t)(row0 + ai * 128 + m * 16) * D + col0 + bj * 128;
                    f32x4 g0, g1; unpack8(gt[m][bj], g0, g1);
                    f32x4 v0 = acc[ai][bj][m][0] * g0, v1 = acc[ai][bj][m][1] * g1;
                    if (MODE) { f32x4 p0, p1; unpack8(pv[m][bj], p0, p1); v0 += p0; v1 += p1; }
                    *(GAS u32x4*)(out + ro) = pack8(v0, v1); } }
    }
};
struct EpiRes {
    const float* x; float* x1; bf16* xb1; float* ssq;
    __device__ __forceinline__ void operator()(const Acc& acc, const Unit& u, int wr, int wc, int fr, int fq) const {
        const int row0 = u.pm * 256 + wr * 64 + fr, col0 = u.pn * 256 + wc * 32 + 8 * fq;
#pragma unroll
        for (int ai = 0; ai < 2; ++ai) {
            f32x4 xv[4][2][2];
#pragma unroll
            for (int m = 0; m < 4; ++m)
#pragma unroll
                for (int bj = 0; bj < 2; ++bj) { const GAS f32x4* xp = (const GAS f32x4*)(x + (size_t)(row0 + ai * 128 + m * 16) * D + col0 + bj * 128); xv[m][bj][0] = xp[0]; xv[m][bj][1] = xp[1]; }
#pragma unroll
            for (int m = 0; m < 4; ++m) { const int r = row0 + ai * 128 + m * 16; const size_t ro = (size_t)r * D + col0; float s = 0.f;
#pragma unroll
                for (int bj = 0; bj < 2; ++bj) {
                    const f32x4 v0 = xv[m][bj][0] + acc[ai][bj][m][0], v1 = xv[m][bj][1] + acc[ai][bj][m][1];
                    GAS f32x4* op = (GAS f32x4*)(x1 + ro + bj * 128); op[0] = v0; op[1] = v1;
                    *(GAS u32x4*)(xb1 + ro + bj * 128) = pack8(v0, v1);
                    s += (v0[0] * v0[0] + v0[1] * v0[1]) + (v0[2] * v0[2] + v0[3] * v0[3]) + (v1[0] * v1[0] + v1[1] * v1[1]) + (v1[2] * v1[2] + v1[3] * v1[3]); }
                s += __shfl_xor(s, 16); s += __shfl_xor(s, 32);
                if (fq == 0) ssq[(size_t)r * 16 + u.pn * 4 + wc] = s; } }
    }
};
struct EpiRoute {
    const float* ssq; const float* brg; const float* bre; u32x4* route; float* rstd2;
    __device__ __forceinline__ void operator()(const Acc& acc, const Unit& u, int wr, int wc, int fr, int fq) const {
        if (wc != 0) return;
        const int row0 = u.pm * 256 + wr * 64 + fr;
        float be[8], bg4[4];
#pragma unroll
        for (int j = 0; j < 8; ++j) be[j] = bre[8 * fq + j];
#pragma unroll
        for (int j = 0; j < 4; ++j) bg4[j] = brg[j];
        f32x4 pqa[2][4];
#pragma unroll
        for (int ai = 0; ai < 2; ++ai)
#pragma unroll
            for (int m = 0; m < 4; ++m) pqa[ai][m] = *(const GAS f32x4*)(ssq + (size_t)(row0 + ai * 128 + m * 16) * 16 + 4 * fq);
#pragma unroll
        for (int ai = 0; ai < 2; ++ai)
#pragma unroll
            for (int m = 0; m < 4; ++m) { const int r = row0 + ai * 128 + m * 16;
                const f32x4 pq = pqa[ai][m]; float s = (pq[0] + pq[1]) + (pq[2] + pq[3]);
                s += __shfl_xor(s, 16); s += __shfl_xor(s, 32);
                const float rs = 1.0f / sqrtf(s * (1.f / D) + EPS);
                float el[8], gl[4];
#pragma unroll
                for (int j = 0; j < 8; ++j) el[j] = acc[ai][0][m][j >> 2][j & 3] * rs + be[j];
#pragma unroll
                for (int j = 0; j < 4; ++j) gl[j] = __shfl(acc[ai][1][m][0][j] * rs + bg4[j], fr);
                int grp = 0; float best = gl[0];
#pragma unroll
                for (int j = 1; j < 4; ++j) if (gl[j] > best) { best = gl[j]; grp = j; }
                float den = 0.f;
#pragma unroll
                for (int j = 0; j < 4; ++j) den += __expf(gl[j] - best);
                const float gw = 1.0f / den;
                int i1 = 0; float l1 = el[0];
#pragma unroll
                for (int j = 1; j < 8; ++j) if (el[j] > l1) { l1 = el[j]; i1 = j; }
                int i2 = -1; float l2 = -3.0e38f;
#pragma unroll
                for (int j = 0; j < 8; ++j) if (j != i1 && el[j] > l2) { l2 = el[j]; i2 = j; }
                const float w0 = 1.0f / (1.0f + __expf(l2 - l1)), w1 = 1.0f - w0;
                if (fq == grp) { u32x4 o; o.x = (unsigned)(grp * 8 + i1); o.y = (unsigned)(grp * 8 + i2); o.z = __float_as_uint(w0 * gw); o.w = __float_as_uint(w1 * gw);
                    *(GAS u32x4*)(route + r) = o; rstd2[r] = rs; } }
    }
};
template <bool GATH> struct MoeSched {
    static constexpr bool GATHER = GATH;
    const LAS int* tb; const LAS int* cn; const u32x2* lists; const char* A; const char* B; size_t bstride; int K, G, c;
    __device__ bool next(int i, Unit& u) const {
        const int U = i * G + c; if (U >= tb[32] * 4) return false;
        const int rt = U >> 2; int e = 0; while (e < 31 && tb[e + 1] <= rt) ++e;
        u.pm = rt; u.pn = U & 3; u.aux = e; return true;
    }
    __device__ __forceinline__ void ptrs(const Unit& u, const char*& a, const char*& b) const {
        a = GATH ? A : A + (size_t)u.pm * 256 * K * 2; b = B + (size_t)u.aux * bstride + (size_t)u.pn * 256 * K * 2; }
    __device__ __forceinline__ void goff(const Unit& u, int R0, int R1, int C0, int C1, unsigned (&vo)[2][2]) const {
        const int e = u.aux, n = cn[e], base = (u.pm - tb[e]) * 256; const u32x2* L = lists + (size_t)e * T;
#pragma unroll
        for (int h = 0; h < 2; ++h) { const int i0 = base + 128 * h + R0, i1 = base + 128 * h + R1;
            const unsigned t0 = (i0 < n) ? (L[i0].x >> 1) : 0u, t1 = (i1 < n) ? (L[i1].x >> 1) : 0u;
            vo[h][0] = (t0 * (unsigned)D + (unsigned)C0) * 2u; vo[h][1] = (t1 * (unsigned)D + (unsigned)C1) * 2u; }
    }
};
struct EpiHid {
    const LAS int* tb; const LAS int* cn; const u32x2* lists; const float* rstd2; bf16* hid;
    __device__ __forceinline__ void operator()(const Acc& acc, const Unit& u, int wr, int wc, int fr, int fq) const {
        const int e = u.aux, n = cn[e], base = (u.pm - tb[e]) * 256; const u32x2* L = lists + (size_t)e * T;
        unsigned tk[2][4]; float rsa[2][4];
#pragma unroll
        for (int ai = 0; ai < 2; ++ai)
#pragma unroll
            for (int m = 0; m < 4; ++m) { const int idx = base + ai * 128 + wr * 64 + m * 16 + fr; tk[ai][m] = (idx < n) ? (L[idx].x >> 1) : 0u; }
#pragma unroll
        for (int ai = 0; ai < 2; ++ai)
#pragma unroll
            for (int m = 0; m < 4; ++m) { const int idx = base + ai * 128 + wr * 64 + m * 16 + fr; const float r = rstd2[tk[ai][m]]; rsa[ai][m] = (idx < n) ? r : 0.f; }
#pragma unroll
        for (int ai = 0; ai < 2; ++ai)
#pragma unroll
            for (int m = 0; m < 4; ++m) { const int rl = ai * 128 + wr * 64 + m * 16 + fr; const float rs = rsa[ai][m];
                f32x4 h0, h1;
#pragma unroll
                for (int j = 0; j < 4; ++j) { h0[j] = siluf_(rs * acc[ai][0][m][0][j]) * (rs * acc[ai][1][m][0][j]); h1[j] = siluf_(rs * acc[ai][0][m][1][j]) * (rs * acc[ai][1][m][1][j]); }
                *(GAS u32x4*)(hid + (size_t)(u.pm * 256 + rl) * DE + u.pn * 128 + wc * 32 + 8 * fq) = pack8(h0, h1); }
    }
};
struct EpiDown {
    const LAS int* tb; const LAS int* cn; const u32x2* lists; bf16* Y;
    __device__ __forceinline__ void operator()(const Acc& acc, const Unit& u, int wr, int wc, int fr, int fq) const {
        const int e = u.aux, n = cn[e], base = (u.pm - tb[e]) * 256; const u32x2* L = lists + (size_t)e * T;
        u32x2 ent[2][4];
#pragma unroll
        for (int ai = 0; ai < 2; ++ai)
#pragma unroll
            for (int m = 0; m < 4; ++m) { const int idx = base + ai * 128 + wr * 64 + m * 16 + fr; ent[ai][m] = (idx < n) ? L[idx] : (u32x2){0u, 0u}; }
#pragma unroll
        for (int ai = 0; ai < 2; ++ai)
#pragma unroll
            for (int m = 0; m < 4; ++m) { const int idx = base + ai * 128 + wr * 64 + m * 16 + fr;
                if (idx < n) { const u32x2 en = ent[ai][m]; const float w = __uint_as_float(en.y);
                    bf16* rowp = Y + (size_t)(en.x & 1u) * T * D + (size_t)(en.x >> 1) * D + u.pn * 256 + wc * 32 + 8 * fq;
#pragma unroll
                    for (int bj = 0; bj < 2; ++bj) *(GAS u32x4*)(rowp + bj * 128) = pack8(acc[ai][bj][m][0] * w, acc[ai][bj][m][1] * w); } }
    }
};
struct EpiPP {
    bf16* pp; float* ssq;
    __device__ __forceinline__ void operator()(const Acc& acc, const Unit& u, int wr, int wc, int fr, int fq) const {
        const int row0 = u.pm * 256 + wr * 64 + fr, col0 = u.pn * 256 + wc * 32 + 8 * fq;
#pragma unroll
        for (int ai = 0; ai < 2; ++ai)
#pragma unroll
            for (int m = 0; m < 4; ++m) { const int r = row0 + ai * 128 + m * 16; float s = 0.f;
#pragma unroll
                for (int bj = 0; bj < 2; ++bj) { const f32x4 v0 = acc[ai][bj][m][0], v1 = acc[ai][bj][m][1];
                    *(GAS u32x4*)(pp + (size_t)r * D + col0 + bj * 128) = pack8(v0, v1);
                    s += (v0[0] * v0[0] + v0[1] * v0[1]) + (v0[2] * v0[2] + v0[3] * v0[3]) + (v1[0] * v1[0] + v1[1] * v1[1]) + (v1[2] * v1[2] + v1[3] * v1[3]); }
                s += __shfl_xor(s, 16); s += __shfl_xor(s, 32);
                if (fq == 0) ssq[(size_t)r * 16 + u.pn * 4 + wc] = s; }
    }
};
struct EpiPle {
    float* x2; const bf16* pp; const float* ssqp; const float* gpost; float* ssq3;
    __device__ __forceinline__ void operator()(const Acc& acc, const Unit& u, int wr, int wc, int fr, int fq) const {
        const int row0 = u.pm * 256 + wr * 64 + fr, col0 = u.pn * 256 + wc * 32 + 8 * fq;
        f32x4 gp[2][2];
#pragma unroll
        for (int bj = 0; bj < 2; ++bj) { const GAS f32x4* g = (const GAS f32x4*)(gpost + col0 + bj * 128); gp[bj][0] = g[0]; gp[bj][1] = g[1]; }
#pragma unroll
        for (int ai = 0; ai < 2; ++ai)
#pragma unroll
            for (int mh = 0; mh < 2; ++mh) {
                f32x4 pq[2], xv[2][2][2]; u32x4 pv[2][2];
#pragma unroll
                for (int mm = 0; mm < 2; ++mm) { const int r = row0 + ai * 128 + (2 * mh + mm) * 16; pq[mm] = *(const GAS f32x4*)(ssqp + (size_t)r * 16 + 4 * fq);
#pragma unroll
                    for (int bj = 0; bj < 2; ++bj) { const size_t ro = (size_t)r * D + col0 + bj * 128; pv[mm][bj] = *(const GAS u32x4*)(pp + ro);
                        const GAS f32x4* xp = (const GAS f32x4*)(x2 + ro); xv[mm][bj][0] = xp[0]; xv[mm][bj][1] = xp[1]; } }
#pragma unroll
                for (int mm = 0; mm < 2; ++mm) { const int m = 2 * mh + mm, r = row0 + ai * 128 + m * 16; const size_t ro = (size_t)r * D + col0;
                    float sp = (pq[mm][0] + pq[mm][1]) + (pq[mm][2] + pq[mm][3]);
                    sp += __shfl_xor(sp, 16); sp += __shfl_xor(sp, 32);
                    const float rp = 1.0f / sqrtf(sp * (1.f / D) + EPS); float s = 0.f;
#pragma unroll
                    for (int bj = 0; bj < 2; ++bj) { f32x4 p0, p1; unpack8(pv[mm][bj], p0, p1);
                        f32x4 v0 = xv[mm][bj][0], v1 = xv[mm][bj][1];
#pragma unroll
                        for (int j = 0; j < 4; ++j) { v0[j] += sigmoidf_(acc[ai][bj][m][0][j]) * (p0[j] * rp * gp[bj][0][j]); v1[j] += sigmoidf_(acc[ai][bj][m][1][j]) * (p1[j] * rp * gp[bj][1][j]); }
                        GAS f32x4* xp = (GAS f32x4*)(x2 + ro + bj * 128); xp[0] = v0; xp[1] = v1;
                        s += (v0[0] * v0[0] + v0[1] * v0[1]) + (v0[2] * v0[2] + v0[3] * v0[3]) + (v1[0] * v1[0] + v1[1] * v1[1]) + (v1[2] * v1[2] + v1[3] * v1[3]); }
                    s += __shfl_xor(s, 16); s += __shfl_xor(s, 32);
                    if (fq == 0) ssq3[(size_t)r * 16 + u.pn * 4 + wc] = s; } }
    }
};

__device__ __forceinline__ void conv_pass(Frame& F, const bf16* cu, const bf16* bg, bf16* ypre) {
    const int gw = F.vcu * NWAVES + F.wave, NGW = F.G * NWAVES, lane = F.lane;
    const float* cw = F.in[I_CONVW];
    for (int un = gw; un < (T / 64) * 2; un += NGW) {
        const int hc = un & 1, t0 = (un >> 1) * 64, ch = hc * 512 + lane * 8;
        f32x4 w0a = *(const GAS f32x4*)(cw + ch), w0b = *(const GAS f32x4*)(cw + ch + 4), w1a = *(const GAS f32x4*)(cw + D + ch), w1b = *(const GAS f32x4*)(cw + D + ch + 4),
              w2a = *(const GAS f32x4*)(cw + 2 * D + ch), w2b = *(const GAS f32x4*)(cw + 2 * D + ch + 4);
        f32x4 p2a = {0.f, 0.f, 0.f, 0.f}, p2b = p2a, p1a = p2a, p1b = p2a;
        if ((t0 & (SEQ - 1)) != 0) { unpack8(*(const GAS u32x4*)(cu + (size_t)(t0 - 2) * D + ch), p2a, p2b); unpack8(*(const GAS u32x4*)(cu + (size_t)(t0 - 1) * D + ch), p1a, p1b); }
#pragma unroll 4
        for (int i = 0; i < 64; ++i) { const size_t ro = (size_t)(t0 + i) * D + ch; f32x4 ca, cb, ba, bb;
            unpack8(*(const GAS u32x4*)(cu + ro), ca, cb); unpack8(*(const GAS u32x4*)(bg + ro), ba, bb);
            const f32x4 ya = ba * (w0a * p2a + w1a * p1a + w2a * ca), yb = bb * (w0b * p2b + w1b * p1b + w2b * cb);
            *(GAS u32x4*)(ypre + ro) = pack8(ya, yb);
            p2a = p1a; p2b = p1b; p1a = ca; p1b = cb; }
    }
}
__device__ __forceinline__ void state_scan(Frame& F, const bf16* kk, const bf16* vv, bf16* S) {
    LAS char* lds = (LAS char*)F.lds;
    constexpr int KST = 144, VST = 80, KBUF = 128 * KST, VBUF = 128 * VST;
    const int tid = F.tid, lane = F.lane, w = F.wave, g = lane >> 4, li = lane & 15, q4 = li >> 2, p4 = li & 3, vt = w >> 2, dt = w & 3;
    for (int un = blockIdx.x; un < 64 * 4; un += F.G) {
        const int bh = un >> 2, vq = un & 3, b = bh >> 3, h = bh & 7;
        const float g128 = exp2f(128.0f * lg2_gamma(h));
        f32x4 Sacc = {0.f, 0.f, 0.f, 0.f};
        __syncthreads();
        u32x4 rk[2], rv;
        { const size_t tok0 = (size_t)b * SEQ;
#pragma unroll
          for (int j = 0; j < 2; ++j) { const int piece = tid + 512 * j, row = piece >> 3, ch = piece & 7; rk[j] = *(const GAS u32x4*)(kk + (tok0 + row) * 512 + h * 64 + ch * 8); }
          { const int row = tid >> 2, ch = tid & 3; rv = *(const GAS u32x4*)(vv + (tok0 + row) * D + h * 128 + vq * 32 + ch * 8); }
#pragma unroll
          for (int j = 0; j < 2; ++j) { const int piece = tid + 512 * j, row = piece >> 3, ch = piece & 7; *(LAS u32x4*)(lds + row * KST + ch * 16) = rk[j]; }
          { const int row = tid >> 2, ch = tid & 3; *(LAS u32x4*)(lds + 2 * KBUF + row * VST + ch * 16) = rv; } }
        for (int c = 0; c < NCH; ++c) {
            { u32x2 o; o.x = cvt_pk_bf16(Sacc[0], Sacc[1]); o.y = cvt_pk_bf16(Sacc[2], Sacc[3]);
              *(GAS u32x2*)(S + ((size_t)(bh * NCH + c) * DK + 16 * dt + li) * DV + 32 * vq + 16 * vt + 4 * g) = o; }
            if (c == NCH - 1) break;
            const int cb = c & 1; const bool pre = (c + 1 < NCH - 1);
            if (pre) { const size_t tok0 = (size_t)b * SEQ + (size_t)(c + 1) * CH;
#pragma unroll
                for (int j = 0; j < 2; ++j) { const int piece = tid + 512 * j, row = piece >> 3, ch = piece & 7; rk[j] = *(const GAS u32x4*)(kk + (tok0 + row) * 512 + h * 64 + ch * 8); }
                { const int row = tid >> 2, ch = tid & 3; rv = *(const GAS u32x4*)(vv + (tok0 + row) * D + h * 128 + vq * 32 + ch * 8); } }
            __syncthreads();
            const LAS char* kb = lds + cb * KBUF; const LAS char* vb = lds + 2 * KBUF + cb * VBUF;
            f32x4 a4 = Sacc;
#pragma unroll
            for (int s = 0; s < 4; ++s) {
                const int r0 = 32 * s + 8 * g + q4;
                const s16x4 alo = tr_read(vb + r0 * VST + (16 * vt + 4 * p4) * 2), ahi = tr_read(vb + (r0 + 4) * VST + (16 * vt + 4 * p4) * 2);
                const s16x4 blo = tr_read(kb + r0 * KST + (16 * dt + 4 * p4) * 2), bhi = tr_read(kb + (r0 + 4) * KST + (16 * dt + 4 * p4) * 2);
                const bf16x8 af = __builtin_shufflevector(alo, ahi, 0, 1, 2, 3, 4, 5, 6, 7), bf = __builtin_shufflevector(blo, bhi, 0, 1, 2, 3, 4, 5, 6, 7);
                a4 = __builtin_amdgcn_mfma_f32_16x16x32_bf16(af, bf, a4, 0, 0, 0);
            }
            Sacc = a4 * g128;
            if (pre) { const int nb = cb ^ 1;
#pragma unroll
                for (int j = 0; j < 2; ++j) { const int piece = tid + 512 * j, row = piece >> 3, ch = piece & 7; *(LAS u32x4*)(lds + nb * KBUF + row * KST + ch * 16) = rk[j]; }
                { const int row = tid >> 2, ch = tid & 3; *(LAS u32x4*)(lds + 2 * KBUF + nb * VBUF + row * VST + ch * 16) = rv; } }
        }
    }
    __syncthreads();
}

__device__ __forceinline__ void ret_out(Frame& F, const bf16* qq, const bf16* kk, const bf16* vv, const bf16* S, const bf16* sgs, bf16* og) {
    LAS char* lds = (LAS char*)F.lds;
    constexpr int VST = 288, KST = 144, KOFF = 192 * VST;
    const int tid = F.tid, lane = F.lane, w = F.wave, g = lane >> 4, li = lane & 15, q4 = li >> 2, p4 = li & 3;
    const float* gret = F.in[I_GRET];
    for (int un = blockIdx.x; un < NB * NH * NCH; un += F.G) {
        const int bh = un >> 6, c = un & 63, b = bh >> 3, h = bh & 7;
        const size_t tok0 = (size_t)b * SEQ + (size_t)c * CH;
        __syncthreads();
#pragma unroll
        for (int j = 0; j < 4; ++j) { const int piece = tid + 512 * j, row = piece >> 4, ch = piece & 15;
            *(LAS u32x4*)(lds + row * VST + ch * 16) = *(const GAS u32x4*)(vv + (tok0 + row) * D + h * 128 + ch * 8); }
        if (c > 0) {
#pragma unroll
            for (int j = 0; j < 2; ++j) { const int piece = tid + 512 * j, row = piece >> 4, ch = piece & 15;
                *(LAS u32x4*)(lds + (128 + row) * VST + ch * 16) = *(const GAS u32x4*)(S + ((size_t)(bh * NCH + c) * DK + row) * DV + ch * 8); } }
#pragma unroll
        for (int j = 0; j < 2; ++j) { const int piece = tid + 512 * j, row = piece >> 3, ch = piece & 7;
            *(LAS u32x4*)(lds + KOFF + row * KST + ch * 16) = *(const GAS u32x4*)(kk + (tok0 + row) * 512 + h * 64 + ch * 8); }
        bf16x8 qf[2];
#pragma unroll
        for (int s = 0; s < 2; ++s) qf[s] = *(const GAS bf16x8*)(qq + (tok0 + 16 * w + li) * 512 + h * 64 + 32 * s + 8 * g);
        __syncthreads();
        f32x4 pt[8];
#pragma unroll
        for (int t = 0; t < 8; ++t) {
            pt[t] = (f32x4){0.f, 0.f, 0.f, 0.f};
            if (t <= w) {
                const bf16x8 k0 = *(const LAS bf16x8*)(lds + KOFF + (16 * t + li) * KST + (8 * g) * 2), k1 = *(const LAS bf16x8*)(lds + KOFF + (16 * t + li) * KST + (32 + 8 * g) * 2);
                pt[t] = __builtin_amdgcn_mfma_f32_16x16x32_bf16(k0, qf[0], pt[t], 0, 0, 0);
                pt[t] = __builtin_amdgcn_mfma_f32_16x16x32_bf16(k1, qf[1], pt[t], 0, 0, 0);
                if (t == w) {
#pragma unroll
                    for (int r = 0; r < 4; ++r) if (4 * g + r > li) pt[t][r] = 0.f; }
            }
        }
        f32x4 acc[8];
#pragma unroll
        for (int n = 0; n < 8; ++n) acc[n] = (f32x4){0.f, 0.f, 0.f, 0.f};
#pragma unroll
        for (int s2 = 0; s2 < 4; ++s2) {
            if (2 * s2 <= w) {
                u32x4 pw; pw.x = cvt_pk_bf16(pt[2 * s2][0], pt[2 * s2][1]); pw.y = cvt_pk_bf16(pt[2 * s2][2], pt[2 * s2][3]);
                pw.z = cvt_pk_bf16(pt[2 * s2 + 1][0], pt[2 * s2 + 1][1]); pw.w = cvt_pk_bf16(pt[2 * s2 + 1][2], pt[2 * s2 + 1][3]);
                const bf16x8 pa = __builtin_bit_cast(bf16x8, pw);
#pragma unroll
                for (int n = 0; n < 8; ++n) {
                    const s16x4 lo = tr_read(lds + (32 * s2 + 4 * g + q4) * VST + (16 * n + 4 * p4) * 2), hi = tr_read(lds + (32 * s2 + 16 + 4 * g + q4) * VST + (16 * n + 4 * p4) * 2);
                    const bf16x8 vf = __builtin_shufflevector(lo, hi, 0, 1, 2, 3, 4, 5, 6, 7);
                    acc[n] = __builtin_amdgcn_mfma_f32_16x16x32_bf16(pa, vf, acc[n], 0, 0, 0);
                }
            }
        }
        if (c > 0) {
#pragma unroll
            for (int s = 0; s < 2; ++s)
#pragma unroll
                for (int n = 0; n < 8; ++n) {
                    const s16x4 lo = tr_read(lds + (128 + 32 * s + 8 * g + q4) * VST + (16 * n + 4 * p4) * 2), hi = tr_read(lds + (128 + 32 * s + 8 * g + 4 + q4) * VST + (16 * n + 4 * p4) * 2);
                    const bf16x8 sf = __builtin_shufflevector(lo, hi, 0, 1, 2, 3, 4, 5, 6, 7);
                    acc[n] = __builtin_amdgcn_mfma_f32_16x16x32_bf16(qf[s], sf, acc[n], 0, 0, 0);
                }
        }
        float rs[4];
#pragma unroll
        for (int r = 0; r < 4; ++r) { float s = 0.f;
#pragma unroll
            for (int n = 0; n < 8; ++n) s += acc[n][r] * acc[n][r];
            s += __shfl_xor(s, 1); s += __shfl_xor(s, 2); s += __shfl_xor(s, 4); s += __shfl_xor(s, 8);
            rs[r] = 1.0f / sqrtf(s * (1.f / DV) + EPS); }
#pragma unroll
        for (int n = 0; n < 8; ++n) { const int col = h * 128 + 16 * n + li; const float gr = gret[col];
#pragma unroll
            for (int r = 0; r < 4; ++r) { const size_t o = (tok0 + 16 * w + 4 * g + r) * D + col;
                og[o] = f2bf(acc[n][r] * rs[r] * gr * bf2f(sgs[o])); } }
    }
    __syncthreads();
}

__device__ __forceinline__ void bucket_phase(Frame& F, const u32x4* route, u32x2* lists, unsigned* gcnt) {
    LAS int* hist = (LAS int*)(F.lds + HS_OFF); LAS int* base = hist + 32;
    for (int ch = blockIdx.x; ch < T / NTHR; ch += F.G) {
        __syncthreads();
        if (F.tid < 32) hist[F.tid] = 0;
        __syncthreads();
        const int tok = ch * NTHR + F.tid; const u32x4 ro = route[tok];
        const int r0 = atomicAdd((int*)&hist[ro.x], 1), r1 = atomicAdd((int*)&hist[ro.y], 1);
        __syncthreads();
        if (F.tid < 32) base[F.tid] = (int)__hip_atomic_fetch_add(gcnt + F.tid, (unsigned)hist[F.tid], RLX_AGENT);
        __syncthreads();
        lists[(size_t)ro.x * T + base[ro.x] + r0] = (u32x2){(unsigned)tok * 2u, ro.z};
        lists[(size_t)ro.y * T + base[ro.y] + r1] = (u32x2){(unsigned)tok * 2u + 1u, ro.w};
    }
}
__device__ __forceinline__ void moe_tables(Frame& F, unsigned* gcnt) {
    LAS int* tb = (LAS int*)(F.lds + TB_OFF); LAS int* cn = (LAS int*)(F.lds + CN_OFF);
    __syncthreads();
    if (F.tid < 32) cn[F.tid] = (int)__hip_atomic_load(gcnt + F.tid, RLX_AGENT);
    __syncthreads();
    if (F.tid == 0) { int a = 0; for (int e = 0; e < 32; ++e) { tb[e] = a; a += (cn[e] + 255) >> 8; } tb[32] = a; }
    __syncthreads();
}
__device__ __forceinline__ void combine_pass(Frame& F, float* x1, const bf16* Y, bf16* xh3) {
    const int gw = F.vcu * NWAVES + F.wave, NGW = F.G * NWAVES, lane = F.lane;
    for (int m = gw; m < T; m += NGW) {
        GAS f32x4* xr = (GAS f32x4*)(x1 + (size_t)m * D) + lane; const GAS u32x2* y0 = (const GAS u32x2*)(Y + (size_t)m * D) + lane; const GAS u32x2* y1 = (const GAS u32x2*)(Y + (size_t)T * D + (size_t)m * D) + lane;
        f32x4 v[4]; float s = 0.f;
#pragma unroll
        for (int j = 0; j < 4; ++j) { v[j] = xr[64 * j]; const u32x2 a = y0[64 * j], b = y1[64 * j];
            v[j] += (f32x4){bf_lo(a.x), bf_hi(a.x), bf_lo(a.y), bf_hi(a.y)} + (f32x4){bf_lo(b.x), bf_hi(b.x), bf_lo(b.y), bf_hi(b.y)};
            s += (v[j].x * v[j].x + v[j].y * v[j].y) + (v[j].z * v[j].z + v[j].w * v[j].w); xr[64 * j] = v[j]; }
        const float rstd = 1.0f / sqrtf(wave_sum(s) * (1.f / D) + EPS);
        GAS u32x2* o8 = (GAS u32x2*)(xh3 + (size_t)m * D) + lane;
#pragma unroll
        for (int j = 0; j < 4; ++j) { u32x2 o; o.x = cvt_pk_bf16(v[j].x * rstd, v[j].y * rstd); o.y = cvt_pk_bf16(v[j].z * rstd, v[j].w * rstd); o8[64 * j] = o; }
    }
}
__device__ __forceinline__ void final_pass(Frame& F, const float* x3, const float* ssq3, float* out) {
    const int gw = F.vcu * NWAVES + F.wave, NGW = F.G * NWAVES, lane = F.lane;
    const float* gf = F.in[I_GFIN];
    f32x4 gv[4];
#pragma unroll
    for (int j = 0; j < 4; ++j) gv[j] = ((const GAS f32x4*)gf)[lane + 64 * j];
    for (int m = gw; m < T; m += NGW) {
        const float s = wave_sum(lane < 16 ? ssq3[(size_t)m * 16 + lane] : 0.f);
        const float rstd = 1.0f / sqrtf(s * (1.f / D) + EPS);
        const GAS f32x4* xr = (const GAS f32x4*)(x3 + (size_t)m * D) + lane; GAS f32x4* o = (GAS f32x4*)(out + (size_t)m * D) + lane;
#pragma unroll
        for (int j = 0; j < 4; ++j) o[64 * j] = xr[64 * j] * rstd * gv[j];
    }
}

constexpr int N_PHASES = 16;
__global__ void __launch_bounds__(NTHR, 2) hyb_fwd(Args args) {
    extern __shared__ __attribute__((aligned(16))) unsigned char lds_raw[];
    Frame F;
    F.lds = (LAS unsigned char*)lds_raw;
    F.tid = threadIdx.x; F.lane = F.tid & 63; F.wave = __builtin_amdgcn_readfirstlane(F.tid >> 6);
    F.G = gridDim.x; { const int bx = blockIdx.x; F.vcu = (F.G % 8 == 0) ? (bx % 8) * (F.G / 8) + bx / 8 : bx; }
#pragma unroll
    for (int i = 0; i < 22; ++i) F.in[i] = args.in[i];
    F.ws = args.ws; F.out = (unsigned char*)args.out;
    unsigned char* ws = args.ws;
    volatile LAS unsigned* MISC = (volatile LAS unsigned*)(F.lds + MISC_OFF);
    for (int u = F.tid; u < (LDS_BYTES - RING_BYTES) / 4; u += NTHR) ((LAS unsigned*)(F.lds + RING_BYTES))[u] = 0u;
    __syncthreads();
    unsigned* ctl = (unsigned*)(ws + WS_CTL);
    const int lo = args.ph_lo, hi = args.ph_hi;
    const bool multi = (hi - lo) > 1;
    XcdBarrier bar; bar.bar = ctl + CW_BAR + args.li * XCD_BAR_WORDS; bar.x = 0; bar.st = nullptr;
    if (multi) bar = xcd_barrier_post(ctl + CW_BAR + args.li * XCD_BAR_WORDS, MISC + 8);
#define IN(k) (lo <= (k) && (k) < hi)
#define SEAM(k) do { if (IN(k) && IN((k) + 1)) xcd_barrier(bar); } while (0)

    bf16* const bufA = (bf16*)(ws + WS_A);
    bf16* const cu = (bf16*)F.out; bf16* const bgb = (bf16*)F.out + (size_t)T * D;
    bf16* const og = (bf16*)F.out; bf16* const mixc = (bf16*)F.out + (size_t)T * D;
    bf16* const Yb = (bf16*)F.out;
    bf16* const qb = (bf16*)(ws + WS_Q); bf16* const kb = (bf16*)(ws + WS_K); bf16* const vb = (bf16*)(ws + WS_V); bf16* const sgb = (bf16*)(ws + WS_SG);
    bf16* const mcb = (bf16*)(ws + WS_MC); bf16* const mrb = (bf16*)(ws + WS_MR); bf16* const Sb = (bf16*)(ws + WS_S);
    bf16* const mixed = (bf16*)(ws + WS_Q); bf16* const ppb = (bf16*)(ws + WS_Q);
    float* const x1 = (float*)(ws + WS_V); bf16* const hid = (bf16*)(ws + WS_MC);
    float* const ssq1 = (float*)(ws + WS_SSQ1); float* const ssqp = (float*)(ws + WS_SSQP); float* const ssq3 = (float*)(ws + WS_SSQ3);
    u32x4* const route = (u32x4*)(ws + WS_ROUTE); u32x2* const lists = (u32x2*)(ws + WS_LIST); float* const rstd2 = (float*)(ws + WS_RSTD2);
    unsigned* const gcnt = ctl + CW_CNT;
    const LAS int* tb = (const LAS int*)(F.lds + TB_OFF); const LAS int* cn = (const LAS int*)(F.lds + CN_OFF);

    if (IN(0)) { p0_prologue(F); } SEAM(0);
    if (IN(1)) { pg8::StaticOrder S; S.init(bufA, ws + W_IN, T, NIN, D, F.G, (int)blockIdx.x);
        EpiG1 E{cu, bgb, qb, kb, vb, sgb, mcb, mrb, (const f32x2*)(ws + WS_ROPE)};
        pg8::gemm_phase(F.lds, D, S, E); } SEAM(1);
    if (IN(2)) { conv_pass(F, cu, bgb, bufA); }
    if (IN(3)) { state_scan(F, kb, vb, Sb); } SEAM(3);
    if (IN(4)) { ret_out(F, qb, kb, vb, Sb, sgb, og); }
    if (IN(5)) { pg8::StaticOrder S; S.init(bufA, ws + W_OC, T, D, D, F.G, (int)blockIdx.x);
        EpiGate<0> E{mcb, nullptr, mixc};
        pg8::gemm_phase(F.lds, D, S, E); } SEAM(5);
    if (IN(6)) { pg8::StaticOrder S; S.init(og, ws + W_OR, T, D, D, F.G, (int)blockIdx.x);
        EpiGate<1> E{mrb, mixc, mixed};
        pg8::gemm_phase(F.lds, D, S, E); } SEAM(6);
    if (IN(7)) { pg8::StaticOrder S; S.init(mixed, ws + W_O, T, D, D, F.G, (int)blockIdx.x);
        EpiRes E{F.in[I_X], x1, bufA, ssq1};
        pg8::gemm_phase(F.lds, D, S, E); } SEAM(7);
    if (IN(8)) { pg8::StaticOrder S; S.init(bufA, ws + W_R, T, 256, D, F.G, (int)blockIdx.x);
        EpiRoute E{ssq1, F.in[I_BRG], F.in[I_BRE], route, rstd2};
        pg8::gemm_phase(F.lds, D, S, E); } SEAM(8);
    if (IN(9)) { bucket_phase(F, route, lists, gcnt); } SEAM(9);
    if (IN(10)) { moe_tables(F, gcnt);
        MoeSched<true> S{tb, cn, lists, (const char*)bufA, (const char*)(ws + W_GU), (size_t)1024 * 1024 * 2, D, F.G, F.vcu};
        EpiHid E{tb, cn, lists, rstd2, hid};
        pg8::gemm_phase(F.lds, D, S, E); } SEAM(10);
    if (IN(11)) { moe_tables(F, gcnt);
        MoeSched<false> S{tb, cn, lists, (const char*)hid, (const char*)(ws + W_DN), (size_t)1024 * 512 * 2, DE, F.G, F.vcu};
        EpiDown E{tb, cn, lists, Yb};
        pg8::gemm_phase(F.lds, DE, S, E); } SEAM(11);
    if (IN(12)) { combine_pass(F, x1, Yb, bufA); }
    if (IN(13)) { pg8::StaticOrder S; S.init(ws + WS_PB, ws + W_PP, T, D, PLE, F.G, (int)blockIdx.x);
        EpiPP E{ppb, ssqp};
        pg8::gemm_phase(F.lds, PLE, S, E); } SEAM(13);
    if (IN(14)) { pg8::StaticOrder S; S.init(bufA, ws + W_PG, T, D, D, F.G, (int)blockIdx.x);
        EpiPle E{x1, ppb, ssqp, F.in[I_GPOST], ssq3};
        pg8::gemm_phase(F.lds, D, S, E); } SEAM(14);
    if (IN(15)) { final_pass(F, x1, ssq3, (float*)F.out); }
#undef IN
#undef SEAM
}

extern "C" void kernel_launch(void* const* d_in, const int* in_sizes, int n_in, void* d_out, int out_size, void* d_ws, size_t ws_size, hipStream_t stream) {
    static int grid = 0;
    if (grid == 0) {
        if (n_in != 22 || in_sizes[0] != T * D || out_size != T * D || ws_size < WS_END) { fprintf(stderr, "kernel_launch: unexpected shapes / workspace (ws %zu, need %zu)\n", ws_size, (size_t)WS_END); grid = -1; return; }
        int dev = 0, cus = 0, per_cu = 0;
        if (hipGetDevice(&dev) != hipSuccess || hipDeviceGetAttribute(&cus, hipDeviceAttributeMultiprocessorCount, dev) != hipSuccess) { grid = -1; return; }
        if (hipFuncSetAttribute((const void*)hyb_fwd, hipFuncAttributeMaxDynamicSharedMemorySize, LDS_BYTES) != hipSuccess) { fprintf(stderr, "kernel_launch: hipFuncSetAttribute failed\n"); grid = -1; return; }
        if (hipOccupancyMaxActiveBlocksPerMultiprocessor(&per_cu, (const void*)hyb_fwd, NTHR, LDS_BYTES) != hipSuccess || per_cu < 1) { fprintf(stderr, "kernel_launch: occupancy query says %d\n", per_cu); }
        (void)hipGetLastError();
        grid = cus;
    }
    if (grid < 0) return;
    if (hipMemsetAsync((char*)d_ws + WS_CTL, 0, CTL_ZERO_BYTES, stream) != hipSuccess) return;
    Args a{};
    for (int i = 0; i < 22; ++i) a.in[i] = (const float*)d_in[i];
    a.out = (float*)d_out; a.ws = (unsigned char*)d_ws;
#if defined(PROBE_DUP)
    a.ph_lo = 0; a.ph_hi = PROBE_DUP + 1; hipLaunchKernelGGL(hyb_fwd, dim3(grid), dim3(NTHR), LDS_BYTES, stream, a);
    a.li = 1; a.ph_lo = PROBE_DUP; a.ph_hi = PROBE_DUP + 1; hipLaunchKernelGGL(hyb_fwd, dim3(grid), dim3(NTHR), LDS_BYTES, stream, a);
    a.li = 2; a.ph_lo = PROBE_DUP + 1; a.ph_hi = N_PHASES; hipLaunchKernelGGL(hyb_fwd, dim3(grid), dim3(NTHR), LDS_BYTES, stream, a);
#else
    a.ph_lo = 0; a.ph_hi = N_PHASES;
    hipLaunchKernelGGL(hyb_fwd, dim3(grid), dim3(NTHR), LDS_BYTES, stream, a);
#endif
}
```

```cpp
#include <hip/hip_runtime.h>
#include <cstdio>
#include <cstdint>

#define LAS __attribute__((address_space(3)))
#define GAS __attribute__((address_space(1)))
typedef unsigned short bf16;
typedef short bf16x8 __attribute__((ext_vector_type(8)));
typedef short s16x4 __attribute__((ext_vector_type(4)));
typedef float f32x4 __attribute__((ext_vector_type(4)));
typedef float f32x2 __attribute__((ext_vector_type(2)));
typedef unsigned u32x4 __attribute__((ext_vector_type(4)));
typedef unsigned u32x2 __attribute__((ext_vector_type(2)));
typedef int v4i32 __attribute__((ext_vector_type(4)));
typedef int v8i32 __attribute__((ext_vector_type(8)));
typedef GAS unsigned gu32;
#define RLX_AGENT __ATOMIC_RELAXED, __HIP_MEMORY_SCOPE_AGENT

constexpr int D = 1024, NB = 8, SEQ = 8192, T = NB * SEQ, PLE = 256;
constexpr int NH = 8, DK = 64, DV = 128, CH = 128, NCH = SEQ / CH;
constexpr int NE = 32, DE = 512;
constexpr int NIN = 8192;
constexpr float EPS = 1e-6f;
constexpr int NWAVES = 8, NTHR = 512;

constexpr size_t MiB = 1u << 20;
constexpr size_t WS_CMAX = 64 * 1024, WS_SB = 128 * 1024;
constexpr size_t WS_CTL = 0, CTL_ZERO_BYTES = 128 * 1024;
constexpr size_t WS_ROUTE = 1 * MiB;
constexpr size_t WS_ROPE = 2 * MiB;
constexpr size_t WS_SSQ1 = 4 * MiB;
constexpr size_t WS_SSQP = 8 * MiB;
constexpr size_t WS_SSQ3 = 12 * MiB;
constexpr size_t WS_LIST = 840 * MiB;
constexpr size_t WS_W = 32 * MiB;
constexpr size_t W_IN = WS_W;
constexpr size_t W_OC = W_IN + 16 * MiB;
constexpr size_t W_OR = W_OC + 2 * MiB;
constexpr size_t W_O = W_OR + 2 * MiB;
constexpr size_t W_PG = W_O + 2 * MiB;
constexpr size_t W_PP = W_PG + 2 * MiB;
constexpr size_t W_R = W_PP + 1 * MiB;
constexpr size_t W_IN8 = W_IN + 10 * MiB;
constexpr size_t W_GU = W_R + 1 * MiB;
constexpr size_t W_DN = W_GU + 64 * MiB;
constexpr size_t WS_RSTD2 = W_DN + 32 * MiB;
constexpr size_t WS_A = 155 * MiB;
constexpr size_t WS_PB = 283 * MiB;
constexpr size_t WS_Q = 315 * MiB;
constexpr size_t WS_K = 379 * MiB;
constexpr size_t WS_V = 443 * MiB;
constexpr size_t WS_SG = 571 * MiB;
constexpr size_t WS_MC = 699 * MiB;
constexpr size_t WS_MR = 827 * MiB;
constexpr size_t WS_S = 955 * MiB;
constexpr size_t WS_END = 1019 * MiB;
static_assert(WS_RSTD2 + (size_t)T * 4 <= WS_A, "ws map");

constexpr int CW_CNT = 64;
constexpr int CW_BAR = 4096;

constexpr int RING_BYTES = 131072;
constexpr int MISC_OFF = RING_BYTES;
constexpr int TB_OFF = RING_BYTES + 256;
constexpr int CN_OFF = RING_BYTES + 512;
constexpr int HS_OFF = RING_BYTES + 768;
constexpr int TE_OFF = RING_BYTES + 1536;
constexpr int CWL_OFF = RING_BYTES + 4096;
constexpr int LDS_BYTES = 147456;

typedef __bf16 bf16x2_t __attribute__((ext_vector_type(2)));
__device__ __forceinline__ unsigned cvt_pk_bf16(float lo, float hi) { const f32x2 v = {lo, hi}; const bf16x2_t b = __builtin_convertvector(v, bf16x2_t); return __builtin_bit_cast(unsigned, b); }
__device__ __forceinline__ float bf_lo(unsigned u) { return __uint_as_float(u << 16); }
__device__ __forceinline__ float bf_hi(unsigned u) { return __uint_as_float(u & 0xffff0000u); }
__device__ __forceinline__ float bf2f(bf16 b) { return __uint_as_float(((unsigned)b) << 16); }
__device__ __forceinline__ bf16 f2bf(float f) { unsigned u = __float_as_uint(f); return (bf16)((u + 0x7fffu + ((u >> 16) & 1u)) >> 16); }
__device__ __forceinline__ u32x4 pack8(const f32x4 a, const f32x4 b) { u32x4 w; w.x = cvt_pk_bf16(a[0], a[1]); w.y = cvt_pk_bf16(a[2], a[3]); w.z = cvt_pk_bf16(b[0], b[1]); w.w = cvt_pk_bf16(b[2], b[3]); return w; }
__device__ __forceinline__ void unpack8(const u32x4 w, f32x4& a, f32x4& b) { a = (f32x4){bf_lo(w.x), bf_hi(w.x), bf_lo(w.y), bf_hi(w.y)}; b = (f32x4){bf_lo(w.z), bf_hi(w.z), bf_lo(w.w), bf_hi(w.w)}; }
__device__ __forceinline__ void st16_wt(bf16* base, size_t off, const u32x4 v) { __builtin_nontemporal_store(v, (GAS u32x4*)(base + off)); }
__device__ __forceinline__ unsigned rot8(unsigned v) { return (unsigned)__builtin_amdgcn_update_dpp(0, (int)v, 0x128, 0xf, 0xf, false); }
__device__ __forceinline__ u32x4 rot8v(const u32x4 v) { u32x4 r; r.x = rot8(v.x); r.y = rot8(v.y); r.z = rot8(v.z); r.w = rot8(v.w); return r; }
__device__ __forceinline__ void st_lines(bf16* base, unsigned rowoff  , const u32x4 a0, const u32x4 a1, int fr, int fq) {
    const bool hi = fr >= 8; const unsigned ro_r = rot8(rowoff); const u32x4 r0 = rot8v(a0), r1 = rot8v(a1);
    const u32x4 X = hi ? r1 : a0, Y = hi ? a1 : r0; const unsigned offX = hi ? ro_r : rowoff, offY = hi ? rowoff : ro_r, seg = (unsigned)(fq + (hi ? 4 : 0)) * 8u;
    st16_wt(base, offX + seg, X); st16_wt(base, offY + seg, Y);
}
__device__ __forceinline__ u32x2 pack8_fp8(const f32x4 a, const f32x4 b) {
    auto cl = [](float x) { return fminf(fmaxf(x, -448.f), 448.f); };
    int lo = __builtin_amdgcn_cvt_pk_fp8_f32(cl(a[0]), cl(a[1]), 0, false); lo = __builtin_amdgcn_cvt_pk_fp8_f32(cl(a[2]), cl(a[3]), lo, true);
    int hi = __builtin_amdgcn_cvt_pk_fp8_f32(cl(b[0]), cl(b[1]), 0, false); hi = __builtin_amdgcn_cvt_pk_fp8_f32(cl(b[2]), cl(b[3]), hi, true);
    return (u32x2){(unsigned)lo, (unsigned)hi};
}
__device__ __forceinline__ void unpack8_fp8(const u32x2 v, f32x4& a, f32x4& b) {
    const f32x2 a0 = __builtin_amdgcn_cvt_pk_f32_fp8((int)v.x, false), a1 = __builtin_amdgcn_cvt_pk_f32_fp8((int)v.x, true), b0 = __builtin_amdgcn_cvt_pk_f32_fp8((int)v.y, false), b1 = __builtin_amdgcn_cvt_pk_f32_fp8((int)v.y, true);
    a = (f32x4){a0[0], a0[1], a1[0], a1[1]}; b = (f32x4){b0[0], b0[1], b1[0], b1[1]};
}
__device__ __forceinline__ unsigned q8x4(const f32x4 g) { const unsigned a = (unsigned)(g[0] * 255.f + 0.5f), b = (unsigned)(g[1] * 255.f + 0.5f), c = (unsigned)(g[2] * 255.f + 0.5f), d = (unsigned)(g[3] * 255.f + 0.5f); return a | (b << 8) | (c << 16) | (d << 24); }
__device__ __forceinline__ f32x4 dq8x4(const unsigned w) { return (f32x4){(float)(w & 0xffu), (float)((w >> 8) & 0xffu), (float)((w >> 16) & 0xffu), (float)(w >> 24)} * (1.0f / 255.0f); }
__device__ __forceinline__ unsigned gate8_off(int tile, int wid, int grp, int lane) { return (unsigned)((((tile * 8 + wid) * 8 + grp) * 64 + lane) * 16); }
__device__ __forceinline__ unsigned qb8x4(const f32x4 v, const float qs) { const unsigned a = (unsigned)(int)(__builtin_rintf(v[0] * qs) + 128.f), b = (unsigned)(int)(__builtin_rintf(v[1] * qs) + 128.f), c = (unsigned)(int)(__builtin_rintf(v[2] * qs) + 128.f), d = (unsigned)(int)(__builtin_rintf(v[3] * qs) + 128.f); return a | (b << 8) | (c << 16) | (d << 24); }
__device__ __forceinline__ f32x4 dqb8x4(const unsigned w, const float sc, const float off) { return (f32x4){(float)(w & 0xffu), (float)((w >> 8) & 0xffu), (float)((w >> 16) & 0xffu), (float)(w >> 24)} * sc + off; }
__device__ __forceinline__ void q64_store(unsigned char* q8, float* scl, int blk, int fr, int fq, const f32x4 a0, const f32x4 a1, const f32x4 b0, const f32x4 b1) {
    float mx = 0.f;
#pragma unroll
    for (int e = 0; e < 4; ++e) mx = fmaxf(fmaxf(mx, fmaxf(fabsf(a0[e]), fabsf(a1[e]))), fmaxf(fabsf(b0[e]), fabsf(b1[e])));
    const int ln = fq * 16 + fr;
    mx = fmaxf(mx, __int_as_float(__builtin_amdgcn_ds_bpermute((ln ^ 16) << 2, __float_as_int(mx)))); mx = fmaxf(mx, __int_as_float(__builtin_amdgcn_ds_bpermute((ln ^ 32) << 2, __float_as_int(mx))));
    mx = fmaxf(mx, 1e-30f); const float qs = 127.0f / mx;
    const u32x4 o = {qb8x4(a0, qs), qb8x4(a1, qs), qb8x4(b0, qs), qb8x4(b1, qs)};
    *(GAS u32x4*)(q8 + ((size_t)blk * 64 + ln) * 16) = o;
    if (fq == 0) scl[(size_t)blk * 16 + fr] = mx * (1.0f / 127.0f);
}
__device__ __forceinline__ void q64_unpack(const u32x4 w, const float sc, f32x4& a0, f32x4& a1, f32x4& b0, f32x4& b1) { const float off = -128.f * sc; a0 = dqb8x4(w.x, sc, off); a1 = dqb8x4(w.y, sc, off); b0 = dqb8x4(w.z, sc, off); b1 = dqb8x4(w.w, sc, off); }
__device__ __forceinline__ float sigmoidf_(float x) { return __builtin_amdgcn_rcpf(1.0f + __expf(-x)); }
__device__ __forceinline__ float siluf_(float x) { return x * __builtin_amdgcn_rcpf(1.0f + __expf(-x)); }
__device__ __forceinline__ float wave_sum(float v) {
#pragma unroll
    for (int o = 1; o < 64; o <<= 1) v += __shfl_xor(v, o);
    return v;
}
__device__ __forceinline__ void lds_barrier() { asm volatile("s_waitcnt lgkmcnt(0)" ::: "memory"); __builtin_amdgcn_s_barrier(); asm volatile("" ::: "memory"); }
__device__ __forceinline__ int lane_now() { unsigned z; asm volatile("v_mov_b32 %0, 0" : "=v"(z)); return (int)__builtin_amdgcn_mbcnt_hi(~0u, __builtin_amdgcn_mbcnt_lo(~0u, z)); }
__device__ __forceinline__ float fq_sum(float s, int fr, int fq) { const int ln = fq * 16 + fr;
    s += __int_as_float(__builtin_amdgcn_ds_bpermute((ln ^ 16) << 2, __float_as_int(s))); s += __int_as_float(__builtin_amdgcn_ds_bpermute((ln ^ 32) << 2, __float_as_int(s))); return s; }
__device__ __forceinline__ s16x4 tr_read(LAS const char* p) { return __builtin_bit_cast(s16x4, __builtin_amdgcn_ds_read_tr16_b64_v4i16((LAS s16x4*)p)); }

__constant__ float c_inv_freq[32] = {1.000000000e+00f, 7.498942018e-01f, 5.623413324e-01f, 4.216965139e-01f, 3.162277639e-01f, 2.371373773e-01f, 1.778279394e-01f, 1.333521456e-01f, 1.000000015e-01f, 7.498942316e-02f, 5.623413250e-02f, 4.216964915e-02f, 3.162277490e-02f, 2.371373773e-02f, 1.778279431e-02f, 1.333521400e-02f, 9.999999776e-03f, 7.498942316e-03f, 5.623413250e-03f, 4.216964822e-03f, 3.162277630e-03f, 2.371373819e-03f, 1.778279431e-03f, 1.333521446e-03f, 1.000000047e-03f, 7.498941850e-04f, 5.623413017e-04f, 4.216965172e-04f, 3.162277571e-04f, 2.371373703e-04f, 1.778279402e-04f, 1.333521504e-04f};
__device__ __forceinline__ float lg2_gamma(int h) {
    const float t[8] = {-4.580368961312e-02f, -2.272007650008e-02f, -1.131531322783e-02f, -5.646563141142e-03f, -2.820519062379e-03f, -1.409570254671e-03f, -7.046129765894e-04f, -3.522634716290e-04f};
    float r = t[0];
#pragma unroll
    for (int i = 1; i < 8; ++i) r = (h == i) ? t[i] : r;
    return r;
}

namespace pg8 {
constexpr int BM = 256, BK = 64, HALF = 128, HTB = HALF * BK * 2, STAGE_BYTES = 8 * HTB, NXCD = 8, WGM = 8;
__host__ __device__ __forceinline__ int lds_byte(int r, int c) { const int st = (r >> 4) * 2 + (c >> 5), rr = r & 15, cc = c & 31, ob = rr * 64 + cc * 2; return st * 1024 + (ob ^ (((ob >> 9) & 1) << 5)); }
__host__ __device__ __forceinline__ void stage_rc(int b, int& R, int& C) { const int st = b / 1024, sb = b % 1024, swz = sb ^ (((sb >> 9) & 1) << 5); R = (st >> 1) * 16 + swz / 64; C = (st & 1) * 32 + (swz % 64) / 2; }
__host__ __device__ __forceinline__ int perm32(int rho) { const int n = rho >> 4, i = rho & 15; return 8 * (i >> 2) + 4 * n + (i & 3); }

struct Unit { int pm, pn, aux; };

struct StaticOrder {
    static constexpr bool GATHER = false, ATILED = false;
    int nM, nN, nwg, G, c; const char* A; const char* B; size_t tstep;
    __device__ void init(const void* A_, const void* B_, int M, int N, int K, int G_, int c_) { nM = M / BM; nN = N / BM; nwg = nM * nN; G = G_; c = c_; A = (const char*)A_; B = (const char*)B_; tstep = (size_t)BM * K * 2; }
    __device__ bool next(int i, Unit& u) const {
        const long L = (long)i * G + c; if (L >= nwg) return false;
        int wgid = (int)L; { const int q = nwg / NXCD, r = nwg % NXCD, xcd = wgid % NXCD, off = wgid / NXCD; wgid = (xcd < r ? xcd * (q + 1) : r * (q + 1) + (xcd - r) * q) + off; }
        const int nig = WGM * nN, gid = wgid / nig, fm = gid * WGM, gsz = (nM - fm) < WGM ? (nM - fm) : WGM;
        u.pm = fm + ((wgid % nig) % gsz); u.pn = (wgid % nig) / gsz; u.aux = 0; return true;
    }
    __device__ __forceinline__ void ptrs(const Unit& u, const char*& a, const char*& b) const { a = A + (size_t)u.pm * tstep; b = B + (size_t)u.pn * tstep; }
    __device__ __forceinline__ void goff(const Unit&, int, int, int, int, unsigned (&)[2][2]) const {}
};

#define PG8_SA(b, h) (((b) * 2 + (h)) * HTB)
#define PG8_SB(b, h) ((4 + (b) * 2 + (h)) * HTB)
#define PG8_GLDS(base, voff, dstoff) do { unsigned _v = (voff); asm volatile("" : "+v"(_v)); __builtin_amdgcn_global_load_lds((const unsigned*)((base) + _v), (LAS unsigned*)(lds + (dstoff)), 16, 0, 0); } while (0)
#define PG8_STAGE_B(bufoff, gbase, h) do { _Pragma("unroll") for (int _i = 0; _i < 2; ++_i) PG8_GLDS((gbase) + (size_t)(h) * hstepB, voffB[_i], (bufoff) + ldsw + _i * 8192); } while (0)
#define PG8_STAGE_A(bufoff, gbase, h) do { if constexpr (Sched::GATHER) { _Pragma("unroll") for (int _i = 0; _i < 2; ++_i) PG8_GLDS((gbase), vg[h][_i], (bufoff) + ldsw + _i * 8192); } \
        else { _Pragma("unroll") for (int _i = 0; _i < 2; ++_i) PG8_GLDS((gbase) + (size_t)(h) * hstep, voffA[_i], (bufoff) + ldsw + _i * 8192); } } while (0)
#define PG8_LDA(dst, b, h) do { _Pragma("unroll") for (int m = 0; m < 4; ++m) frag_load<Epi::FP8>(dst[m], lds + PG8_SA(b, h) + aoff + m * 2048); } while (0)
#define PG8_LDB(dst, b, h) do { _Pragma("unroll") for (int n = 0; n < 2; ++n) frag_load<Epi::FP8>(dst[n], lds + PG8_SB(b, h) + boff + n * 2048); } while (0)
#define PG8_MMA(ai, bj, At, Bt) do { __builtin_amdgcn_s_setprio(1); _Pragma("unroll") for (int m = 0; m < 4; ++m) _Pragma("unroll") for (int n = 0; n < 2; ++n) \
        acc[ai][bj][m][n] = frag_mma<Epi::FP8, BScale<Epi>::v, IsI8<Epi>::v>(Bt[n], At[m], acc[ai][bj][m][n]); __builtin_amdgcn_s_setprio(0); } while (0)
#define PG8_WAIT_V(n) asm volatile("s_waitcnt vmcnt(" #n ")" ::: "memory")
#define PG8_WAIT_L(n) asm volatile("s_waitcnt lgkmcnt(" #n ")" ::: "memory")
#define PG8_BAR __builtin_amdgcn_s_barrier()
#define PG8_SCHED __builtin_amdgcn_sched_barrier(0)

struct FragBf { bf16x8 p[2]; };
template <bool F8> struct FragT { typedef FragBf type; };
template <> struct FragT<true> { typedef v8i32 type; };
template <bool F8> __device__ __forceinline__ void frag_load(typename FragT<F8>::type& d, const LAS unsigned char* p) {
    if constexpr (F8) d = __builtin_shufflevector(*(const LAS v4i32*)p, *(const LAS v4i32*)(p + 16), 0, 1, 2, 3, 4, 5, 6, 7);
    else { d.p[0] = *(const LAS bf16x8*)p; d.p[1] = *(const LAS bf16x8*)(p + 1024); }
}
template <class E, bool F8 = E::FP8> struct BScale { static constexpr int v = 0x7f7f7f7f; };
template <class E> struct BScale<E, true> { static constexpr int v = E::BSC; };
template <class E, class = void> struct IsI8 { static constexpr bool v = false; };
template <class E> struct IsI8<E, decltype((void)E::I8)> { static constexpr bool v = E::I8; };
template <bool F8, int SB, bool I8> __device__ __forceinline__ f32x4 frag_mma(const typename FragT<F8>::type& b, const typename FragT<F8>::type& a, f32x4 c) {
    if constexpr (I8) { v4i32 ci = __builtin_bit_cast(v4i32, c);
        ci = __builtin_amdgcn_mfma_i32_16x16x64_i8(__builtin_bit_cast(v4i32, b.p[0]), __builtin_bit_cast(v4i32, a.p[0]), ci, 0, 0, 0);
        ci = __builtin_amdgcn_mfma_i32_16x16x64_i8(__builtin_bit_cast(v4i32, b.p[1]), __builtin_bit_cast(v4i32, a.p[1]), ci, 0, 0, 0); return __builtin_bit_cast(f32x4, ci); }
    else if constexpr (F8) return __builtin_amdgcn_mfma_scale_f32_16x16x128_f8f6f4(b, a, c, 0, 0, 0, SB, 0, SB);
    else { c = __builtin_amdgcn_mfma_f32_16x16x32_bf16(b.p[0], a.p[0], c, 0, 0, 0); return __builtin_amdgcn_mfma_f32_16x16x32_bf16(b.p[1], a.p[1], c, 0, 0, 0); }
}
template <class Epi, class Sched>
__device__ __forceinline__ void gemm_phase(LAS unsigned char* lds, const int wid, const int K, const Sched& S, const Epi& E, const int noepi = 0, const int delay = 0) {
    if (delay > 0) { const unsigned long long t0 = __builtin_amdgcn_s_memrealtime(); while (__builtin_amdgcn_s_memrealtime() - t0 < (unsigned long long)delay) __builtin_amdgcn_s_sleep(16); }
    const int lane = lane_now(), tid = wid * 64 + lane, wr = wid >> 2, wc = wid & 3, fr = lane & 15, fq = lane >> 4;
    const int nt = K / BK;
    unsigned voffA[2], voffB[2]; int Rr[2], Cc[2];
#pragma unroll
    for (int i = 0; i < 2; ++i) { int R, C; stage_rc(tid * 16 + i * 8192, R, C); const int Rb = Epi::ADJ ? 64 * (R >> 5) + perm32(R & 31) : (R & ~31) + perm32(R & 31); Rr[i] = R; Cc[i] = C;
        voffA[i] = Sched::ATILED ? (unsigned)((((R >> 4) * 8 + (R & 7)) * 1024) + (C >> 5) * 64 + ((R >> 3) & 1) * 32 + (C & 31)) * 2u : (unsigned)(R * K + C) * 2u; voffB[i] = (unsigned)(Rb * K + C) * 2u; }
    const size_t hstepB = Epi::ADJ ? (size_t)32 * K * 2 : (size_t)HALF * K * 2;
    const size_t kstep = (size_t)(BK * 2);
    const size_t kstepA = Sched::ATILED ? (size_t)256 : (size_t)(BK * 2);
    const size_t hstep = (size_t)HALF * K * 2;
    const unsigned ldsw = (unsigned)wid * 1024u;
    const int aoff = Epi::FP8 ? lds_byte(wr * 64 + fr, (fq & 1) * 16) + (fq >> 1) * 1024 : lds_byte(wr * 64 + fr, fq * 8);
    const int boff = Epi::FP8 ? lds_byte(wc * 32 + fr, (fq & 1) * 16) + (fq >> 1) * 1024 : lds_byte(wc * 32 + fr, fq * 8);
    Unit cur, nxt; int ui = 0;
    if (!S.next(0, cur)) return;
    f32x4 acc[2][2][4][2];
#pragma unroll
    for (int a = 0; a < 2; ++a)
#pragma unroll
        for (int b = 0; b < 2; ++b)
#pragma unroll
            for (int m = 0; m < 4; ++m)
#pragma unroll
                for (int n = 0; n < 2; ++n) acc[a][b][m][n] = (f32x4){0.f, 0.f, 0.f, 0.f};
    typedef typename FragT<Epi::FP8>::type frag_t;
    frag_t At[4], B0[2], B1[2];
    const char *cA, *cB; S.ptrs(cur, cA, cB);
    unsigned vg[2][2] = {{0u, 0u}, {0u, 0u}}, vn[2][2] = {{0u, 0u}, {0u, 0u}};
    if constexpr (Sched::GATHER) S.goff(cur, Rr[0], Rr[1], Cc[0], Cc[1], vg);
    PG8_STAGE_B(PG8_SB(0, 0), cB, 0); PG8_STAGE_B(PG8_SB(0, 1), cB, 1); PG8_STAGE_A(PG8_SA(0, 0), cA, 0); PG8_STAGE_A(PG8_SA(0, 1), cA, 1);
    if (wr == 1) PG8_BAR;
    PG8_WAIT_V(2); PG8_BAR;
    PG8_STAGE_B(PG8_SB(1, 0), cB + kstep, 0); PG8_STAGE_A(PG8_SA(1, 0), cA + kstepA, 0); PG8_STAGE_B(PG8_SB(1, 1), cB + kstep, 1);
    PG8_WAIT_V(6); PG8_BAR;
    for (;;) {
        const bool has_next = S.next(ui + 1, nxt);
        const char *nA = cA, *nB = cB; if (has_next) S.ptrs(nxt, nA, nB);
        if constexpr (Sched::GATHER) {
#pragma unroll
            for (int h = 0; h < 2; ++h)
#pragma unroll
                for (int i = 0; i < 2; ++i) vn[h][i] = vg[h][i];
            if (has_next) S.goff(nxt, Rr[0], Rr[1], Cc[0], Cc[1], vn);
        }
#pragma nounroll
        for (int t = 0; t < nt; t += 2) {
            const bool last = (t == nt - 2);
            const char* a1 = cA + (size_t)(t + 1) * kstepA;
            const char* a2 = last ? nA : cA + (size_t)(t + 2) * kstepA; const char* b2 = last ? nB : cB + (size_t)(t + 2) * kstep;
            const char* a3 = a2 + kstepA; const char* b3 = b2 + kstep;
            PG8_LDB(B0, 0, 0); PG8_LDB(B1, 0, 1); PG8_SCHED; PG8_LDA(At, 0, 0); PG8_STAGE_A(PG8_SA(1, 1), a1, 1);
            if constexpr (Sched::GATHER) { if (last) {
#pragma unroll
                for (int h = 0; h < 2; ++h)
#pragma unroll
                    for (int i = 0; i < 2; ++i) vg[h][i] = vn[h][i]; } }
            PG8_WAIT_V(8); PG8_WAIT_L(0); PG8_BAR; PG8_MMA(0, 0, At, B0); PG8_MMA(0, 1, At, B1); PG8_BAR; PG8_SCHED;
            PG8_LDA(At, 0, 1); PG8_STAGE_B(PG8_SB(0, 0), b2, 0); PG8_STAGE_B(PG8_SB(0, 1), b2, 1); PG8_STAGE_A(PG8_SA(0, 0), a2, 0);
            PG8_WAIT_V(8); PG8_WAIT_L(0); PG8_BAR; PG8_MMA(1, 0, At, B0); PG8_MMA(1, 1, At, B1); PG8_BAR; PG8_SCHED;
            PG8_LDB(B0, 1, 0); PG8_LDB(B1, 1, 1); PG8_SCHED; PG8_LDA(At, 1, 0); PG8_STAGE_A(PG8_SA(0, 1), a2, 1);
            PG8_WAIT_V(8); PG8_WAIT_L(0); PG8_BAR; PG8_MMA(0, 0, At, B0); PG8_MMA(0, 1, At, B1); PG8_BAR; PG8_SCHED;
            PG8_LDA(At, 1, 1); PG8_STAGE_B(PG8_SB(1, 0), b3, 0); PG8_STAGE_B(PG8_SB(1, 1), b3, 1); PG8_STAGE_A(PG8_SA(1, 0), a3, 0);
            PG8_WAIT_V(8); PG8_WAIT_L(0); PG8_BAR; PG8_MMA(1, 0, At, B0); PG8_MMA(1, 1, At, B1); PG8_BAR; PG8_SCHED;
        }
        if (wr == 0) PG8_BAR;
        { Unit ue = cur; asm volatile("" : "+v"(ue.pm), "+v"(ue.pn), "+v"(ue.aux)); ue.pm = __builtin_amdgcn_readfirstlane(ue.pm); ue.pn = __builtin_amdgcn_readfirstlane(ue.pn); ue.aux = __builtin_amdgcn_readfirstlane(ue.aux);
          const int lane_e = lane_now();
          const int fr_e = lane_e & 15, fq_e = lane_e >> 4;
          if constexpr (IsI8<Epi>::v) { E.dequant(acc, ue, wr, wc, fr_e, fq_e); asm volatile("" ::: "memory"); __builtin_amdgcn_sched_barrier(0); }
          if (noepi != 1) E(acc, ue, wr, wc, fr_e, fq_e); }
        if (!has_next) break;
#pragma unroll
        for (int a = 0; a < 2; ++a)
#pragma unroll
            for (int b = 0; b < 2; ++b)
#pragma unroll
                for (int m = 0; m < 4; ++m)
#pragma unroll
                    for (int n = 0; n < 2; ++n) acc[a][b][m][n] = (f32x4){0.f, 0.f, 0.f, 0.f};
        cur = nxt; cA = nA; cB = nB; ++ui;
        if (wr == 1) PG8_BAR;
    }
    PG8_WAIT_V(0);
    PG8_BAR;
}
}
using pg8::Unit;
typedef f32x4 Acc[2][2][4][2];

#define XB_TMO      128
#define XB_XCNT(j)  (256  + 64 * (j))
#define XB_XSUB(j)  (1280 + 64 * (j))
#define XB_XGEN(j)  (2304 + 64 * (j))
#define XB_TOP      3328
#define XB_TOPGEN   3392
#define XCD_BAR_WORDS 3456
#define XB_SPIN_CAP (1u << 18)
__device__ __forceinline__ unsigned xb_ld(unsigned* p)              { return __hip_atomic_load(p, __ATOMIC_RELAXED, __HIP_MEMORY_SCOPE_AGENT); }
__device__ __forceinline__ unsigned xb_add(unsigned* p, unsigned v) { return __hip_atomic_fetch_add(p, v, __ATOMIC_RELAXED, __HIP_MEMORY_SCOPE_AGENT); }
__device__ __forceinline__ unsigned xb_xcc_id() { return (unsigned)__builtin_amdgcn_s_getreg((3 << 11) | 20) & 0xFu; }
#define XB_SPIN(cond, bar) do { unsigned _sp = 0; while (cond) { __builtin_amdgcn_s_sleep(1); \
    if ((++_sp & 255u) == 0u) { if (xb_ld(&(bar)[XB_TMO])) break; if (_sp > XB_SPIN_CAP) { atomicAdd(&(bar)[XB_TMO], 1u); break; } } } } while (0)
struct XcdBarrier { unsigned* bar; unsigned x; volatile LAS unsigned* st; };
__device__ __forceinline__ XcdBarrier xcd_barrier_post(unsigned* bar, volatile LAS unsigned* st, const int wave) {
    XcdBarrier b; b.bar = bar; b.x = xb_xcc_id(); b.st = st;
    if (wave == 0 && lane_now() == 0) (void)xb_add(&bar[XB_XCNT(b.x)], 1u);
    return b;
}
__device__ __forceinline__ void xcd_barrier_complete(unsigned* bar, unsigned x, unsigned& nloc, unsigned& nx) {
    const unsigned G = gridDim.x * gridDim.y * gridDim.z;
    unsigned sum, cnt, mine, sp = 0u;
    for (;;) {
        sum = 0u; cnt = 0u; mine = 0u;
#pragma unroll
        for (unsigned j = 0; j < 16; ++j) { const unsigned c = xb_ld(&bar[XB_XCNT(j)]); sum += c; cnt += (c > 0u) ? 1u : 0u; mine = (j == x) ? c : mine; }
        if (sum == G) break;
        __builtin_amdgcn_s_sleep(1);
        if ((++sp & 255u) == 0u) { if (xb_ld(&bar[XB_TMO])) break; if (sp > XB_SPIN_CAP) { atomicAdd(&bar[XB_TMO], 1u); break; } }
    }
    nloc = mine > 0u ? mine : 1u; nx = cnt > 0u ? cnt : 1u;
}
__device__ __forceinline__ void xcd_barrier(const XcdBarrier& b, const int wave) {
    asm volatile("s_waitcnt vmcnt(0)" ::: "memory");
    __syncthreads();
    if (wave == 0 && lane_now() == 0) {
        unsigned* bar = b.bar;
        __builtin_amdgcn_s_waitcnt(0);
        unsigned nloc = b.st[0], nx = b.st[1];
        if (nloc == 0u) { xcd_barrier_complete(bar, b.x, nloc, nx); b.st[0] = nloc; b.st[1] = nx; }
        const unsigned old = xb_add(&bar[XB_XSUB(b.x)], 1u);
        const unsigned gen = old / nloc;
        if (old + 1u == (gen + 1u) * nloc) {
            __builtin_amdgcn_fence(__ATOMIC_RELEASE, "agent");
            asm volatile("s_waitcnt vmcnt(0)" ::: "memory");
            const unsigned og = xb_add(&bar[XB_TOP], 1u);
            const unsigned tg = og / nx;
            if (og + 1u == (tg + 1u) * nx) xb_add(&bar[XB_TOPGEN], 1u);
            else XB_SPIN(xb_ld(&bar[XB_TOPGEN]) == tg, bar);
            __builtin_amdgcn_fence(__ATOMIC_ACQUIRE, "agent");
            xb_add(&bar[XB_XGEN(b.x)], 1u);
            asm volatile("s_waitcnt vmcnt(0)" ::: "memory");
        } else {
            XB_SPIN(xb_ld(&bar[XB_XGEN(b.x)]) == gen, bar);
            __builtin_amdgcn_fence(__ATOMIC_ACQUIRE, "agent");
            asm volatile("s_waitcnt vmcnt(0)" ::: "memory");
        }
    }
    __syncthreads();
}

struct Args { const float* in[22]; float* out; unsigned char* ws; int ph_lo, ph_hi, li, noepi; };
struct Frame {
    LAS unsigned char* lds;
    int wave, vcu, G;
    __device__ __forceinline__ int tid() const { return wave * 64 + lane_now(); }
    __device__ __forceinline__ int lane() const { return lane_now(); }
    const float* in[22]; unsigned char* ws; unsigned char* out;
};
enum { I_X = 0, I_P, I_GMIX, I_WIN, I_CONVW, I_GRET, I_WOC, I_WOR, I_WO, I_GMOE, I_WRG, I_BRG, I_WRE, I_BRE, I_WG, I_WU, I_WD, I_GPIN, I_WPG, I_WPP, I_GPOST, I_GFIN };

__device__ __forceinline__ void p0_transpose_item(const float* W, int ldw, const float* g, bf16* WT, int ldt, int k0, int n0, int drow, LAS float* scr, int lane, const float f8scale = 0.f, const float* cmax = nullptr, float* sbw = nullptr) {
    f32x4 v[8]; float gs[8];
    const int c4 = lane & 7, kr = lane >> 3;
#pragma unroll
    for (int i = 0; i < 8; ++i) { const int kk = kr + 8 * i; v[i] = *(const GAS f32x4*)(W + (size_t)(k0 + kk) * ldw + n0 + 4 * c4); gs[i] = g ? g[k0 + kk] : 1.0f; }
#pragma unroll
    for (int i = 0; i < 8; ++i) { const int kk = kr + 8 * i; LAS float* d = scr + kk * 33 + 4 * c4; d[0] = v[i][0] * gs[i]; d[1] = v[i][1] * gs[i]; d[2] = v[i][2] * gs[i]; d[3] = v[i][3] * gs[i]; }
    asm volatile("s_waitcnt lgkmcnt(0)" ::: "memory");
    const int c = lane & 7;
#pragma unroll
    for (int j = 0; j < 4; ++j) { const int n = (lane >> 3) + 8 * j; const LAS float* s = scr + (8 * c) * 33 + n;
        if (cmax) { const float cm = fmaxf(cmax[n0 + n], 1e-30f), q = 127.0f / cm; unsigned lo = 0u, hi = 0u;
#pragma unroll
            for (int e = 0; e < 4; ++e) { lo |= ((unsigned)(int)__builtin_rintf(s[e * 33] * q) & 0xffu) << (8 * e); hi |= ((unsigned)(int)__builtin_rintf(s[(4 + e) * 33] * q) & 0xffu) << (8 * e); }
            *(GAS u32x2*)((unsigned char*)WT + (size_t)(drow + n) * ldt + k0 + 8 * c) = (u32x2){lo, hi};
            if (k0 == 0 && c == 0) sbw[drow + n] = cm * (1.0f / 127.0f);
        } else if (f8scale != 0.f) { const float q = f8scale;
            const u32x2 o8 = pack8_fp8((f32x4){s[0 * 33] * q, s[1 * 33] * q, s[2 * 33] * q, s[3 * 33] * q}, (f32x4){s[4 * 33] * q, s[5 * 33] * q, s[6 * 33] * q, s[7 * 33] * q});
            *(GAS u32x2*)((unsigned char*)WT + (size_t)(drow + n) * ldt + k0 + 8 * c) = o8;
        } else {
        u32x4 o; o.x = cvt_pk_bf16(s[0 * 33], s[1 * 33]); o.y = cvt_pk_bf16(s[2 * 33], s[3 * 33]); o.z = cvt_pk_bf16(s[4 * 33], s[5 * 33]); o.w = cvt_pk_bf16(s[6 * 33], s[7 * 33]);
        *(GAS u32x4*)(WT + (size_t)(drow + n) * ldt + k0 + 8 * c) = o; } }
    asm volatile("s_waitcnt lgkmcnt(0)" ::: "memory");
}
__device__ __forceinline__ int win_drow(int n0) {
    if (n0 < 1024) return 256 * (n0 >> 7) + 64 * ((n0 & 127) >> 5) + (n0 & 31);
    if (n0 < 2048) { const int c = n0 - 1024; return 256 * (c >> 7) + 64 * ((c & 127) >> 5) + 32 + (c & 31); }
    if (n0 >= 4096 && n0 < 5120) return n0 + 1024;
    if (n0 >= 5120 && n0 < 6144) return n0 - 1024;
    return n0;
}
__device__ __forceinline__ void sincos_acc(float angf, float& s, float& c) {
    const double a = (double)angf;
    const double kq = __builtin_rint(a * 0.63661977236758134308);
    double r = __builtin_fma(-kq, 1.5707963267948966, a); r = __builtin_fma(-kq, 6.123233995736766e-17, r);
    const double r2 = r * r;
    const double sp = r * (1.0 + r2 * (-1.0 / 6 + r2 * (1.0 / 120 + r2 * (-1.0 / 5040 + r2 * (1.0 / 362880 + r2 * (-1.0 / 39916800 + r2 * (1.0 / 6227020800.0)))))));
    const double cp = 1.0 + r2 * (-0.5 + r2 * (1.0 / 24 + r2 * (-1.0 / 720 + r2 * (1.0 / 40320 + r2 * (-1.0 / 3628800 + r2 * (1.0 / 479001600.0 + r2 * (-1.0 / 87178291200.0)))))));
    const int q = ((int)(long long)kq) & 3;
    const double ss = (q == 0) ? sp : (q == 1) ? cp : (q == 2) ? -sp : -cp;
    const double cc = (q == 0) ? cp : (q == 1) ? -sp : (q == 2) ? -cp : sp;
    s = (float)ss; c = (float)cc;
}
__device__ __forceinline__ void p0_quant_win(Frame& F) {
    LAS float* scr = (LAS float*)(F.lds + F.wave * 16384);
    const int gw = F.vcu * NWAVES + F.wave, NGW = F.G * NWAVES, lane = F.lane();
    unsigned char* ws = F.ws;
    for (int it = gw; it < 4096; it += NGW) { const int kb = it >> 8, nb = it & 255;
        p0_transpose_item(F.in[I_WIN], NIN, F.in[I_GMIX], (bf16*)(ws + W_IN), D, 64 * kb, 32 * nb, win_drow(32 * nb), scr, lane, 0.f, (const float*)(ws + WS_CMAX), (float*)(ws + WS_SB)); }
    for (int it = gw; it < 512; it += NGW)
        p0_transpose_item(F.in[I_WPG], D, F.in[I_GPIN], (bf16*)(ws + W_PG), D, 64 * (it >> 5), 32 * (it & 31), 32 * (it & 31), scr, lane, 0.f, (const float*)(ws + WS_CMAX) + NIN, (float*)(ws + WS_SB) + NIN);
}
__device__ __forceinline__ void p0_prologue(Frame& F) {
    LAS float* scr = (LAS float*)(F.lds + F.wave * 16384);
    const int gw = F.vcu * NWAVES + F.wave, NGW = F.G * NWAVES, lane = F.lane();
    unsigned char* ws = F.ws;
    { const int c4 = lane & 7, kr = lane >> 3;
      for (int it = gw; it < 4096 + 512; it += NGW) { const bool pg = it >= 4096; const int q = pg ? it - 4096 : it, kb = pg ? q >> 5 : q >> 8, nb = pg ? q & 31 : q & 255, ldw = pg ? D : NIN;
          const float* W = pg ? F.in[I_WPG] : F.in[I_WIN]; const float* g = pg ? F.in[I_GPIN] : F.in[I_GMIX]; unsigned* cmax = (unsigned*)(ws + WS_CMAX) + (pg ? NIN : 0);
          f32x4 v[8]; float gs[8];
#pragma unroll
          for (int i = 0; i < 8; ++i) { const int kk = 64 * kb + kr + 8 * i; v[i] = *(const GAS f32x4*)(W + (size_t)kk * ldw + 32 * nb + 4 * c4); gs[i] = g[kk]; }
          f32x4 mx = {0.f, 0.f, 0.f, 0.f};
#pragma unroll
          for (int i = 0; i < 8; ++i)
#pragma unroll
              for (int j = 0; j < 4; ++j) mx[j] = fmaxf(mx[j], fabsf(v[i][j] * gs[i]));
#pragma unroll
          for (int o = 8; o < 64; o <<= 1)
#pragma unroll
              for (int j = 0; j < 4; ++j) mx[j] = fmaxf(mx[j], __shfl_xor(mx[j], o));
          if (kr == 0) {
#pragma unroll
              for (int j = 0; j < 4; ++j) atomicMax(&cmax[32 * nb + 4 * c4 + j], __float_as_uint(mx[j])); } } }
    constexpr int I0 = 0, I1 = 512, I5 = 128, I6 = 8192;
    constexpr int NITEMS = I0 + 4 * I1 + I5 + 3 * I6;
    for (int it = gw; it < NITEMS; it += NGW) {
        int r = it;
        if (r < I1) { p0_transpose_item(F.in[I_WOC], D, nullptr, (bf16*)(ws + W_OC), D, 64 * (r >> 5), 32 * (r & 31), 32 * (r & 31), scr, lane); continue; } r -= I1;
        if (r < I1) { p0_transpose_item(F.in[I_WOR], D, nullptr, (bf16*)(ws + W_OR), D, 64 * (r >> 5), 32 * (r & 31), 32 * (r & 31), scr, lane, 64.f); continue; } r -= I1;
        if (r < I1) { p0_transpose_item(F.in[I_WO], D, nullptr, (bf16*)(ws + W_O), D, 64 * (r >> 5), 32 * (r & 31), 32 * (r & 31), scr, lane); continue; } r -= I1;
        if (r < I1) { continue; } r -= I1;
        if (r < I5) { p0_transpose_item(F.in[I_WPP], D, nullptr, (bf16*)(ws + W_PP), PLE, 64 * (r >> 5), 32 * (r & 31), 32 * (r & 31), scr, lane); continue; } r -= I5;
        if (r < I6) { const int e = r >> 8, q = r & 255, kb = q >> 4, nb = q & 15, n0 = 32 * nb;
            p0_transpose_item(F.in[I_WG] + (size_t)e * D * DE, DE, F.in[I_GMOE], (bf16*)(ws + W_GU + (size_t)e * 1024 * 1024), D, 64 * kb, n0, 256 * (n0 >> 7) + (n0 & 127), scr, lane, 32.f); continue; } r -= I6;
        if (r < I6) { const int e = r >> 8, q = r & 255, kb = q >> 4, nb = q & 15, n0 = 32 * nb;
            p0_transpose_item(F.in[I_WU] + (size_t)e * D * DE, DE, F.in[I_GMOE], (bf16*)(ws + W_GU + (size_t)e * 1024 * 1024), D, 64 * kb, n0, 256 * (n0 >> 7) + 128 + (n0 & 127), scr, lane, 32.f); continue; } r -= I6;
        { const int e = r >> 8, q = r & 255, kb = q >> 5, nb = q & 31;
            p0_transpose_item(F.in[I_WD] + (size_t)e * DE * D, D, nullptr, (bf16*)(ws + W_DN + (size_t)e * 1024 * 512), DE, 64 * kb, 32 * nb, 32 * nb, scr, lane, 16.f); }
    }
    const int gt = F.vcu * NTHR + F.tid(), NGT = F.G * NTHR;
    for (int it = gt; it < 256 * 128; it += NGT) {
        const int row = it >> 7, k0 = (it & 127) * 8;
        const bool isre = row < 32, isrg = (row >= 128 && row < 132), valid = isre || isrg;
        const float* src = isre ? F.in[I_WRE] + row : F.in[I_WRG] + (isrg ? row - 128 : 0); const int st = isre ? NE : 4;
        float wv[8];
#pragma unroll
        for (int j = 0; j < 8; ++j) wv[j] = src[(size_t)(k0 + j) * st];
        const f32x4 g0 = *(const GAS f32x4*)(F.in[I_GMOE] + k0), g1 = *(const GAS f32x4*)(F.in[I_GMOE] + k0 + 4);
        const float m = valid ? 1.f : 0.f;
        u32x4 o; o.x = cvt_pk_bf16(wv[0] * g0[0] * m, wv[1] * g0[1] * m); o.y = cvt_pk_bf16(wv[2] * g0[2] * m, wv[3] * g0[3] * m);
        o.z = cvt_pk_bf16(wv[4] * g1[0] * m, wv[5] * g1[1] * m); o.w = cvt_pk_bf16(wv[6] * g1[2] * m, wv[7] * g1[3] * m);
        *(GAS u32x4*)((bf16*)(ws + W_R) + (size_t)row * D + k0) = o;
    }
    for (int it = gt; it < SEQ * 32; it += NGT) {
        const int pos = it >> 5, i = it & 31; float s, c; sincos_acc(__fmul_rn((float)pos, c_inv_freq[i]), s, c);
        ((GAS f32x2*)(ws + WS_ROPE))[it] = (f32x2){c, s};
    }
    { const float* p = F.in[I_P]; bf16* pb = (bf16*)(ws + WS_PB); constexpr size_t NIT = (size_t)T * PLE / 8;
      for (size_t it0 = gt; it0 < NIT; it0 += (size_t)NGT * 4) { f32x4 a[4], b[4];
#pragma unroll
          for (int q = 0; q < 4; ++q) { const size_t it = it0 + (size_t)q * NGT; if (it < NIT) { a[q] = ((const GAS f32x4*)p)[2 * it]; b[q] = ((const GAS f32x4*)p)[2 * it + 1]; } }
#pragma unroll
          for (int q = 0; q < 4; ++q) { const size_t it = it0 + (size_t)q * NGT; if (it < NIT) ((GAS u32x4*)pb)[it] = pack8(a[q], b[q]); } } }
    { const float* x = F.in[I_X]; bf16* xh = (bf16*)(ws + WS_A);
      for (int m0 = gw; m0 < T; m0 += NGW * 4) {
          f32x4 v[4][4]; float ss[4], mxa[4];
#pragma unroll
          for (int q = 0; q < 4; ++q) { const int m = m0 + q * NGW; const GAS f32x4* xr = (const GAS f32x4*)(x + (size_t)(m < T ? m : m0) * D) + lane;
#pragma unroll
              for (int j = 0; j < 4; ++j) v[q][j] = xr[64 * j]; }
#pragma unroll
          for (int q = 0; q < 4; ++q) { float s = 0.f, mx = 0.f;
#pragma unroll
              for (int j = 0; j < 4; ++j) { s += (v[q][j].x * v[q][j].x + v[q][j].y * v[q][j].y) + (v[q][j].z * v[q][j].z + v[q][j].w * v[q][j].w);
                  mx = fmaxf(fmaxf(mx, fmaxf(fabsf(v[q][j].x), fabsf(v[q][j].y))), fmaxf(fabsf(v[q][j].z), fabsf(v[q][j].w))); }
              ss[q] = s; mxa[q] = mx; }
#pragma unroll
          for (int q = 0; q < 4; ++q) { const int m = m0 + q * NGW; const float rms = sqrtf(wave_sum(ss[q]) * (1.f / D) + EPS), rstd = 1.0f / rms;
              float mx = mxa[q];
#pragma unroll
              for (int o = 1; o < 64; o <<= 1) mx = fmaxf(mx, __shfl_xor(mx, o));
              mx = fmaxf(mx, 1e-30f); const float qs = 127.0f / mx;
              if (m < T) { if (lane == 0) { ((float*)(ws + WS_RSTD2))[m] = rms;
                                            ((float*)(ws + WS_SSQ3))[m] = mx * rstd * (1.0f / 127.0f); }
 GAS u32x2* o8 = (GAS u32x2*)(xh + (size_t)m * D) + lane; GAS unsigned* o4 = (GAS unsigned*)(ws + WS_S + (size_t)m * D) + lane;
#pragma unroll
                  for (int j = 0; j < 4; ++j) { u32x2 o; o.x = cvt_pk_bf16(v[q][j].x * rstd, v[q][j].y * rstd); o.y = cvt_pk_bf16(v[q][j].z * rstd, v[q][j].w * rstd); o8[64 * j] = o;
                      const unsigned w8 = ((unsigned)(int)__builtin_rintf(v[q][j].x * qs) & 0xffu) | (((unsigned)(int)__builtin_rintf(v[q][j].y * qs) & 0xffu) << 8) | (((unsigned)(int)__builtin_rintf(v[q][j].z * qs) & 0xffu) << 16) | ((unsigned)(int)__builtin_rintf(v[q][j].w * qs) << 24);
                      o4[64 * j] = w8; } } }
      } }
}

__device__ __forceinline__ unsigned cu_off(int t, int ch) {
    return (unsigned)((((t >> 4) * 8 + (t & 7)) * 32 + (ch >> 5)) * 64 + ((t >> 3) & 1) * 32 + (ch & 31));
}
__device__ __forceinline__ void dequant_i8(Acc& acc, const float* sa, const float* sbp, int row0) {
    f32x4 cb[2][2]; float ra[2][4];
#pragma unroll
    for (int bj = 0; bj < 2; ++bj)
#pragma unroll
        for (int n = 0; n < 2; ++n) cb[bj][n] = *(const GAS f32x4*)(sbp + 32 * bj + 4 * n);
#pragma unroll
    for (int ai = 0; ai < 2; ++ai)
#pragma unroll
        for (int m = 0; m < 4; ++m) ra[ai][m] = sa[row0 + ai * 128 + m * 16];
#pragma unroll
    for (int ai = 0; ai < 2; ++ai)
#pragma unroll
        for (int bj = 0; bj < 2; ++bj)
#pragma unroll
            for (int m = 0; m < 4; ++m)
#pragma unroll
                for (int n = 0; n < 2; ++n) { const v4i32 ci = __builtin_bit_cast(v4i32, acc[ai][bj][m][n]);
                    acc[ai][bj][m][n] = (f32x4){(float)ci[0], (float)ci[1], (float)ci[2], (float)ci[3]} * cb[bj][n] * ra[ai][m]; }
}
struct EpiG1 {
    static constexpr bool ADJ = true; static constexpr bool FP8 = false; static constexpr bool I8 = true;
    const float* sa; const float* sb;
    __device__ __forceinline__ void dequant(Acc& acc, const Unit& u, int wr, int wc, int fr, int fq) const { dequant_i8(acc, sa, sb + (u.pn + pn0) * 256 + wc * 64 + 8 * fq, u.pm * 256 + wr * 64 + fr); }
    bf16 *cu, *ypre, *q, *k, *v, *sg, *mc, *mr; const f32x2* rope; const LAS float* cw; int pn0;
    template <int ACT, int STRIDE = D> __device__ __forceinline__ void plain(const Acc& acc, bf16* dst, unsigned off0, int fr, int fq) const {
#pragma unroll
        for (int ai = 0; ai < 2; ++ai)
#pragma unroll
            for (int m = 0; m < 4; ++m) { u32x4 o[2];
#pragma unroll
                for (int bj = 0; bj < 2; ++bj) { f32x4 v0 = acc[ai][bj][m][0], v1 = acc[ai][bj][m][1];
                    if (ACT == 1) {
#pragma unroll
                        for (int j = 0; j < 4; ++j) { v0[j] = siluf_(v0[j]); v1[j] = siluf_(v1[j]); } }
                    if (ACT == 2) {
#pragma unroll
                        for (int j = 0; j < 4; ++j) { v0[j] = sigmoidf_(v0[j]); v1[j] = sigmoidf_(v1[j]); } }
                    o[bj] = pack8(v0, v1); }
                st_lines(dst, off0 + (unsigned)(ai * 128 + m * 16) * STRIDE, o[0], o[1], fr, fq); }
    }
    __device__ __forceinline__ void operator()(const Acc& acc, const Unit& u, int wr, int wc, int fr, int fq) const {
        const int row0 = u.pm * 256 + wr * 64 + fr, pn = u.pn + pn0;
        if (pn < 8) {
#pragma unroll
            for (int ai = 0; ai < 2; ++ai)
#pragma unroll
                for (int m = 0; m < 4; ++m) { const size_t rowo = (size_t)(((u.pm * 16 + ai * 8 + wr * 4 + m) * 8 + (fr & 7)) * 32 + pn * 4 + wc) * 64 + (fr >> 3) * 32 + 8 * fq;
                    st16_wt(cu, rowo, pack8(acc[ai][0][m][0] * acc[ai][1][m][0], acc[ai][0][m][1] * acc[ai][1][m][1])); }
        } else if (pn < 12) {
            const int chw = (pn - 8) * 256 + wc * 64 + 8 * fq;
            u32x4 cv[2][2][3];
#define G1_CLOAD(slot, q) do { int r_ = row0 + ((q) >> 2) * 128 + ((q) & 3) * 16; asm volatile("" : "+v"(r_)); const int pos_ = r_ & (SEQ - 1);     \
                _Pragma("unroll") for (int bj = 0; bj < 2; ++bj) _Pragma("unroll") for (int d = 0; d < 3; ++d) \
                    cv[slot][bj][d] = *(const GAS u32x4*)(cu + cu_off(pos_ >= d ? r_ - d : r_, chw + 32 * bj)); } while (0)
            G1_CLOAD(0, 0);
#pragma unroll
            for (int q = 0; q < 8; ++q) {
                if (q + 1 < 8) { if ((q & 1) == 0) G1_CLOAD(1, q + 1); else G1_CLOAD(0, q + 1); }
                const int ai = q >> 2, m = q & 3, sl = q & 1, r = row0 + ai * 128 + m * 16, pos = r & (SEQ - 1);
                const float k1 = pos >= 1 ? 1.f : 0.f, k2 = pos >= 2 ? 1.f : 0.f;
                u32x4 res[2];
#pragma unroll
                for (int bj = 0; bj < 2; ++bj) { const LAS f32x4* wp = (const LAS f32x4*)(cw + chw + 32 * bj);
                    f32x4 c0a, c0b, c1a, c1b, c2a, c2b; unpack8(cv[sl][bj][0], c0a, c0b); unpack8(cv[sl][bj][1], c1a, c1b); unpack8(cv[sl][bj][2], c2a, c2b);
                    const f32x4 ya = acc[ai][bj][m][0] * (wp[0] * (c2a * k2) + wp[D / 4] * (c1a * k1) + wp[2 * D / 4] * c0a);
                    const f32x4 yb = acc[ai][bj][m][1] * (wp[1] * (c2b * k2) + wp[D / 4 + 1] * (c1b * k1) + wp[2 * D / 4 + 1] * c0b);
                    res[bj] = pack8(ya, yb); }
                st_lines(ypre, (unsigned)r * D + (pn - 8) * 256 + wc * 64, res[0], res[1], fr, fq);
            }
#undef G1_CLOAD
        }
        else if (pn < 16) {
            const bool isk = pn >= 14; const int head = ((pn - 12) & 1) * 4 + wc; bf16* dst = isk ? k : q;
            const float lg = lg2_gamma(head);
#pragma unroll
            for (int ai = 0; ai < 2; ++ai) {
                f32x4 cs[4][4];
#pragma unroll
                for (int m = 0; m < 4; ++m) { const int pos = (row0 + ai * 128 + m * 16) & (SEQ - 1); const GAS f32x4* rp = (const GAS f32x4*)(rope + (size_t)pos * 32 + 8 * fq);
#pragma unroll
                    for (int j = 0; j < 4; ++j) cs[m][j] = rp[j]; }
#pragma unroll
                for (int m = 0; m < 4; ++m) { const int r = row0 + ai * 128 + m * 16, pos = r & (SEQ - 1); const float e = (float)((pos & (CH - 1)) + 1) * lg;
                    const float sc = isk ? 0.125f * exp2f(-e) : exp2f(e);
                    f32x4 o1[2], o2[2];
#pragma unroll
                    for (int n = 0; n < 2; ++n) { const f32x4 cs0 = cs[m][2 * n], cs1 = cs[m][2 * n + 1];
                        const f32x4 a = acc[ai][0][m][n], b = acc[ai][1][m][n];
                        o1[n] = (f32x4){(a[0] * cs0[0] - b[0] * cs0[1]) * sc, (a[1] * cs0[2] - b[1] * cs0[3]) * sc, (a[2] * cs1[0] - b[2] * cs1[1]) * sc, (a[3] * cs1[2] - b[3] * cs1[3]) * sc};
                        o2[n] = (f32x4){(a[0] * cs0[1] + b[0] * cs0[0]) * sc, (a[1] * cs0[3] + b[1] * cs0[2]) * sc, (a[2] * cs1[1] + b[2] * cs1[0]) * sc, (a[3] * cs1[3] + b[3] * cs1[2]) * sc}; }
                    st_lines(dst, (unsigned)r * 512u + head * 64, pack8(o1[0], o1[1]), pack8(o2[0], o2[1]), fr, fq); } }
        } else if (pn < 20) plain<1>(acc, sg, (unsigned)row0 * D + (pn - 16) * 256 + wc * 64, fr, fq);
        else if (pn < 24) plain<0>(acc, v, (unsigned)row0 * D + (pn - 20) * 256 + wc * 64, fr, fq);
        else { unsigned char* g8 = (unsigned char*)(pn < 28 ? mc : mr); const int tile = u.pm * 4 + ((pn - 24) & 3);
#pragma unroll
            for (int ai = 0; ai < 2; ++ai)
#pragma unroll
                for (int m = 0; m < 4; ++m) { u32x4 o; f32x4 t;
#pragma unroll
                    for (int j = 0; j < 4; ++j) t[j] = sigmoidf_(acc[ai][0][m][0][j]); o.x = q8x4(t);
#pragma unroll
                    for (int j = 0; j < 4; ++j) t[j] = sigmoidf_(acc[ai][0][m][1][j]); o.y = q8x4(t);
#pragma unroll
                    for (int j = 0; j < 4; ++j) t[j] = sigmoidf_(acc[ai][1][m][0][j]); o.z = q8x4(t);
#pragma unroll
                    for (int j = 0; j < 4; ++j) t[j] = sigmoidf_(acc[ai][1][m][1][j]); o.w = q8x4(t);
                    *(GAS u32x4*)(g8 + gate8_off(tile, wr * 4 + wc, ai * 4 + m, fq * 16 + fr)) = o; } }
    }
};
template <int MODE, bool F8 = false> struct EpiGate {
    static constexpr bool ADJ = true; static constexpr bool FP8 = F8; static constexpr int BSC = 0x7c7c7c7c;
    const bf16* gate; const bf16* prev; bf16* out; int variant; bf16* dead; float* scl;
    __device__ __forceinline__ void operator()(const Acc& acc, const Unit& u, int wr, int wc, int fr, int fq) const {
        const unsigned tbase = (unsigned)(u.pm * 4 + u.pn) * 65536u + (unsigned)(wr * 64 + fr) * 256u + wc * 64, rbase = (unsigned)(u.pm * 256 + wr * 64 + fr) * D + u.pn * 256 + wc * 64;
        if constexpr (MODE == 0) {
            u32x4 gt[2][4];
#pragma unroll
            for (int ai = 0; ai < 2; ++ai)
#pragma unroll
                for (int m = 0; m < 4; ++m) gt[ai][m] = *(const GAS u32x4*)((const unsigned char*)gate + gate8_off(u.pm * 4 + u.pn, wr * 4 + wc, ai * 4 + m, fq * 16 + fr));
#pragma unroll
            for (int ai = 0; ai < 2; ++ai)
#pragma unroll
                for (int m = 0; m < 4; ++m) {
                    q64_store((unsigned char*)out, scl, ((u.pm * 4 + u.pn) * 8 + wr * 4 + wc) * 8 + ai * 4 + m, fr, fq,
                              acc[ai][0][m][0] * dq8x4(gt[ai][m].x), acc[ai][0][m][1] * dq8x4(gt[ai][m].y), acc[ai][1][m][0] * dq8x4(gt[ai][m].z), acc[ai][1][m][1] * dq8x4(gt[ai][m].w)); }
        } else {
#pragma unroll
        for (int ai = 0; ai < 2; ++ai) {
            u32x4 gt[4], pv[4]; float ps[4];
#pragma unroll
            for (int m = 0; m < 4; ++m) { const int blk = ((u.pm * 4 + u.pn) * 8 + wr * 4 + wc) * 8 + ai * 4 + m;
                gt[m] = *(const GAS u32x4*)((const unsigned char*)gate + gate8_off(u.pm * 4 + u.pn, wr * 4 + wc, ai * 4 + m, fq * 16 + fr));
                pv[m] = *(const GAS u32x4*)((const unsigned char*)prev + ((size_t)blk * 64 + fq * 16 + fr) * 16); ps[m] = scl[(size_t)blk * 16 + fr]; }
#pragma unroll
            for (int m = 0; m < 4; ++m) { u32x4 o[2]; f32x4 p[2][2]; q64_unpack(pv[m], ps[m], p[0][0], p[0][1], p[1][0], p[1][1]);
#pragma unroll
                for (int bj = 0; bj < 2; ++bj) {
                    o[bj] = pack8(acc[ai][bj][m][0] * dq8x4(bj ? gt[m].z : gt[m].x) + p[bj][0], acc[ai][bj][m][1] * dq8x4(bj ? gt[m].w : gt[m].y) + p[bj][1]); }
                st_lines(out, rbase + (unsigned)(ai * 128 + m * 16) * D, o[0], o[1], fr, fq); } }
        }
    }
};
struct EpiRes {
    static constexpr bool ADJ = true; static constexpr bool FP8 = false;
    const float* rms; bf16* xb1; float* ssq; unsigned char* x8;
    __device__ __forceinline__ void operator()(const Acc& acc, const Unit& u, int wr, int wc, int fr, int fq) const {
        const int row0 = u.pm * 256 + wr * 64 + fr; const unsigned cg = u.pn * 256 + wc * 64;
        u32x4 xv[2][4][2]; float rm[2][4];
#pragma unroll
        for (int ai = 0; ai < 2; ++ai)
#pragma unroll
            for (int m = 0; m < 4; ++m) { const int r = row0 + ai * 128 + m * 16; rm[ai][m] = rms[r];
#pragma unroll
                for (int bj = 0; bj < 2; ++bj) xv[ai][m][bj] = *(const GAS u32x4*)(xb1 + (size_t)r * D + cg + bj * 32 + 8 * fq); }
#pragma unroll
        for (int ai = 0; ai < 2; ++ai)
#pragma unroll
            for (int m = 0; m < 4; ++m) { const int r = row0 + ai * 128 + m * 16; float s = 0.f; u32x4 o[2];
#pragma unroll
                for (int bj = 0; bj < 2; ++bj) { f32x4 x0, x1; unpack8(xv[ai][m][bj], x0, x1);
                    const f32x4 v0 = x0 * rm[ai][m] + acc[ai][bj][m][0], v1 = x1 * rm[ai][m] + acc[ai][bj][m][1];
                    o[bj] = pack8(v0, v1);
                    *(GAS u32x2*)(x8 + (size_t)r * D + cg + bj * 32 + 8 * fq) = pack8_fp8(v0, v1);
                    s += (v0[0] * v0[0] + v0[1] * v0[1]) + (v0[2] * v0[2] + v0[3] * v0[3]) + (v1[0] * v1[0] + v1[1] * v1[1]) + (v1[2] * v1[2] + v1[3] * v1[3]); }
                st_lines(xb1, (unsigned)r * D + cg, o[0], o[1], fr, fq);
                s = fq_sum(s, fr, fq);
                if (fq == 0) ssq[(size_t)r * 16 + u.pn * 4 + wc] = s; }
    }
};
struct EpiRoute {
    static constexpr bool ADJ = false; static constexpr bool FP8 = false;
    const float* ssq; const float* brg; const float* bre; float* rstd2; u32x4* lists; unsigned* gcnt; LAS int* hs;
    __device__ __forceinline__ void operator()(const Acc& acc, const Unit& u, int wr, int wc, int fr, int fq) const {
        if (wc != 0) return;
        const int row0 = u.pm * 256 + wr * 64 + fr, lane = fq * 16 + fr;
        LAS int* hist = hs + wr * 64; LAS int* bs = hist + 32;
        float be[8], bg4[4];
#pragma unroll
        for (int j = 0; j < 8; ++j) be[j] = bre[8 * fq + j];
#pragma unroll
        for (int j = 0; j < 4; ++j) bg4[j] = brg[j];
        f32x4 pqa[2][4];
#pragma unroll
        for (int ai = 0; ai < 2; ++ai)
#pragma unroll
            for (int m = 0; m < 4; ++m) pqa[ai][m] = *(const GAS f32x4*)(ssq + (size_t)(row0 + ai * 128 + m * 16) * 16 + 4 * fq);
        int ee0[8], ee1[8], rk0[8], rk1[8]; float ww0[8], ww1[8], rsq[8]; bool own[8];
#pragma unroll
        for (int ai = 0; ai < 2; ++ai)
#pragma unroll
            for (int m = 0; m < 4; ++m) { const int q = ai * 4 + m, r = row0 + ai * 128 + m * 16;
                const f32x4 pq = pqa[ai][m]; float s = (pq[0] + pq[1]) + (pq[2] + pq[3]);
                s = fq_sum(s, fr, fq);
                const float rs = 1.0f / sqrtf(s * (1.f / D) + EPS);
                float el[8], gl[4];
#pragma unroll
                for (int j = 0; j < 8; ++j) el[j] = acc[ai][0][m][j >> 2][j & 3] * rs + be[j];
#pragma unroll
                for (int j = 0; j < 4; ++j) gl[j] = __shfl(acc[ai][1][m][0][j] * rs + bg4[j], fr);
                int grp = 0; float best = gl[0];
#pragma unroll
                for (int j = 1; j < 4; ++j) if (gl[j] > best) { best = gl[j]; grp = j; }
                float den = 0.f;
#pragma unroll
                for (int j = 0; j < 4; ++j) den += __expf(gl[j] - best);
                const float gw = 1.0f / den;
                int i1 = 0; float l1 = el[0];
#pragma unroll
                for (int j = 1; j < 8; ++j) if (el[j] > l1) { l1 = el[j]; i1 = j; }
                int i2 = -1; float l2 = -3.0e38f;
#pragma unroll
                for (int j = 0; j < 8; ++j) if (j != i1 && el[j] > l2) { l2 = el[j]; i2 = j; }
                const float w0 = 1.0f / (1.0f + __expf(l2 - l1)), w1 = 1.0f - w0;
                rsq[q] = rs; own[q] = (fq == grp); ee0[q] = grp * 8 + i1; ee1[q] = grp * 8 + i2; ww0[q] = w0 * gw; ww1[q] = w1 * gw; rk0[q] = 0; rk1[q] = 0;
                if (own[q]) { rstd2[r] = rs; rk0[q] = atomicAdd((int*)&hist[ee0[q]], 1); rk1[q] = atomicAdd((int*)&hist[ee1[q]], 1); } }
        asm volatile("s_waitcnt lgkmcnt(0)" ::: "memory");
        if (lane < 32) { const int c = hist[lane]; hist[lane] = 0; bs[lane] = (int)__hip_atomic_fetch_add(gcnt + lane, (unsigned)c, RLX_AGENT); }
        asm volatile("s_waitcnt vmcnt(0) lgkmcnt(0)" ::: "memory");
#pragma unroll
        for (int q = 0; q < 8; ++q) if (own[q]) { const unsigned tok = (unsigned)(row0 + (q >> 2) * 128 + (q & 3) * 16);
            lists[(size_t)ee0[q] * T + bs[ee0[q]] + rk0[q]] = (u32x4){tok * 2u, __float_as_uint(ww0[q]), __float_as_uint(rsq[q]), 0u};
            lists[(size_t)ee1[q] * T + bs[ee1[q]] + rk1[q]] = (u32x4){tok * 2u + 1u, __float_as_uint(ww1[q]), __float_as_uint(rsq[q]), 0u}; }
        asm volatile("s_waitcnt lgkmcnt(0)" ::: "memory");
    }
};
template <bool GATH, bool TILED = false> struct MoeSched {
    static constexpr bool GATHER = GATH, ATILED = TILED;
    const LAS int* tb; const LAS int* cn; const LAS int* te; const u32x4* lists; const char* A; const char* B; size_t bstride; int K, G, c;
    __device__ bool next(int i, Unit& u) const {
        const int U = i * G + c; if (U >= tb[32] * 4) return false;
        const int rt = U >> 2;
        u.pm = rt; u.pn = U & 3; u.aux = te[rt]; return true;
    }
    __device__ __forceinline__ void ptrs(const Unit& u, const char*& a, const char*& b) const {
        a = GATH ? A : A + (size_t)u.pm * 256 * K * 2; b = B + (size_t)u.aux * bstride + (size_t)u.pn * 256 * K * 2; }
    __device__ __forceinline__ void goff(const Unit& u, int R0, int R1, int C0, int C1, unsigned (&vo)[2][2]) const {
        const int e = u.aux, n = cn[e], base = (u.pm - tb[e]) * 256; const u32x4* L = lists + (size_t)e * T;
        const int i00 = base + R0, i01 = base + R1, i10 = base + 128 + R0, i11 = base + 128 + R1;
        const unsigned l00 = L[i00 < n ? i00 : 0].x, l01 = L[i01 < n ? i01 : 0].x, l10 = L[i10 < n ? i10 : 0].x, l11 = L[i11 < n ? i11 : 0].x;
        const unsigned t00 = (i00 < n) ? (l00 >> 1) : 0u, t01 = (i01 < n) ? (l01 >> 1) : 0u, t10 = (i10 < n) ? (l10 >> 1) : 0u, t11 = (i11 < n) ? (l11 >> 1) : 0u;
        vo[0][0] = (t00 * (unsigned)(D / 2) + (unsigned)C0) * 2u; vo[0][1] = (t01 * (unsigned)(D / 2) + (unsigned)C1) * 2u;
        vo[1][0] = (t10 * (unsigned)(D / 2) + (unsigned)C0) * 2u; vo[1][1] = (t11 * (unsigned)(D / 2) + (unsigned)C1) * 2u;
    }
};
struct EpiHid {
    static constexpr bool ADJ = false; static constexpr bool FP8 = true; static constexpr int BSC = 0x7f7f7f7f;
    const LAS int* tb; const LAS int* cn; const u32x4* lists; bf16* hid;
    __device__ __forceinline__ void operator()(const Acc& acc, const Unit& u, int wr, int wc, int fr, int fq) const {
        const int e = u.aux, n = cn[e], base = (u.pm - tb[e]) * 256; const u32x4* L = lists + (size_t)e * T;
        float rsa[2][4];
#pragma unroll
        for (int ai = 0; ai < 2; ++ai)
#pragma unroll
            for (int m = 0; m < 4; ++m) { const int idx = base + ai * 128 + wr * 64 + m * 16 + fr; const float r = __uint_as_float(L[idx < n ? idx : 0].z) * (1.0f / 32.0f); rsa[ai][m] = (idx < n) ? r : 0.f; }
#pragma unroll
        for (int ai = 0; ai < 2; ++ai)
#pragma unroll
            for (int m = 0; m < 4; ++m) { const float rs = rsa[ai][m];
                f32x4 h0, h1;
#pragma unroll
                for (int j = 0; j < 4; ++j) { h0[j] = siluf_(rs * acc[ai][0][m][0][j]) * (rs * acc[ai][1][m][0][j]); h1[j] = siluf_(rs * acc[ai][0][m][1][j]) * (rs * acc[ai][1][m][1][j]); }
                *(GAS u32x2*)((unsigned char*)hid + (size_t)(u.pm * 256 + ai * 128 + wr * 64 + m * 16 + fr) * DE + u.pn * 128 + wc * 32 + 8 * fq) = pack8_fp8(h0, h1); }
    }
};
struct EpiDown {
    static constexpr bool ADJ = true; static constexpr bool FP8 = true; static constexpr int BSC = 0x7f7f7f7f;
    const LAS int* tb; const LAS int* cn; const u32x4* lists; bf16* Y;
    __device__ __forceinline__ void operator()(const Acc& acc, const Unit& u, int wr, int wc, int fr, int fq) const {
        const int e = u.aux, n = cn[e], base = (u.pm - tb[e]) * 256; const u32x4* L = lists + (size_t)e * T;
        u32x4 ent[2][4];
#pragma unroll
        for (int ai = 0; ai < 2; ++ai)
#pragma unroll
            for (int m = 0; m < 4; ++m) { const int idx = base + ai * 128 + wr * 64 + m * 16 + fr; ent[ai][m] = L[idx < n ? idx : 0]; }
#pragma unroll
        for (int ai = 0; ai < 2; ++ai)
#pragma unroll
            for (int m = 0; m < 4; ++m) { const int idx = base + ai * 128 + wr * 64 + m * 16 + fr; const bool ok = idx < n;
                const u32x4 en = ent[ai][m]; const float w = __uint_as_float(en.y);
                unsigned char* dst = (unsigned char*)Y + (size_t)(en.x & 1u) * ((size_t)T * D) + (size_t)(en.x >> 1) * D + u.pn * 256 + wc * 64 + 8 * fq;
                if (ok) { *(GAS u32x2*)dst = pack8_fp8(acc[ai][0][m][0] * w, acc[ai][0][m][1] * w); *(GAS u32x2*)(dst + 32) = pack8_fp8(acc[ai][1][m][0] * w, acc[ai][1][m][1] * w); } }
    }
};
struct EpiPP {
    static constexpr bool ADJ = true; static constexpr bool FP8 = false;
    bf16* pp; float* ssq; const float* gpost; float* pscl;
    __device__ __forceinline__ void operator()(const Acc& acc, const Unit& u, int wr, int wc, int fr, int fq) const {
        const int row0 = u.pm * 256 + wr * 64 + fr; const unsigned cg = u.pn * 256 + wc * 64;
        f32x4 gp[2][2];
#pragma unroll
        for (int bj = 0; bj < 2; ++bj) { const GAS f32x4* g = (const GAS f32x4*)(gpost + cg + bj * 32 + 8 * fq); gp[bj][0] = g[0]; gp[bj][1] = g[1]; }
#pragma unroll
        for (int ai = 0; ai < 2; ++ai)
#pragma unroll
            for (int m = 0; m < 4; ++m) { const int r = row0 + ai * 128 + m * 16; float s = 0.f;
#pragma unroll
                for (int bj = 0; bj < 2; ++bj) { const f32x4 v0 = acc[ai][bj][m][0], v1 = acc[ai][bj][m][1];
                    s += (v0[0] * v0[0] + v0[1] * v0[1]) + (v0[2] * v0[2] + v0[3] * v0[3]) + (v1[0] * v1[0] + v1[1] * v1[1]) + (v1[2] * v1[2] + v1[3] * v1[3]); }
                q64_store((unsigned char*)pp, pscl, ((u.pm * 4 + u.pn) * 8 + wr * 4 + wc) * 8 + ai * 4 + m, fr, fq, acc[ai][0][m][0] * gp[0][0], acc[ai][0][m][1] * gp[0][1], acc[ai][1][m][0] * gp[1][0], acc[ai][1][m][1] * gp[1][1]);
                s = fq_sum(s, fr, fq);
                if (fq == 0) ssq[(size_t)r * 16 + u.pn * 4 + wc] = s; }
    }
};
struct EpiPle {
    static constexpr bool ADJ = true; static constexpr bool FP8 = false; static constexpr bool I8 = true;
    const bf16* x2; const float* rstd3; const bf16* pp; const float* rstdp; bf16* x3; float* ssq3; const float* sa; const float* sb; const float* pscl; float* scl3;
    __device__ __forceinline__ void dequant(Acc& acc, const Unit& u, int wr, int wc, int fr, int fq) const { dequant_i8(acc, sa, sb + u.pn * 256 + wc * 64 + 8 * fq, u.pm * 256 + wr * 64 + fr); }
    __device__ __forceinline__ void operator()(const Acc& acc, const Unit& u, int wr, int wc, int fr, int fq) const {
        const int row0 = u.pm * 256 + wr * 64 + fr; const unsigned cg = u.pn * 256 + wc * 64;
#pragma unroll
        for (int ai = 0; ai < 2; ++ai) {
            float r3[4], rpa[4], psc[4]; u32x4 xv[4][2], pv[4];
#pragma unroll
            for (int m = 0; m < 4; ++m) { const unsigned r = (unsigned)(row0 + ai * 128 + m * 16); const int blk = ((u.pm * 4 + u.pn) * 8 + wr * 4 + wc) * 8 + ai * 4 + m; r3[m] = rstd3[r]; rpa[m] = rstdp[r];
                pv[m] = *(const GAS u32x4*)((const unsigned char*)pp + ((unsigned)blk * 64u + (unsigned)(fq * 16 + fr)) * 16u); psc[m] = pscl[(unsigned)blk * 16u + (unsigned)fr];
#pragma unroll
                for (int bj = 0; bj < 2; ++bj) { const unsigned ro = r * (unsigned)D + cg + bj * 32 + 8 * fq; xv[m][bj] = *(const GAS u32x4*)(x2 + ro); } }
#pragma unroll
            for (int m = 0; m < 4; ++m) { const int r = row0 + ai * 128 + m * 16;
                const float rp = rpa[m], rg = r3[m]; float s = 0.f; f32x4 xo[2][2]; f32x4 pq[2][2]; q64_unpack(pv[m], psc[m], pq[0][0], pq[0][1], pq[1][0], pq[1][1]);
#pragma unroll
                for (int bj = 0; bj < 2; ++bj) { f32x4 v0, v1; const f32x4 p0 = pq[bj][0], p1 = pq[bj][1]; unpack8(xv[m][bj], v0, v1);
#pragma unroll
                    for (int j = 0; j < 4; ++j) { v0[j] += sigmoidf_(rg * acc[ai][bj][m][0][j]) * (p0[j] * rp); v1[j] += sigmoidf_(rg * acc[ai][bj][m][1][j]) * (p1[j] * rp); }
                    xo[bj][0] = v0; xo[bj][1] = v1;
                    s += (v0[0] * v0[0] + v0[1] * v0[1]) + (v0[2] * v0[2] + v0[3] * v0[3]) + (v1[0] * v1[0] + v1[1] * v1[1]) + (v1[2] * v1[2] + v1[3] * v1[3]); }
                q64_store((unsigned char*)x3, scl3, ((u.pm * 4 + u.pn) * 8 + wr * 4 + wc) * 8 + ai * 4 + m, fr, fq, xo[0][0], xo[0][1], xo[1][0], xo[1][1]);
                s = fq_sum(s, fr, fq);
                if (fq == 0) ssq3[(size_t)r * 16 + u.pn * 4 + wc] = s; } }
    }
};

__device__ __forceinline__ void conv_pass(Frame& F, const bf16* cu, const bf16* bg, bf16* ypre) {
    const int gw = F.vcu * NWAVES + F.wave, NGW = F.G * NWAVES, lane = F.lane();
    const float* cw = F.in[I_CONVW];
    for (int un = gw; un < (T / 64) * 2; un += NGW) {
        const int hc = un & 1, t0 = (un >> 1) * 64, ch = hc * 512 + lane * 8;
        f32x4 w0a = *(const GAS f32x4*)(cw + ch), w0b = *(const GAS f32x4*)(cw + ch + 4), w1a = *(const GAS f32x4*)(cw + D + ch), w1b = *(const GAS f32x4*)(cw + D + ch + 4),
              w2a = *(const GAS f32x4*)(cw + 2 * D + ch), w2b = *(const GAS f32x4*)(cw + 2 * D + ch + 4);
        f32x4 p2a = {0.f, 0.f, 0.f, 0.f}, p2b = p2a, p1a = p2a, p1b = p2a;
        if ((t0 & (SEQ - 1)) != 0) { unpack8(*(const GAS u32x4*)(cu + cu_off(t0 - 2, ch)), p2a, p2b); unpack8(*(const GAS u32x4*)(cu + cu_off(t0 - 1, ch)), p1a, p1b); }
        for (int i0 = 0; i0 < 64; i0 += 8) { u32x4 cr[8], br[8];
#pragma unroll
            for (int i = 0; i < 8; ++i) { const size_t ro = (size_t)(t0 + i0 + i) * D + ch; cr[i] = *(const GAS u32x4*)(cu + cu_off(t0 + i0 + i, ch)); br[i] = *(const GAS u32x4*)(bg + ro); }
#pragma unroll
            for (int i = 0; i < 8; ++i) { const size_t ro = (size_t)(t0 + i0 + i) * D + ch; f32x4 ca, cb, ba, bb;
                unpack8(cr[i], ca, cb); unpack8(br[i], ba, bb);
                const f32x4 ya = ba * (w0a * p2a + w1a * p1a + w2a * ca), yb = bb * (w0b * p2b + w1b * p1b + w2b * cb);
                *(GAS u32x4*)(ypre + ro) = pack8(ya, yb);
                p2a = p1a; p2b = p1b; p1a = ca; p1b = cb; } }
    }
}
__device__ __forceinline__ void state_scan(Frame& F, const bf16* kk, const bf16* vv, bf16* S) {
    LAS char* lds = (LAS char*)F.lds;
    constexpr int KST = 144, VST = 80, KBUF = 128 * KST, VBUF = 128 * VST;
    const int tid = F.tid(), lane = F.lane(), w = F.wave, g = lane >> 4, li = lane & 15, q4 = li >> 2, p4 = li & 3, vt = w >> 2, dt = w & 3;
    const int krow0 = tid >> 3, kch = tid & 7, vrow = tid >> 2, vch = tid & 3;
    for (int un = F.vcu; un < 64 * 4; un += F.G) {
        const int bh = un >> 2, vq = un & 3, b = bh >> 3, h = bh & 7;
        const float g128 = exp2f(128.0f * lg2_gamma(h));
        const bf16* kbase = kk + (size_t)b * SEQ * 512 + h * 64 + kch * 8; const bf16* vbase = vv + (size_t)b * SEQ * D + h * 128 + vq * 32 + vch * 8;
        f32x4 Sacc = {0.f, 0.f, 0.f, 0.f};
        u32x4 rk[3][2], rv[3];
#define SS_LOAD(slot, c_) do { const size_t t0_ = (size_t)(c_) * CH; rk[slot][0] = *(const GAS u32x4*)(kbase + (t0_ + krow0) * 512); rk[slot][1] = *(const GAS u32x4*)(kbase + (t0_ + krow0 + 64) * 512); \
        rv[slot] = *(const GAS u32x4*)(vbase + (t0_ + vrow) * D); } while (0)
#define SS_PUT(slot, buf) do { *(LAS u32x4*)(lds + (buf) * KBUF + krow0 * KST + kch * 16) = rk[slot][0]; *(LAS u32x4*)(lds + (buf) * KBUF + (krow0 + 64) * KST + kch * 16) = rk[slot][1]; \
        *(LAS u32x4*)(lds + 2 * KBUF + (buf) * VBUF + vrow * VST + vch * 16) = rv[slot]; } while (0)
#define SS_STEP(slot, c_) do { const int c = (c_); \
        { u32x2 o; o.x = cvt_pk_bf16(Sacc[0], Sacc[1]); o.y = cvt_pk_bf16(Sacc[2], Sacc[3]); \
          *(GAS u32x2*)(S + ((size_t)((bh * NCH + c) * 4 + vq) * 2048 + (size_t)(((16 * dt + li) >> 2) * 2 + vt) * 64 + (li & 3) * 16 + 4 * g)) = o; } \
        if (c + 3 < NCH - 1) SS_LOAD(slot, c + 3);             \
        lds_barrier(); \
        { const int cb = c & 1; const LAS char* kb = lds + cb * KBUF; const LAS char* vb = lds + 2 * KBUF + cb * VBUF; f32x4 a4 = Sacc; \
          _Pragma("unroll") for (int s = 0; s < 4; ++s) { const int r0 = 32 * s + 8 * g + q4; \
            const s16x4 alo = tr_read(vb + r0 * VST + (16 * vt + 4 * p4) * 2), ahi = tr_read(vb + (r0 + 4) * VST + (16 * vt + 4 * p4) * 2); \
            const s16x4 blo = tr_read(kb + r0 * KST + (16 * dt + 4 * p4) * 2), bhi = tr_read(kb + (r0 + 4) * KST + (16 * dt + 4 * p4) * 2); \
            const bf16x8 af = __builtin_shufflevector(alo, ahi, 0, 1, 2, 3, 4, 5, 6, 7), bf = __builtin_shufflevector(blo, bhi, 0, 1, 2, 3, 4, 5, 6, 7); \
            a4 = __builtin_amdgcn_mfma_f32_16x16x32_bf16(af, bf, a4, 0, 0, 0); } \
          Sacc = a4 * g128; } \
        if (c + 1 < NCH - 1) SS_PUT(((slot) + 1) % 3, (c + 1) & 1); } while (0)
        __syncthreads();
        SS_LOAD(0, 0); SS_LOAD(1, 1); SS_LOAD(2, 2);
        SS_PUT(0, 0);
        for (int c3 = 0; c3 < NCH - 1; c3 += 3) { SS_STEP(0, c3); SS_STEP(1, c3 + 1); SS_STEP(2, c3 + 2); }
        { u32x2 o; o.x = cvt_pk_bf16(Sacc[0], Sacc[1]); o.y = cvt_pk_bf16(Sacc[2], Sacc[3]);
          *(GAS u32x2*)(S + ((size_t)((bh * NCH + (NCH - 1)) * 4 + vq) * 2048 + (size_t)(((16 * dt + li) >> 2) * 2 + vt) * 64 + (li & 3) * 16 + 4 * g)) = o; }
#undef SS_LOAD
#undef SS_PUT
#undef SS_STEP
    }
    __syncthreads();
}

__device__ __forceinline__ void ret_out(Frame& F, const bf16* qq, const bf16* kk, const bf16* vv, const bf16* S, const bf16* sgs, bf16* og) {
    LAS char* lds = (LAS char*)F.lds;
    constexpr int VST = 288, KST = 144, KOFF = 192 * VST, OST = 272, OOFF = KOFF + 128 * KST;
    constexpr int NU = NB * NH * NCH;
    const int tid = F.tid(), lane = F.lane(), w = F.wave, g = lane >> 4, li = lane & 15, q4 = li >> 2, p4 = li & 3;
    const float* gret = F.in[I_GRET];
    LAS char* const obuf = lds + OOFF + w * (16 * OST);
    u32x4 pv[4], ps[2], pk[2]; bf16x8 pq[2];
#define RO_PREFETCH(un_) do { const int bh_ = (un_) >> 6, c_ = (un_) & 63, b_ = bh_ >> 3, h_ = bh_ & 7; const size_t t0_ = (size_t)b_ * SEQ + (size_t)c_ * CH; \
        _Pragma("unroll") for (int j = 0; j < 4; ++j) { const int piece = tid + 512 * j, row = piece >> 4, ch = piece & 15; pv[j] = *(const GAS u32x4*)(vv + (t0_ + row) * D + h_ * 128 + ch * 8); } \
        _Pragma("unroll") for (int j = 0; j < 2; ++j) { const int piece = tid + 512 * j, row = piece >> 4, ch = piece & 15; \
            ps[j] = (c_ > 0) ? *(const GAS u32x4*)(S + ((size_t)((bh_ * NCH + c_) * 4 + (ch >> 2)) * 2048 + (size_t)((row >> 2) * 2 + ((ch >> 1) & 1)) * 64 + (row & 3) * 16 + (ch & 1) * 8)) : (u32x4){0u, 0u, 0u, 0u}; } \
        _Pragma("unroll") for (int j = 0; j < 2; ++j) { const int piece = tid + 512 * j, row = piece >> 3, ch = piece & 7; pk[j] = *(const GAS u32x4*)(kk + (t0_ + row) * 512 + h_ * 64 + ch * 8); } \
        _Pragma("unroll") for (int s_ = 0; s_ < 2; ++s_) pq[s_] = *(const GAS bf16x8*)(qq + (t0_ + 16 * w + li) * 512 + h_ * 64 + 32 * s_ + 8 * g); } while (0)
    int un = blockIdx.x;
    if (un < NU) RO_PREFETCH(un);
    for (; un < NU; un += F.G) {
        const int bh = un >> 6, c = un & 63, b = bh >> 3, h = bh & 7;
        const size_t tok0 = (size_t)b * SEQ + (size_t)c * CH;
        bf16x8 qf[2]; qf[0] = pq[0]; qf[1] = pq[1];
        lds_barrier();
#pragma unroll
        for (int j = 0; j < 4; ++j) { const int piece = tid + 512 * j, row = piece >> 4, ch = piece & 15; *(LAS u32x4*)(lds + row * VST + ch * 16) = pv[j]; }
#pragma unroll
        for (int j = 0; j < 2; ++j) { const int piece = tid + 512 * j, row = piece >> 4, ch = piece & 15; *(LAS u32x4*)(lds + (128 + row) * VST + ch * 16) = ps[j]; }
#pragma unroll
        for (int j = 0; j < 2; ++j) { const int piece = tid + 512 * j, row = piece >> 3, ch = piece & 7; *(LAS u32x4*)(lds + KOFF + row * KST + ch * 16) = pk[j]; }
        if (un + F.G < NU) RO_PREFETCH(un + F.G);
        u32x4 sgv[4];
#pragma unroll
        for (int j = 0; j < 4; ++j) { const int piece = lane + 64 * j, row = piece >> 4, ch = piece & 15; sgv[j] = *(const GAS u32x4*)(sgs + (tok0 + 16 * w + row) * D + h * 128 + ch * 8); }
        lds_barrier();
        f32x4 pt[8];
#pragma unroll
        for (int t = 0; t < 8; ++t) {
            pt[t] = (f32x4){0.f, 0.f, 0.f, 0.f};
            if (t <= w) {
                const bf16x8 k0 = *(const LAS bf16x8*)(lds + KOFF + (16 * t + li) * KST + (8 * g) * 2), k1 = *(const LAS bf16x8*)(lds + KOFF + (16 * t + li) * KST + (32 + 8 * g) * 2);
                pt[t] = __builtin_amdgcn_mfma_f32_16x16x32_bf16(k0, qf[0], pt[t], 0, 0, 0);
                pt[t] = __builtin_amdgcn_mfma_f32_16x16x32_bf16(k1, qf[1], pt[t], 0, 0, 0);
                if (t == w) {
#pragma unroll
                    for (int r = 0; r < 4; ++r) if (4 * g + r > li) pt[t][r] = 0.f; }
            }
        }
        f32x4 acc[8];
#pragma unroll
        for (int n = 0; n < 8; ++n) acc[n] = (f32x4){0.f, 0.f, 0.f, 0.f};
#pragma unroll
        for (int s2 = 0; s2 < 4; ++s2) {
            if (2 * s2 <= w) {
                u32x4 pw; pw.x = cvt_pk_bf16(pt[2 * s2][0], pt[2 * s2][1]); pw.y = cvt_pk_bf16(pt[2 * s2][2], pt[2 * s2][3]);
                pw.z = cvt_pk_bf16(pt[2 * s2 + 1][0], pt[2 * s2 + 1][1]); pw.w = cvt_pk_bf16(pt[2 * s2 + 1][2], pt[2 * s2 + 1][3]);
                const bf16x8 pa = __builtin_bit_cast(bf16x8, pw);
#pragma unroll
                for (int n = 0; n < 8; ++n) {
                    const s16x4 lo = tr_read(lds + (32 * s2 + 4 * g + q4) * VST + (16 * n + 4 * p4) * 2), hi = tr_read(lds + (32 * s2 + 16 + 4 * g + q4) * VST + (16 * n + 4 * p4) * 2);
                    const bf16x8 vf = __builtin_shufflevector(lo, hi, 0, 1, 2, 3, 4, 5, 6, 7);
                    acc[n] = __builtin_amdgcn_mfma_f32_16x16x32_bf16(vf, pa, acc[n], 0, 0, 0);
                }
            }
        }
        if (c > 0) {
#pragma unroll
            for (int s = 0; s < 2; ++s)
#pragma unroll
                for (int n = 0; n < 8; ++n) {
                    const s16x4 lo = tr_read(lds + (128 + 32 * s + 8 * g + q4) * VST + (16 * n + 4 * p4) * 2), hi = tr_read(lds + (128 + 32 * s + 8 * g + 4 + q4) * VST + (16 * n + 4 * p4) * 2);
                    const bf16x8 sf = __builtin_shufflevector(lo, hi, 0, 1, 2, 3, 4, 5, 6, 7);
                    acc[n] = __builtin_amdgcn_mfma_f32_16x16x32_bf16(sf, qf[s], acc[n], 0, 0, 0);
                }
        }
        float ssum = 0.f;
#pragma unroll
        for (int n = 0; n < 8; ++n) ssum += (acc[n][0] * acc[n][0] + acc[n][1] * acc[n][1]) + (acc[n][2] * acc[n][2] + acc[n][3] * acc[n][3]);
        ssum += __shfl_xor(ssum, 16); ssum += __shfl_xor(ssum, 32);
        const float rs = 1.0f / sqrtf(ssum * (1.f / DV) + EPS);
#pragma unroll
        for (int n = 0; n < 8; ++n) { const f32x4 gr = *(const GAS f32x4*)(gret + h * 128 + 16 * n + 4 * g); const f32x4 o = acc[n] * gr * rs;
            u32x2 pk2; pk2.x = cvt_pk_bf16(o[0], o[1]); pk2.y = cvt_pk_bf16(o[2], o[3]);
            *(LAS u32x2*)(obuf + li * OST + (16 * n + 4 * g) * 2) = pk2; }
        asm volatile("s_waitcnt lgkmcnt(0)" ::: "memory");
#pragma unroll
        for (int j = 0; j < 4; ++j) { const int piece = lane + 64 * j, row = piece >> 4, ch = piece & 15;
            const u32x4 ov = *(const LAS u32x4*)(obuf + row * OST + ch * 16);
            f32x4 o0, o1, s0, s1; unpack8(ov, o0, o1); unpack8(sgv[j], s0, s1);
            *(GAS u32x2*)((unsigned char*)og + (size_t)(tok0 + 16 * w + row) * D + h * 128 + ch * 8) = pack8_fp8(o0 * s0, o1 * s1); }
        asm volatile("s_waitcnt lgkmcnt(0)" ::: "memory");
    }
#undef RO_PREFETCH
    __syncthreads();
}

__device__ __forceinline__ void moe_tables(Frame& F, unsigned* gcnt) {
    LAS int* tb = (LAS int*)(F.lds + TB_OFF); LAS int* cn = (LAS int*)(F.lds + CN_OFF);
    __syncthreads();
    if (F.tid() < 32) cn[F.tid()] = (int)__hip_atomic_load(gcnt + F.tid(), RLX_AGENT);
    __syncthreads();
    if (F.tid() == 0) { int a = 0; for (int e = 0; e < 32; ++e) { tb[e] = a; a += (cn[e] + 255) >> 8; } tb[32] = a; }
    __syncthreads();
    { LAS int* te = (LAS int*)(F.lds + TE_OFF); for (int t = F.tid(); t < tb[32]; t += NTHR) { int e = 0; while (e < 31 && tb[e + 1] <= t) ++e; te[t] = e; } }
    __syncthreads();
}
__device__ __forceinline__ void combine_pass(Frame& F, bf16* xb, const bf16* Y, float* rstd3, const float* ssqp, float* rstdp, unsigned char* x8, float* sa2) {
    const int gw = F.vcu * NWAVES + F.wave, NGW = F.G * NWAVES, lane = F.lane();
    for (int m = gw; m < T; m += NGW) {
        GAS u32x4* xr = (GAS u32x4*)(xb + (size_t)m * D) + lane; const GAS u32x2* y0 = (const GAS u32x2*)((const unsigned char*)Y + (size_t)m * D) + lane; const GAS u32x2* y1 = (const GAS u32x2*)((const unsigned char*)Y + (size_t)T * D + (size_t)m * D) + lane;
        u32x4 xa[2]; u32x2 ya[2], yb[2];
#pragma unroll
        for (int j = 0; j < 2; ++j) { xa[j] = xr[64 * j]; ya[j] = y0[64 * j]; yb[j] = y1[64 * j]; }
        float s = 0.f; f32x4 v[2][2];
#pragma unroll
        for (int j = 0; j < 2; ++j) { f32x4 a0, a1, b0, b1; unpack8(xa[j], v[j][0], v[j][1]); unpack8_fp8(ya[j], a0, a1); unpack8_fp8(yb[j], b0, b1);
            v[j][0] += (a0 + b0) * (1.0f / 16.0f); v[j][1] += (a1 + b1) * (1.0f / 16.0f);
#pragma unroll
            for (int q = 0; q < 2; ++q) s += (v[j][q][0] * v[j][q][0] + v[j][q][1] * v[j][q][1]) + (v[j][q][2] * v[j][q][2] + v[j][q][3] * v[j][q][3]); }
        s = wave_sum(s);
        float mx = 0.f;
#pragma unroll
        for (int j = 0; j < 2; ++j)
#pragma unroll
            for (int q = 0; q < 2; ++q)
#pragma unroll
                for (int e = 0; e < 4; ++e) mx = fmaxf(mx, fabsf(v[j][q][e]));
#pragma unroll
        for (int o = 1; o < 64; o <<= 1) mx = fmaxf(mx, __shfl_xor(mx, o));
        mx = fmaxf(mx, 1e-30f); const float qs = 127.0f / mx;
#pragma unroll
        for (int j = 0; j < 2; ++j) { xr[64 * j] = pack8(v[j][0], v[j][1]); unsigned lo = 0u, hi = 0u;
#pragma unroll
            for (int e = 0; e < 4; ++e) { lo |= ((unsigned)(int)__builtin_rintf(v[j][0][e] * qs) & 0xffu) << (8 * e); hi |= ((unsigned)(int)__builtin_rintf(v[j][1][e] * qs) & 0xffu) << (8 * e); }
            ((GAS u32x2*)(x8 + (size_t)m * D))[lane + 64 * j] = (u32x2){lo, hi}; }
        if (lane == 0) sa2[m] = mx * (1.0f / 127.0f);
        const float sp = wave_sum(lane < 16 ? ssqp[(size_t)m * 16 + lane] : 0.f);
        if (lane == 0) { rstd3[m] = 1.0f / sqrtf(s * (1.f / D) + EPS); rstdp[m] = 1.0f / sqrtf(sp * (1.f / D) + EPS); }
    }
}
__device__ __forceinline__ void final_pass(Frame& F, const unsigned char* x3q, const float* scl3, const float* ssq3, float* out) {
    const int gw = F.vcu * NWAVES + F.wave, NGW = F.G * NWAVES, lane = F.lane(), fr = lane & 15, fq = lane >> 4;
    const float* gf = F.in[I_GFIN]; LAS float* tl = (LAS float*)(F.lds + F.wave * 16384);
    for (int rg = gw; rg < T / 16; rg += NGW) {
        const int pm = rg >> 4, ai = (rg >> 3) & 1, wr = (rg >> 2) & 1, m = rg & 3; const unsigned r = (unsigned)(pm * 256 + ai * 128 + wr * 64 + m * 16 + fr);
        const f32x4 pr = *(const GAS f32x4*)(ssq3 + r * 16u + 4u * (unsigned)fq);
        const float ssum = fq_sum((pr[0] + pr[1]) + (pr[2] + pr[3]), fr, fq), rstd = 1.0f / sqrtf(ssum * (1.f / D) + EPS);
        const unsigned rbase = (unsigned)(pm * 256 + ai * 128 + wr * 64 + m * 16);
#pragma unroll 1
        for (int half = 0; half < 2; ++half) {
        u32x4 wv[8]; float scv[8];
#pragma unroll
        for (int c8 = 0; c8 < 8; ++c8) { const int cgp = half * 8 + c8, pn = cgp >> 2, wc = cgp & 3; const unsigned blk = (unsigned)(((pm * 4 + pn) * 8 + wr * 4 + wc) * 8 + ai * 4 + m);
            wv[c8] = *(const GAS u32x4*)(x3q + (blk * 64u + (unsigned)lane) * 16u); scv[c8] = scl3[blk * 16u + (unsigned)fr]; }
#pragma unroll
        for (int c8 = 0; c8 < 8; ++c8) { const int cgp = half * 8 + c8, pn = cgp >> 2, wc = cgp & 3;
            f32x4 a0, a1, b0, b1; q64_unpack(wv[c8], scv[c8] * rstd, a0, a1, b0, b1);
            LAS f32x4* wp = (LAS f32x4*)(tl + (c8 & 1) * (16 * 68) + fr * 68 + 8 * fq); wp[0] = a0; wp[1] = a1; wp[8] = b0; wp[9] = b1;
            asm volatile("s_waitcnt lgkmcnt(0)" ::: "memory");
            const unsigned c0 = (unsigned)(pn * 256 + wc * 64 + 4 * (lane & 15)); const f32x4 g = *(const GAS f32x4*)(gf + c0);
#pragma unroll
            for (int k = 0; k < 4; ++k) { const int row = 4 * k + (lane >> 4); const f32x4 v = *(const LAS f32x4*)(tl + (c8 & 1) * (16 * 68) + row * 68 + 4 * (lane & 15));
                *(GAS f32x4*)(out + (rbase + (unsigned)row) * (unsigned)D + c0) = v * g; } }
        }
    }
}

constexpr int N_PHASES = 16;
#ifndef STAG_ON
#define STAG_ON 0
#endif
#define STAG(t) (STAG_ON ? (t) : 0)
__global__ void __launch_bounds__(NTHR, 2) hyb_fwd(Args args) {
    extern __shared__ __attribute__((aligned(16))) unsigned char lds_raw[];
    Frame F;
    F.lds = (LAS unsigned char*)lds_raw;
    F.wave = __builtin_amdgcn_readfirstlane((int)(threadIdx.x >> 6));
    F.G = gridDim.x; { const int bx = blockIdx.x; F.vcu = (F.G % 8 == 0) ? (bx % 8) * (F.G / 8) + bx / 8 : bx; }
#pragma unroll
    for (int i = 0; i < 22; ++i) F.in[i] = args.in[i];
    F.ws = args.ws; F.out = (unsigned char*)args.out;
    unsigned char* ws = args.ws;
    volatile LAS unsigned* MISC = (volatile LAS unsigned*)(F.lds + MISC_OFF);
    for (int u = F.tid(); u < (LDS_BYTES - RING_BYTES) / 4; u += NTHR) ((LAS unsigned*)(F.lds + RING_BYTES))[u] = 0u;
    __syncthreads();
    unsigned* ctl = (unsigned*)(ws + WS_CTL);
    const int lo = args.ph_lo, hi = args.ph_hi;
    const bool multi = (hi - lo) > 1;
    XcdBarrier bar; bar.bar = ctl + CW_BAR + args.li * XCD_BAR_WORDS; bar.x = 0; bar.st = nullptr;
    if (multi) bar = xcd_barrier_post(ctl + CW_BAR + args.li * XCD_BAR_WORDS, MISC + 8, F.wave);
#define IN(k) (lo <= (k) && (k) < hi)
#define SEAM(k) do { if (IN(k) && IN((k) + 1)) xcd_barrier(bar, F.wave); } while (0)

    bf16* const bufA = (bf16*)(ws + WS_A);
    bf16* const cu = (bf16*)F.out; bf16* const ypre = (bf16*)F.out + (size_t)T * D;
    bf16* const og = (bf16*)F.out;
    bf16* const Yb = (bf16*)F.out;
    unsigned char* const x8 = (unsigned char*)(ws + WS_Q);
    bf16* const qb = (bf16*)(ws + WS_Q); bf16* const kb = (bf16*)(ws + WS_K); bf16* const vb = (bf16*)(ws + WS_V); bf16* const sgb = (bf16*)(ws + WS_SG);
    bf16* const mcb = (bf16*)(ws + WS_MC); bf16* const mixc = (bf16*)(ws + WS_MC + 64 * MiB);
    bf16* const mrb = (bf16*)(ws + WS_MR + 64 * MiB); bf16* const Sb = (bf16*)(ws + WS_S);
    bf16* const mixed = (bf16*)(ws + WS_V); bf16* const ppb = (bf16*)(ws + WS_SG);
    bf16* const x3b = (bf16*)(ws + WS_V); float* const rstd3 = (float*)(ws + WS_SSQ1); float* const rstdp = (float*)(ws + WS_SSQ1 + (size_t)T * 4); bf16* const hid = (bf16*)(ws + WS_MC);
    float* const ssq1 = (float*)(ws + WS_SSQ1); float* const ssqp = (float*)(ws + WS_SSQP); float* const ssq3 = (float*)(ws + WS_SSQ3);
    u32x4* const route = (u32x4*)(ws + WS_ROUTE); u32x4* const lists = (u32x4*)(ws + WS_LIST); float* const rstd2 = (float*)(ws + WS_RSTD2);
    unsigned* const gcnt = ctl + CW_CNT;
    const LAS int* tb = (const LAS int*)(F.lds + TB_OFF); const LAS int* cn = (const LAS int*)(F.lds + CN_OFF); const LAS int* te = (const LAS int*)(F.lds + TE_OFF);

    if (IN(0)) { p0_prologue(F); if (multi) xcd_barrier(bar, F.wave); p0_quant_win(F); } SEAM(0);
    if (IN(1)) { pg8::StaticOrder S; S.init(ws + WS_S, ws + W_IN, T, 2048, D / 2, F.G, (int)blockIdx.x);
        EpiG1 E{(const float*)(ws + WS_SSQ3), (const float*)(ws + WS_SB), cu, ypre, qb, kb, vb, sgb, mcb, mrb, (const f32x2*)(ws + WS_ROPE), (const LAS float*)(F.lds + CWL_OFF), 0};
        pg8::gemm_phase(F.lds, F.wave, D / 2, S, E, args.noepi, (F.vcu & 1) ? STAG(1700) : 0); } SEAM(1);
    if (IN(2)) { { LAS float* cwl = (LAS float*)(F.lds + CWL_OFF); for (int i = F.tid(); i < 3 * D; i += NTHR) cwl[i] = F.in[I_CONVW][i]; __syncthreads(); }
        pg8::StaticOrder S; S.init(ws + WS_S, ws + W_IN + (size_t)2048 * D, T, NIN - 2048, D / 2, F.G, (int)blockIdx.x);
        EpiG1 E{(const float*)(ws + WS_SSQ3), (const float*)(ws + WS_SB), cu, ypre, qb, kb, vb, sgb, mcb, mrb, (const f32x2*)(ws + WS_ROPE), (const LAS float*)(F.lds + CWL_OFF), 8};
        pg8::gemm_phase(F.lds, F.wave, D / 2, S, E, args.noepi); } SEAM(2);
    if (IN(3)) { state_scan(F, kb, vb, Sb); } SEAM(3);
    if (IN(4)) { ret_out(F, qb, kb, vb, Sb, sgb, og); }
    if (IN(5)) { pg8::StaticOrder S; S.init(ypre, ws + W_OC, T, D, D, F.G, (int)blockIdx.x);
        EpiGate<0> E{mcb, nullptr, mixc, args.noepi, vb, (float*)(ws + WS_MR)};
        pg8::gemm_phase(F.lds, F.wave, D, S, E, args.noepi, (F.vcu & 1) ? STAG(2000) : 0); } SEAM(5);
    if (IN(6)) { pg8::StaticOrder S; S.init(og, ws + W_OR, T, D, D / 2, F.G, (int)blockIdx.x);
        EpiGate<1, true> E{mrb, mixc, mixed, args.noepi, vb, (float*)(ws + WS_MR)};
        pg8::gemm_phase(F.lds, F.wave, D / 2, S, E, args.noepi, (F.vcu & 1) ? STAG(2000) : 0); } SEAM(6);
    if (IN(7)) { pg8::StaticOrder S; S.init(mixed, ws + W_O, T, D, D, F.G, (int)blockIdx.x);
        EpiRes E{(const float*)(ws + WS_RSTD2), bufA, ssq1, x8};
        pg8::gemm_phase(F.lds, F.wave, D, S, E, args.noepi, (F.vcu & 1) ? STAG(2500) : 0); }
    SEAM(7);
    if (IN(8)) { pg8::StaticOrder S; S.init(bufA, ws + W_R, T, 256, D, F.G, (int)blockIdx.x);
        EpiRoute E{ssq1, F.in[I_BRG], F.in[I_BRE], rstd2, lists, gcnt, (LAS int*)(F.lds + HS_OFF)};
        pg8::gemm_phase(F.lds, F.wave, D, S, E, args.noepi); }
    if (IN(13)) { pg8::StaticOrder S; S.init(ws + WS_PB, ws + W_PP, T, D, PLE, F.G, (int)blockIdx.x);
        EpiPP E{ppb, ssqp, F.in[I_GPOST], (float*)(ws + WS_SG + 64 * MiB)};
        pg8::gemm_phase(F.lds, F.wave, PLE, S, E); }
    SEAM(9);
    if (IN(10)) { moe_tables(F, gcnt);
        MoeSched<true> S{tb, cn, te, lists, (const char*)x8, (const char*)(ws + W_GU), (size_t)1024 * 1024, D / 2, F.G, F.vcu};
        EpiHid E{tb, cn, lists, hid};
        pg8::gemm_phase(F.lds, F.wave, D / 2, S, E, args.noepi, (F.vcu & 1) ? STAG(2000) : 0); } SEAM(10);
    if (IN(11)) { moe_tables(F, gcnt);
        MoeSched<false> S{tb, cn, te, lists, (const char*)hid, (const char*)(ws + W_DN), (size_t)1024 * 512, DE / 2, F.G, F.vcu};
        EpiDown E{tb, cn, lists, Yb};
        pg8::gemm_phase(F.lds, F.wave, DE / 2, S, E); } SEAM(11);
    if (IN(12)) { combine_pass(F, bufA, Yb, rstd3, ssqp, rstdp, x8, rstd3 + 2 * T); } SEAM(12);
    if (IN(14)) { pg8::StaticOrder S; S.init(x8, ws + W_PG, T, D, D / 2, F.G, (int)blockIdx.x);
        EpiPle E{bufA, rstd3, ppb, rstdp, x3b, ssq3, rstd3 + 2 * T, (const float*)(ws + WS_SB) + NIN, (const float*)(ws + WS_SG + 64 * MiB), (float*)(ws + WS_V + 64 * MiB)};
        pg8::gemm_phase(F.lds, F.wave, D / 2, S, E, args.noepi, (F.vcu & 1) ? STAG(2500) : 0); } SEAM(14);
    if (IN(15)) { final_pass(F, (const unsigned char*)x3b, (const float*)(ws + WS_V + 64 * MiB), ssq3, (float*)F.out); }
#undef IN
#undef SEAM
}

extern "C" void kernel_launch(void* const* d_in, const int* in_sizes, int n_in, void* d_out, int out_size, void* d_ws, size_t ws_size, hipStream_t stream) {
    static int grid = 0;
    if (grid == 0) {
        if (n_in != 22 || in_sizes[0] != T * D || out_size != T * D || ws_size < WS_END) { fprintf(stderr, "kernel_launch: unexpected shapes / workspace (ws %zu, need %zu)\n", ws_size, (size_t)WS_END); grid = -1; return; }
        int dev = 0, cus = 0, per_cu = 0;
        if (hipGetDevice(&dev) != hipSuccess || hipDeviceGetAttribute(&cus, hipDeviceAttributeMultiprocessorCount, dev) != hipSuccess) { grid = -1; return; }
        if (hipFuncSetAttribute((const void*)hyb_fwd, hipFuncAttributeMaxDynamicSharedMemorySize, LDS_BYTES) != hipSuccess) { fprintf(stderr, "kernel_launch: hipFuncSetAttribute failed\n"); grid = -1; return; }
        if (hipOccupancyMaxActiveBlocksPerMultiprocessor(&per_cu, (const void*)hyb_fwd, NTHR, LDS_BYTES) != hipSuccess || per_cu < 1) { fprintf(stderr, "kernel_launch: occupancy query says %d\n", per_cu); }
        (void)hipGetLastError();
        grid = cus;
    }
    if (grid < 0) return;
    if (hipMemsetAsync((char*)d_ws + WS_CTL, 0, CTL_ZERO_BYTES, stream) != hipSuccess) return;
    Args a{};
    for (int i = 0; i < 22; ++i) a.in[i] = (const float*)d_in[i];
    a.out = (float*)d_out; a.ws = (unsigned char*)d_ws;
#if defined(PROBE_DUP)
    a.ph_lo = 0; a.ph_hi = PROBE_DUP + 1; hipLaunchKernelGGL(hyb_fwd, dim3(grid), dim3(NTHR), LDS_BYTES, stream, a);
    for (int rep = 0; rep < PROBE_REPS; ++rep) { a.li = 1; a.noepi = PROBE_NOEPI; a.ph_lo = PROBE_DUP; a.ph_hi = PROBE_DUP + 1; hipLaunchKernelGGL(hyb_fwd, dim3(grid), dim3(NTHR), LDS_BYTES, stream, a);
#if defined(PROBE_INTER)
        a.noepi = 0; a.ph_lo = PROBE_INTER; a.ph_hi = PROBE_INTER + 1; hipLaunchKernelGGL(hyb_fwd, dim3(grid), dim3(NTHR), LDS_BYTES, stream, a);
#endif
    }
    a.li = 2; a.noepi = 0; a.ph_lo = PROBE_DUP + 1; a.ph_hi = N_PHASES; hipLaunchKernelGGL(hyb_fwd, dim3(grid), dim3(NTHR), LDS_BYTES, stream, a);
#else
    a.ph_lo = 0; a.ph_hi = N_PHASES;
    hipLaunchKernelGGL(hyb_fwd, dim3(grid), dim3(NTHR), LDS_BYTES, stream, a);
#endif
}
```

```cpp
#include <hip/hip_runtime.h>
#include <cstdio>
#include <cstdint>

#define LAS __attribute__((address_space(3)))
#define GAS __attribute__((address_space(1)))
typedef unsigned short bf16;
typedef short bf16x8 __attribute__((ext_vector_type(8)));
typedef short s16x4 __attribute__((ext_vector_type(4)));
typedef float f32x4 __attribute__((ext_vector_type(4)));
typedef float f32x2 __attribute__((ext_vector_type(2)));
typedef unsigned u32x4 __attribute__((ext_vector_type(4)));
typedef unsigned u32x2 __attribute__((ext_vector_type(2)));
typedef int v4i32 __attribute__((ext_vector_type(4)));
typedef int v8i32 __attribute__((ext_vector_type(8)));
typedef GAS unsigned gu32;
#define RLX_AGENT __ATOMIC_RELAXED, __HIP_MEMORY_SCOPE_AGENT

constexpr int D = 1024, NB = 8, SEQ = 8192, T = NB * SEQ, PLE = 256;
constexpr int NH = 8, DK = 64, DV = 128, CH = 128, NCH = SEQ / CH;
constexpr int NE = 32, DE = 512;
constexpr int NIN = 8192;
constexpr float EPS = 1e-6f;
constexpr int NWAVES = 8, NTHR = 512;

constexpr size_t MiB = 1u << 20;
constexpr size_t WS_CMAX = 64 * 1024, WS_SB = 128 * 1024;
constexpr size_t WS_RMAX = 256 * 1024;
constexpr size_t WS_CTL = 0, CTL_ZERO_BYTES = 512 * 1024;
constexpr size_t WS_ROUTE = 1 * MiB;
constexpr size_t WS_ROPE = 2 * MiB;
constexpr size_t WS_SSQ1 = 4 * MiB;
constexpr size_t WS_SSQP = 8 * MiB;
constexpr size_t WS_SSQ3 = 12 * MiB;
constexpr size_t WS_LIST = 840 * MiB;
constexpr size_t WS_W = 32 * MiB;
constexpr size_t W_IN = WS_W;
constexpr size_t W_OC = W_IN + 16 * MiB;
constexpr size_t W_OR = W_OC + 2 * MiB;
constexpr size_t W_O = W_OR + 2 * MiB;
constexpr size_t W_PG = W_O + 2 * MiB;
constexpr size_t W_PP = W_PG + 2 * MiB;
constexpr size_t W_R = W_PP + 1 * MiB;
constexpr size_t W_IN8 = W_IN + 10 * MiB;
constexpr size_t W_GU = W_R + 1 * MiB;
constexpr size_t W_DN = W_GU + 64 * MiB;
constexpr size_t WS_RSTD2 = W_DN + 32 * MiB;
constexpr size_t WS_A = 155 * MiB;
constexpr size_t WS_PB = 283 * MiB;
constexpr size_t WS_Q = 315 * MiB;
constexpr size_t WS_K = 379 * MiB;
constexpr size_t WS_V = 443 * MiB;
constexpr size_t WS_SG = 571 * MiB;
constexpr size_t WS_MC = 699 * MiB;
constexpr size_t WS_MR = 827 * MiB;
constexpr size_t WS_S = 955 * MiB;
constexpr size_t WS_END = 1019 * MiB;
static_assert(WS_RSTD2 + (size_t)T * 4 <= WS_A, "ws map");

constexpr int CW_CNT = 64;
constexpr int CW_BAR = 4096;

constexpr int RING_BYTES = 131072;
constexpr int MISC_OFF = RING_BYTES;
constexpr int TB_OFF = RING_BYTES + 256;
constexpr int CN_OFF = RING_BYTES + 512;
constexpr int HS_OFF = RING_BYTES + 768;
constexpr int TE_OFF = RING_BYTES + 1536;
constexpr int CWL_OFF = RING_BYTES + 4096;
constexpr int LDS_BYTES = 147456;

typedef __bf16 bf16x2_t __attribute__((ext_vector_type(2)));
__device__ __forceinline__ unsigned cvt_pk_bf16(float lo, float hi) { const f32x2 v = {lo, hi}; const bf16x2_t b = __builtin_convertvector(v, bf16x2_t); return __builtin_bit_cast(unsigned, b); }
__device__ __forceinline__ float bf_lo(unsigned u) { return __uint_as_float(u << 16); }
__device__ __forceinline__ float bf_hi(unsigned u) { return __uint_as_float(u & 0xffff0000u); }
__device__ __forceinline__ float bf2f(bf16 b) { return __uint_as_float(((unsigned)b) << 16); }
__device__ __forceinline__ bf16 f2bf(float f) { unsigned u = __float_as_uint(f); return (bf16)((u + 0x7fffu + ((u >> 16) & 1u)) >> 16); }
__device__ __forceinline__ u32x4 pack8(const f32x4 a, const f32x4 b) { u32x4 w; w.x = cvt_pk_bf16(a[0], a[1]); w.y = cvt_pk_bf16(a[2], a[3]); w.z = cvt_pk_bf16(b[0], b[1]); w.w = cvt_pk_bf16(b[2], b[3]); return w; }
__device__ __forceinline__ void unpack8(const u32x4 w, f32x4& a, f32x4& b) { a = (f32x4){bf_lo(w.x), bf_hi(w.x), bf_lo(w.y), bf_hi(w.y)}; b = (f32x4){bf_lo(w.z), bf_hi(w.z), bf_lo(w.w), bf_hi(w.w)}; }
__device__ __forceinline__ void st16_wt(bf16* base, size_t off, const u32x4 v) { __builtin_nontemporal_store(v, (GAS u32x4*)(base + off)); }
__device__ __forceinline__ unsigned rot8(unsigned v) { return (unsigned)__builtin_amdgcn_update_dpp(0, (int)v, 0x128, 0xf, 0xf, false); }
__device__ __forceinline__ u32x4 rot8v(const u32x4 v) { u32x4 r; r.x = rot8(v.x); r.y = rot8(v.y); r.z = rot8(v.z); r.w = rot8(v.w); return r; }
__device__ __forceinline__ void st_lines(bf16* base, unsigned rowoff  , const u32x4 a0, const u32x4 a1, int fr, int fq) {
    const bool hi = fr >= 8; const unsigned ro_r = rot8(rowoff); const u32x4 r0 = rot8v(a0), r1 = rot8v(a1);
    const u32x4 X = hi ? r1 : a0, Y = hi ? a1 : r0; const unsigned offX = hi ? ro_r : rowoff, offY = hi ? rowoff : ro_r, seg = (unsigned)(fq + (hi ? 4 : 0)) * 8u;
    st16_wt(base, offX + seg, X); st16_wt(base, offY + seg, Y);
}
__device__ __forceinline__ u32x2 pack8_fp8(const f32x4 a, const f32x4 b) {
    auto cl = [](float x) { return fminf(fmaxf(x, -448.f), 448.f); };
    int lo = __builtin_amdgcn_cvt_pk_fp8_f32(cl(a[0]), cl(a[1]), 0, false); lo = __builtin_amdgcn_cvt_pk_fp8_f32(cl(a[2]), cl(a[3]), lo, true);
    int hi = __builtin_amdgcn_cvt_pk_fp8_f32(cl(b[0]), cl(b[1]), 0, false); hi = __builtin_amdgcn_cvt_pk_fp8_f32(cl(b[2]), cl(b[3]), hi, true);
    return (u32x2){(unsigned)lo, (unsigned)hi};
}
__device__ __forceinline__ void unpack8_fp8(const u32x2 v, f32x4& a, f32x4& b) {
    const f32x2 a0 = __builtin_amdgcn_cvt_pk_f32_fp8((int)v.x, false), a1 = __builtin_amdgcn_cvt_pk_f32_fp8((int)v.x, true), b0 = __builtin_amdgcn_cvt_pk_f32_fp8((int)v.y, false), b1 = __builtin_amdgcn_cvt_pk_f32_fp8((int)v.y, true);
    a = (f32x4){a0[0], a0[1], a1[0], a1[1]}; b = (f32x4){b0[0], b0[1], b1[0], b1[1]};
}
__device__ __forceinline__ unsigned q8x4(const f32x4 g) { const unsigned a = (unsigned)(g[0] * 255.f + 0.5f), b = (unsigned)(g[1] * 255.f + 0.5f), c = (unsigned)(g[2] * 255.f + 0.5f), d = (unsigned)(g[3] * 255.f + 0.5f); return a | (b << 8) | (c << 16) | (d << 24); }
__device__ __forceinline__ f32x4 dq8x4(const unsigned w) { return (f32x4){(float)(w & 0xffu), (float)((w >> 8) & 0xffu), (float)((w >> 16) & 0xffu), (float)(w >> 24)} * (1.0f / 255.0f); }
__device__ __forceinline__ unsigned gate8_off(int tile, int wid, int grp, int lane) { return (unsigned)((((tile * 8 + wid) * 8 + grp) * 64 + lane) * 16); }
__device__ __forceinline__ unsigned qb8x4(const f32x4 v, const float qs) { const unsigned a = (unsigned)(int)(__builtin_rintf(v[0] * qs) + 128.f), b = (unsigned)(int)(__builtin_rintf(v[1] * qs) + 128.f), c = (unsigned)(int)(__builtin_rintf(v[2] * qs) + 128.f), d = (unsigned)(int)(__builtin_rintf(v[3] * qs) + 128.f); return a | (b << 8) | (c << 16) | (d << 24); }
__device__ __forceinline__ f32x4 dqb8x4(const unsigned w, const float sc, const float off) { return (f32x4){(float)(w & 0xffu), (float)((w >> 8) & 0xffu), (float)((w >> 16) & 0xffu), (float)(w >> 24)} * sc + off; }
__device__ __forceinline__ void q64_store(unsigned char* q8, float* scl, int blk, int fr, int fq, const f32x4 a0, const f32x4 a1, const f32x4 b0, const f32x4 b1, unsigned* rowmax = nullptr) {
    float mx = 0.f;
#pragma unroll
    for (int e = 0; e < 4; ++e) mx = fmaxf(fmaxf(mx, fmaxf(fabsf(a0[e]), fabsf(a1[e]))), fmaxf(fabsf(b0[e]), fabsf(b1[e])));
    const int ln = fq * 16 + fr;
    mx = fmaxf(mx, __int_as_float(__builtin_amdgcn_ds_bpermute((ln ^ 16) << 2, __float_as_int(mx)))); mx = fmaxf(mx, __int_as_float(__builtin_amdgcn_ds_bpermute((ln ^ 32) << 2, __float_as_int(mx))));
    mx = fmaxf(mx, 1e-30f); const float qs = 127.0f / mx;
    const u32x4 o = {qb8x4(a0, qs), qb8x4(a1, qs), qb8x4(b0, qs), qb8x4(b1, qs)};
    *(GAS u32x4*)(q8 + ((size_t)blk * 64 + ln) * 16) = o;
    if (fq == 0) { scl[(size_t)blk * 16 + fr] = mx * (1.0f / 127.0f); if (rowmax) atomicMax(rowmax, __float_as_uint(mx)); }
}
__device__ __forceinline__ void q64_unpack(const u32x4 w, const float sc, f32x4& a0, f32x4& a1, f32x4& b0, f32x4& b1) { const float off = -128.f * sc; a0 = dqb8x4(w.x, sc, off); a1 = dqb8x4(w.y, sc, off); b0 = dqb8x4(w.z, sc, off); b1 = dqb8x4(w.w, sc, off); }
__device__ __forceinline__ float sigmoidf_(float x) { return __builtin_amdgcn_rcpf(1.0f + __expf(-x)); }
__device__ __forceinline__ float siluf_(float x) { return x * __builtin_amdgcn_rcpf(1.0f + __expf(-x)); }
__device__ __forceinline__ float wave_sum(float v) {
#pragma unroll
    for (int o = 1; o < 64; o <<= 1) v += __shfl_xor(v, o);
    return v;
}
__device__ __forceinline__ void lds_barrier() { asm volatile("s_waitcnt lgkmcnt(0)" ::: "memory"); __builtin_amdgcn_s_barrier(); asm volatile("" ::: "memory"); }
__device__ __forceinline__ int lane_now() { unsigned z; asm volatile("v_mov_b32 %0, 0" : "=v"(z)); return (int)__builtin_amdgcn_mbcnt_hi(~0u, __builtin_amdgcn_mbcnt_lo(~0u, z)); }
__device__ __forceinline__ float fq_sum(float s, int fr, int fq) { const int ln = fq * 16 + fr;
    s += __int_as_float(__builtin_amdgcn_ds_bpermute((ln ^ 16) << 2, __float_as_int(s))); s += __int_as_float(__builtin_amdgcn_ds_bpermute((ln ^ 32) << 2, __float_as_int(s))); return s; }
__device__ __forceinline__ s16x4 tr_read(LAS const char* p) { return __builtin_bit_cast(s16x4, __builtin_amdgcn_ds_read_tr16_b64_v4i16((LAS s16x4*)p)); }

__constant__ float c_inv_freq[32] = {1.000000000e+00f, 7.498942018e-01f, 5.623413324e-01f, 4.216965139e-01f, 3.162277639e-01f, 2.371373773e-01f, 1.778279394e-01f, 1.333521456e-01f, 1.000000015e-01f, 7.498942316e-02f, 5.623413250e-02f, 4.216964915e-02f, 3.162277490e-02f, 2.371373773e-02f, 1.778279431e-02f, 1.333521400e-02f, 9.999999776e-03f, 7.498942316e-03f, 5.623413250e-03f, 4.216964822e-03f, 3.162277630e-03f, 2.371373819e-03f, 1.778279431e-03f, 1.333521446e-03f, 1.000000047e-03f, 7.498941850e-04f, 5.623413017e-04f, 4.216965172e-04f, 3.162277571e-04f, 2.371373703e-04f, 1.778279402e-04f, 1.333521504e-04f};
__device__ __forceinline__ float lg2_gamma(int h) {
    const float t[8] = {-4.580368961312e-02f, -2.272007650008e-02f, -1.131531322783e-02f, -5.646563141142e-03f, -2.820519062379e-03f, -1.409570254671e-03f, -7.046129765894e-04f, -3.522634716290e-04f};
    float r = t[0];
#pragma unroll
    for (int i = 1; i < 8; ++i) r = (h == i) ? t[i] : r;
    return r;
}

namespace pg8 {
constexpr int BM = 256, BK = 64, HALF = 128, HTB = HALF * BK * 2, STAGE_BYTES = 8 * HTB, NXCD = 8, WGM = 8;
__host__ __device__ __forceinline__ int lds_byte(int r, int c) { const int st = (r >> 4) * 2 + (c >> 5), rr = r & 15, cc = c & 31, ob = rr * 64 + cc * 2; return st * 1024 + (ob ^ (((ob >> 9) & 1) << 5)); }
__host__ __device__ __forceinline__ void stage_rc(int b, int& R, int& C) { const int st = b / 1024, sb = b % 1024, swz = sb ^ (((sb >> 9) & 1) << 5); R = (st >> 1) * 16 + swz / 64; C = (st & 1) * 32 + (swz % 64) / 2; }
__host__ __device__ __forceinline__ int perm32(int rho) { const int n = rho >> 4, i = rho & 15; return 8 * (i >> 2) + 4 * n + (i & 3); }

struct Unit { int pm, pn, aux; };

struct StaticOrder {
    static constexpr bool GATHER = false, ATILED = false;
    int nM, nN, nwg, G, c; const char* A; const char* B; size_t tstep;
    __device__ void init(const void* A_, const void* B_, int M, int N, int K, int G_, int c_) { nM = M / BM; nN = N / BM; nwg = nM * nN; G = G_; c = c_; A = (const char*)A_; B = (const char*)B_; tstep = (size_t)BM * K * 2; }
    __device__ bool next(int i, Unit& u) const {
        const long L = (long)i * G + c; if (L >= nwg) return false;
        int wgid = (int)L; { const int q = nwg / NXCD, r = nwg % NXCD, xcd = wgid % NXCD, off = wgid / NXCD; wgid = (xcd < r ? xcd * (q + 1) : r * (q + 1) + (xcd - r) * q) + off; }
        const int nig = WGM * nN, gid = wgid / nig, fm = gid * WGM, gsz = (nM - fm) < WGM ? (nM - fm) : WGM;
        u.pm = fm + ((wgid % nig) % gsz); u.pn = (wgid % nig) / gsz; u.aux = 0; return true;
    }
    __device__ __forceinline__ void ptrs(const Unit& u, const char*& a, const char*& b) const { a = A + (size_t)u.pm * tstep; b = B + (size_t)u.pn * tstep; }
    __device__ __forceinline__ void goff(const Unit&, int, int, int, int, unsigned (&)[2][2]) const {}
};

#define PG8_SA(b, h) (((b) * 2 + (h)) * HTB)
#define PG8_SB(b, h) ((4 + (b) * 2 + (h)) * HTB)
#define PG8_GLDS(base, voff, dstoff) do { unsigned _v = (voff); asm volatile("" : "+v"(_v)); __builtin_amdgcn_global_load_lds((const unsigned*)((base) + _v), (LAS unsigned*)(lds + (dstoff)), 16, 0, 0); } while (0)
#define PG8_STAGE_B(bufoff, gbase, h) do { _Pragma("unroll") for (int _i = 0; _i < 2; ++_i) PG8_GLDS((gbase) + (size_t)(h) * hstepB, voffB[_i], (bufoff) + ldsw + _i * 8192); } while (0)
#define PG8_STAGE_A(bufoff, gbase, h) do { if constexpr (Sched::GATHER) { _Pragma("unroll") for (int _i = 0; _i < 2; ++_i) PG8_GLDS((gbase), vg[h][_i], (bufoff) + ldsw + _i * 8192); } \
        else { _Pragma("unroll") for (int _i = 0; _i < 2; ++_i) PG8_GLDS((gbase) + (size_t)(h) * hstep, voffA[_i], (bufoff) + ldsw + _i * 8192); } } while (0)
#define PG8_LDA(dst, b, h) do { _Pragma("unroll") for (int m = 0; m < 4; ++m) frag_load<Epi::FP8>(dst[m], lds + PG8_SA(b, h) + aoff + m * 2048); } while (0)
#define PG8_LDB(dst, b, h) do { _Pragma("unroll") for (int n = 0; n < 2; ++n) frag_load<Epi::FP8>(dst[n], lds + PG8_SB(b, h) + boff + n * 2048); } while (0)
#define PG8_MMA(ai, bj, At, Bt) do { __builtin_amdgcn_s_setprio(1); _Pragma("unroll") for (int m = 0; m < 4; ++m) _Pragma("unroll") for (int n = 0; n < 2; ++n) \
        acc[ai][bj][m][n] = frag_mma<Epi::FP8, BScale<Epi>::v, IsI8<Epi>::v>(Bt[n], At[m], acc[ai][bj][m][n]); __builtin_amdgcn_s_setprio(0); } while (0)
#define PG8_WAIT_V(n) asm volatile("s_waitcnt vmcnt(" #n ")" ::: "memory")
#define PG8_WAIT_L(n) asm volatile("s_waitcnt lgkmcnt(" #n ")" ::: "memory")
#define PG8_BAR __builtin_amdgcn_s_barrier()
#define PG8_SCHED __builtin_amdgcn_sched_barrier(0)

struct FragBf { bf16x8 p[2]; };
template <bool F8> struct FragT { typedef FragBf type; };
template <> struct FragT<true> { typedef v8i32 type; };
template <bool F8> __device__ __forceinline__ void frag_load(typename FragT<F8>::type& d, const LAS unsigned char* p) {
    if constexpr (F8) d = __builtin_shufflevector(*(const LAS v4i32*)p, *(const LAS v4i32*)(p + 16), 0, 1, 2, 3, 4, 5, 6, 7);
    else { d.p[0] = *(const LAS bf16x8*)p; d.p[1] = *(const LAS bf16x8*)(p + 1024); }
}
template <class E, bool F8 = E::FP8> struct BScale { static constexpr int v = 0x7f7f7f7f; };
template <class E> struct BScale<E, true> { static constexpr int v = E::BSC; };
template <class E, class = void> struct IsI8 { static constexpr bool v = false; };
template <class E> struct IsI8<E, decltype((void)E::I8)> { static constexpr bool v = E::I8; };
template <bool F8, int SB, bool I8> __device__ __forceinline__ f32x4 frag_mma(const typename FragT<F8>::type& b, const typename FragT<F8>::type& a, f32x4 c) {
    if constexpr (I8) { v4i32 ci = __builtin_bit_cast(v4i32, c);
        ci = __builtin_amdgcn_mfma_i32_16x16x64_i8(__builtin_bit_cast(v4i32, b.p[0]), __builtin_bit_cast(v4i32, a.p[0]), ci, 0, 0, 0);
        ci = __builtin_amdgcn_mfma_i32_16x16x64_i8(__builtin_bit_cast(v4i32, b.p[1]), __builtin_bit_cast(v4i32, a.p[1]), ci, 0, 0, 0); return __builtin_bit_cast(f32x4, ci); }
    else if constexpr (F8) return __builtin_amdgcn_mfma_scale_f32_16x16x128_f8f6f4(b, a, c, 0, 0, 0, SB, 0, SB);
    else { c = __builtin_amdgcn_mfma_f32_16x16x32_bf16(b.p[0], a.p[0], c, 0, 0, 0); return __builtin_amdgcn_mfma_f32_16x16x32_bf16(b.p[1], a.p[1], c, 0, 0, 0); }
}
template <class Epi, class Sched>
__device__ __forceinline__ void gemm_phase(LAS unsigned char* lds, const int wid, const int K, const Sched& S, const Epi& E, const int noepi = 0, const int delay = 0) {
    if (delay > 0) { const unsigned long long t0 = __builtin_amdgcn_s_memrealtime(); while (__builtin_amdgcn_s_memrealtime() - t0 < (unsigned long long)delay) __builtin_amdgcn_s_sleep(16); }
    const int lane = lane_now(), tid = wid * 64 + lane, wr = wid >> 2, wc = wid & 3, fr = lane & 15, fq = lane >> 4;
    const int nt = K / BK;
    unsigned voffA[2], voffB[2]; int Rr[2], Cc[2];
#pragma unroll
    for (int i = 0; i < 2; ++i) { int R, C; stage_rc(tid * 16 + i * 8192, R, C); const int Rb = Epi::ADJ ? 64 * (R >> 5) + perm32(R & 31) : (R & ~31) + perm32(R & 31); Rr[i] = R; Cc[i] = C;
        voffA[i] = Sched::ATILED ? (unsigned)((((R >> 4) * 8 + (R & 7)) * 1024) + (C >> 5) * 64 + ((R >> 3) & 1) * 32 + (C & 31)) * 2u : (unsigned)(R * K + C) * 2u; voffB[i] = (unsigned)(Rb * K + C) * 2u; }
    const size_t hstepB = Epi::ADJ ? (size_t)32 * K * 2 : (size_t)HALF * K * 2;
    const size_t kstep = (size_t)(BK * 2);
    const size_t kstepA = Sched::ATILED ? (size_t)256 : (size_t)(BK * 2);
    const size_t hstep = (size_t)HALF * K * 2;
    const unsigned ldsw = (unsigned)wid * 1024u;
    const int aoff = Epi::FP8 ? lds_byte(wr * 64 + fr, (fq & 1) * 16) + (fq >> 1) * 1024 : lds_byte(wr * 64 + fr, fq * 8);
    const int boff = Epi::FP8 ? lds_byte(wc * 32 + fr, (fq & 1) * 16) + (fq >> 1) * 1024 : lds_byte(wc * 32 + fr, fq * 8);
    Unit cur, nxt; int ui = 0;
    if (!S.next(0, cur)) return;
    f32x4 acc[2][2][4][2];
#pragma unroll
    for (int a = 0; a < 2; ++a)
#pragma unroll
        for (int b = 0; b < 2; ++b)
#pragma unroll
            for (int m = 0; m < 4; ++m)
#pragma unroll
                for (int n = 0; n < 2; ++n) acc[a][b][m][n] = (f32x4){0.f, 0.f, 0.f, 0.f};
    typedef typename FragT<Epi::FP8>::type frag_t;
    frag_t At[4], B0[2], B1[2];
    const char *cA, *cB; S.ptrs(cur, cA, cB);
    unsigned vg[2][2] = {{0u, 0u}, {0u, 0u}}, vn[2][2] = {{0u, 0u}, {0u, 0u}};
    if constexpr (Sched::GATHER) S.goff(cur, Rr[0], Rr[1], Cc[0], Cc[1], vg);
    PG8_STAGE_B(PG8_SB(0, 0), cB, 0); PG8_STAGE_B(PG8_SB(0, 1), cB, 1); PG8_STAGE_A(PG8_SA(0, 0), cA, 0); PG8_STAGE_A(PG8_SA(0, 1), cA, 1);
    if (wr == 1) PG8_BAR;
    PG8_WAIT_V(2); PG8_BAR;
    PG8_STAGE_B(PG8_SB(1, 0), cB + kstep, 0); PG8_STAGE_A(PG8_SA(1, 0), cA + kstepA, 0); PG8_STAGE_B(PG8_SB(1, 1), cB + kstep, 1);
    PG8_WAIT_V(6); PG8_BAR;
    for (;;) {
        const bool has_next = S.next(ui + 1, nxt);
        const char *nA = cA, *nB = cB; if (has_next) S.ptrs(nxt, nA, nB);
        if constexpr (Sched::GATHER) {
#pragma unroll
            for (int h = 0; h < 2; ++h)
#pragma unroll
                for (int i = 0; i < 2; ++i) vn[h][i] = vg[h][i];
            if (has_next) S.goff(nxt, Rr[0], Rr[1], Cc[0], Cc[1], vn);
        }
#pragma nounroll
        for (int t = 0; t < nt; t += 2) {
            const bool last = (t == nt - 2);
            const char* a1 = cA + (size_t)(t + 1) * kstepA;
            const char* a2 = last ? nA : cA + (size_t)(t + 2) * kstepA; const char* b2 = last ? nB : cB + (size_t)(t + 2) * kstep;
            const char* a3 = a2 + kstepA; const char* b3 = b2 + kstep;
            PG8_LDB(B0, 0, 0); PG8_LDB(B1, 0, 1); PG8_SCHED; PG8_LDA(At, 0, 0); PG8_STAGE_A(PG8_SA(1, 1), a1, 1);
            if constexpr (Sched::GATHER) { if (last) {
#pragma unroll
                for (int h = 0; h < 2; ++h)
#pragma unroll
                    for (int i = 0; i < 2; ++i) vg[h][i] = vn[h][i]; } }
            PG8_WAIT_V(8); PG8_WAIT_L(0); PG8_BAR; PG8_MMA(0, 0, At, B0); PG8_MMA(0, 1, At, B1); PG8_BAR; PG8_SCHED;
            PG8_LDA(At, 0, 1); PG8_STAGE_B(PG8_SB(0, 0), b2, 0); PG8_STAGE_B(PG8_SB(0, 1), b2, 1); PG8_STAGE_A(PG8_SA(0, 0), a2, 0);
            PG8_WAIT_V(8); PG8_WAIT_L(0); PG8_BAR; PG8_MMA(1, 0, At, B0); PG8_MMA(1, 1, At, B1); PG8_BAR; PG8_SCHED;
            PG8_LDB(B0, 1, 0); PG8_LDB(B1, 1, 1); PG8_SCHED; PG8_LDA(At, 1, 0); PG8_STAGE_A(PG8_SA(0, 1), a2, 1);
            PG8_WAIT_V(8); PG8_WAIT_L(0); PG8_BAR; PG8_MMA(0, 0, At, B0); PG8_MMA(0, 1, At, B1); PG8_BAR; PG8_SCHED;
            PG8_LDA(At, 1, 1); PG8_STAGE_B(PG8_SB(1, 0), b3, 0); PG8_STAGE_B(PG8_SB(1, 1), b3, 1); PG8_STAGE_A(PG8_SA(1, 0), a3, 0);
            PG8_WAIT_V(8); PG8_WAIT_L(0); PG8_BAR; PG8_MMA(1, 0, At, B0); PG8_MMA(1, 1, At, B1); PG8_BAR; PG8_SCHED;
        }
        if (wr == 0) PG8_BAR;
        { Unit ue = cur; asm volatile("" : "+v"(ue.pm), "+v"(ue.pn), "+v"(ue.aux)); ue.pm = __builtin_amdgcn_readfirstlane(ue.pm); ue.pn = __builtin_amdgcn_readfirstlane(ue.pn); ue.aux = __builtin_amdgcn_readfirstlane(ue.aux);
          const int lane_e = lane_now();
          const int fr_e = lane_e & 15, fq_e = lane_e >> 4;
          if constexpr (IsI8<Epi>::v) { E.dequant(acc, ue, wr, wc, fr_e, fq_e); asm volatile("" ::: "memory"); __builtin_amdgcn_sched_barrier(0); }
          if (noepi != 1) E(acc, ue, wr, wc, fr_e, fq_e); }
        if (!has_next) break;
#pragma unroll
        for (int a = 0; a < 2; ++a)
#pragma unroll
            for (int b = 0; b < 2; ++b)
#pragma unroll
                for (int m = 0; m < 4; ++m)
#pragma unroll
                    for (int n = 0; n < 2; ++n) acc[a][b][m][n] = (f32x4){0.f, 0.f, 0.f, 0.f};
        cur = nxt; cA = nA; cB = nB; ++ui;
        if (wr == 1) PG8_BAR;
    }
    PG8_WAIT_V(0);
    PG8_BAR;
}
}
using pg8::Unit;
typedef f32x4 Acc[2][2][4][2];

#define XB_TMO      128
#define XB_XCNT(j)  (256  + 64 * (j))
#define XB_XSUB(j)  (1280 + 64 * (j))
#define XB_XGEN(j)  (2304 + 64 * (j))
#define XB_TOP      3328
#define XB_TOPGEN   3392
#define XCD_BAR_WORDS 3456
#define XB_SPIN_CAP (1u << 18)
__device__ __forceinline__ unsigned xb_ld(unsigned* p)              { return __hip_atomic_load(p, __ATOMIC_RELAXED, __HIP_MEMORY_SCOPE_AGENT); }
__device__ __forceinline__ unsigned xb_add(unsigned* p, unsigned v) { return __hip_atomic_fetch_add(p, v, __ATOMIC_RELAXED, __HIP_MEMORY_SCOPE_AGENT); }
__device__ __forceinline__ unsigned xb_xcc_id() { return (unsigned)__builtin_amdgcn_s_getreg((3 << 11) | 20) & 0xFu; }
#define XB_SPIN(cond, bar) do { unsigned _sp = 0; while (cond) { __builtin_amdgcn_s_sleep(1); \
    if ((++_sp & 255u) == 0u) { if (xb_ld(&(bar)[XB_TMO])) break; if (_sp > XB_SPIN_CAP) { atomicAdd(&(bar)[XB_TMO], 1u); break; } } } } while (0)
struct XcdBarrier { unsigned* bar; unsigned x; volatile LAS unsigned* st; };
__device__ __forceinline__ XcdBarrier xcd_barrier_post(unsigned* bar, volatile LAS unsigned* st, const int wave) {
    XcdBarrier b; b.bar = bar; b.x = xb_xcc_id(); b.st = st;
    if (wave == 0 && lane_now() == 0) (void)xb_add(&bar[XB_XCNT(b.x)], 1u);
    return b;
}
__device__ __forceinline__ void xcd_barrier_complete(unsigned* bar, unsigned x, unsigned& nloc, unsigned& nx) {
    const unsigned G = gridDim.x * gridDim.y * gridDim.z;
    unsigned sum, cnt, mine, sp = 0u;
    for (;;) {
        sum = 0u; cnt = 0u; mine = 0u;
#pragma unroll
        for (unsigned j = 0; j < 16; ++j) { const unsigned c = xb_ld(&bar[XB_XCNT(j)]); sum += c; cnt += (c > 0u) ? 1u : 0u; mine = (j == x) ? c : mine; }
        if (sum == G) break;
        __builtin_amdgcn_s_sleep(1);
        if ((++sp & 255u) == 0u) { if (xb_ld(&bar[XB_TMO])) break; if (sp > XB_SPIN_CAP) { atomicAdd(&bar[XB_TMO], 1u); break; } }
    }
    nloc = mine > 0u ? mine : 1u; nx = cnt > 0u ? cnt : 1u;
}
__device__ __forceinline__ void xcd_barrier(const XcdBarrier& b, const int wave) {
    asm volatile("s_waitcnt vmcnt(0)" ::: "memory");
    __syncthreads();
    if (wave == 0 && lane_now() == 0) {
        unsigned* bar = b.bar;
        __builtin_amdgcn_s_waitcnt(0);
        unsigned nloc = b.st[0], nx = b.st[1];
        if (nloc == 0u) { xcd_barrier_complete(bar, b.x, nloc, nx); b.st[0] = nloc; b.st[1] = nx; }
        const unsigned old = xb_add(&bar[XB_XSUB(b.x)], 1u);
        const unsigned gen = old / nloc;
        if (old + 1u == (gen + 1u) * nloc) {
            __builtin_amdgcn_fence(__ATOMIC_RELEASE, "agent");
            asm volatile("s_waitcnt vmcnt(0)" ::: "memory");
            const unsigned og = xb_add(&bar[XB_TOP], 1u);
            const unsigned tg = og / nx;
            if (og + 1u == (tg + 1u) * nx) xb_add(&bar[XB_TOPGEN], 1u);
            else XB_SPIN(xb_ld(&bar[XB_TOPGEN]) == tg, bar);
            __builtin_amdgcn_fence(__ATOMIC_ACQUIRE, "agent");
            xb_add(&bar[XB_XGEN(b.x)], 1u);
            asm volatile("s_waitcnt vmcnt(0)" ::: "memory");
        } else {
            XB_SPIN(xb_ld(&bar[XB_XGEN(b.x)]) == gen, bar);
            __builtin_amdgcn_fence(__ATOMIC_ACQUIRE, "agent");
            asm volatile("s_waitcnt vmcnt(0)" ::: "memory");
        }
    }
    __syncthreads();
}

struct Args { const float* in[22]; float* out; unsigned char* ws; int ph_lo, ph_hi, li, noepi; };
struct Frame {
    LAS unsigned char* lds;
    int wave, vcu, G;
    __device__ __forceinline__ int tid() const { return wave * 64 + lane_now(); }
    __device__ __forceinline__ int lane() const { return lane_now(); }
    const float* in[22]; unsigned char* ws; unsigned char* out;
};
enum { I_X = 0, I_P, I_GMIX, I_WIN, I_CONVW, I_GRET, I_WOC, I_WOR, I_WO, I_GMOE, I_WRG, I_BRG, I_WRE, I_BRE, I_WG, I_WU, I_WD, I_GPIN, I_WPG, I_WPP, I_GPOST, I_GFIN };

__device__ __forceinline__ void p0_transpose_item(const float* W, int ldw, const float* g, bf16* WT, int ldt, int k0, int n0, int drow, LAS float* scr, int lane, const float f8scale = 0.f, const float* cmax = nullptr, float* sbw = nullptr) {
    f32x4 v[8]; float gs[8];
    const int c4 = lane & 7, kr = lane >> 3;
#pragma unroll
    for (int i = 0; i < 8; ++i) { const int kk = kr + 8 * i; v[i] = *(const GAS f32x4*)(W + (size_t)(k0 + kk) * ldw + n0 + 4 * c4); gs[i] = g ? g[k0 + kk] : 1.0f; }
#pragma unroll
    for (int i = 0; i < 8; ++i) { const int kk = kr + 8 * i; LAS float* d = scr + kk * 33 + 4 * c4; d[0] = v[i][0] * gs[i]; d[1] = v[i][1] * gs[i]; d[2] = v[i][2] * gs[i]; d[3] = v[i][3] * gs[i]; }
    asm volatile("s_waitcnt lgkmcnt(0)" ::: "memory");
    const int c = lane & 7;
#pragma unroll
    for (int j = 0; j < 4; ++j) { const int n = (lane >> 3) + 8 * j; const LAS float* s = scr + (8 * c) * 33 + n;
        if (cmax) { const float cm = fmaxf(cmax[n0 + n], 1e-30f), q = 127.0f / cm; unsigned lo = 0u, hi = 0u;
#pragma unroll
            for (int e = 0; e < 4; ++e) { lo |= ((unsigned)(int)__builtin_rintf(s[e * 33] * q) & 0xffu) << (8 * e); hi |= ((unsigned)(int)__builtin_rintf(s[(4 + e) * 33] * q) & 0xffu) << (8 * e); }
            *(GAS u32x2*)((unsigned char*)WT + (size_t)(drow + n) * ldt + k0 + 8 * c) = (u32x2){lo, hi};
            if (k0 == 0 && c == 0) sbw[drow + n] = cm * (1.0f / 127.0f);
        } else if (f8scale != 0.f) { const float q = f8scale;
            const u32x2 o8 = pack8_fp8((f32x4){s[0 * 33] * q, s[1 * 33] * q, s[2 * 33] * q, s[3 * 33] * q}, (f32x4){s[4 * 33] * q, s[5 * 33] * q, s[6 * 33] * q, s[7 * 33] * q});
            *(GAS u32x2*)((unsigned char*)WT + (size_t)(drow + n) * ldt + k0 + 8 * c) = o8;
        } else {
        u32x4 o; o.x = cvt_pk_bf16(s[0 * 33], s[1 * 33]); o.y = cvt_pk_bf16(s[2 * 33], s[3 * 33]); o.z = cvt_pk_bf16(s[4 * 33], s[5 * 33]); o.w = cvt_pk_bf16(s[6 * 33], s[7 * 33]);
        *(GAS u32x4*)(WT + (size_t)(drow + n) * ldt + k0 + 8 * c) = o; } }
    asm volatile("s_waitcnt lgkmcnt(0)" ::: "memory");
}
__device__ __forceinline__ int win_drow(int n0) {
    if (n0 < 1024) return 256 * (n0 >> 7) + 64 * ((n0 & 127) >> 5) + (n0 & 31);
    if (n0 < 2048) { const int c = n0 - 1024; return 256 * (c >> 7) + 64 * ((c & 127) >> 5) + 32 + (c & 31); }
    if (n0 >= 4096 && n0 < 5120) return n0 + 1024;
    if (n0 >= 5120 && n0 < 6144) return n0 - 1024;
    return n0;
}
__device__ __forceinline__ void sincos_acc(float angf, float& s, float& c) {
    const double a = (double)angf;
    const double kq = __builtin_rint(a * 0.63661977236758134308);
    double r = __builtin_fma(-kq, 1.5707963267948966, a); r = __builtin_fma(-kq, 6.123233995736766e-17, r);
    const double r2 = r * r;
    const double sp = r * (1.0 + r2 * (-1.0 / 6 + r2 * (1.0 / 120 + r2 * (-1.0 / 5040 + r2 * (1.0 / 362880 + r2 * (-1.0 / 39916800 + r2 * (1.0 / 6227020800.0)))))));
    const double cp = 1.0 + r2 * (-0.5 + r2 * (1.0 / 24 + r2 * (-1.0 / 720 + r2 * (1.0 / 40320 + r2 * (-1.0 / 3628800 + r2 * (1.0 / 479001600.0 + r2 * (-1.0 / 87178291200.0)))))));
    const int q = ((int)(long long)kq) & 3;
    const double ss = (q == 0) ? sp : (q == 1) ? cp : (q == 2) ? -sp : -cp;
    const double cc = (q == 0) ? cp : (q == 1) ? -sp : (q == 2) ? -cp : sp;
    s = (float)ss; c = (float)cc;
}
__device__ __forceinline__ void p0_quant_win(Frame& F) {
    LAS float* scr = (LAS float*)(F.lds + F.wave * 16384);
    const int gw = F.vcu * NWAVES + F.wave, NGW = F.G * NWAVES, lane = F.lane();
    unsigned char* ws = F.ws;
    for (int it = gw; it < 4096; it += NGW) { const int kb = it >> 8, nb = it & 255;
        p0_transpose_item(F.in[I_WIN], NIN, F.in[I_GMIX], (bf16*)(ws + W_IN), D, 64 * kb, 32 * nb, win_drow(32 * nb), scr, lane, 0.f, (const float*)(ws + WS_CMAX), (float*)(ws + WS_SB)); }
    for (int it = gw; it < 512; it += NGW)
        p0_transpose_item(F.in[I_WPG], D, F.in[I_GPIN], (bf16*)(ws + W_PG), D, 64 * (it >> 5), 32 * (it & 31), 32 * (it & 31), scr, lane, 0.f, (const float*)(ws + WS_CMAX) + NIN, (float*)(ws + WS_SB) + NIN);
    for (int it = gw; it < 512; it += NGW)
        p0_transpose_item(F.in[I_WO], D, nullptr, (bf16*)(ws + W_O), D, 64 * (it >> 5), 32 * (it & 31), 32 * (it & 31), scr, lane, 0.f, (const float*)(ws + WS_CMAX) + NIN + D, (float*)(ws + WS_SB) + NIN + D);
}
__device__ __forceinline__ void p0_prologue(Frame& F) {
    LAS float* scr = (LAS float*)(F.lds + F.wave * 16384);
    const int gw = F.vcu * NWAVES + F.wave, NGW = F.G * NWAVES, lane = F.lane();
    unsigned char* ws = F.ws;
    { const int c4 = lane & 7, kr = lane >> 3;
      const float* const Wi = F.in[I_WIN]; const float* const Wp = F.in[I_WPG]; const float* const Wo = F.in[I_WO]; const float* const gmx = F.in[I_GMIX]; const float* const gpi = F.in[I_GPIN];
      for (int it = gw; it < 4096 + 1024; it += NGW) { const bool pg = it >= 4096, wo = it >= 4608; const int q = wo ? it - 4608 : pg ? it - 4096 : it, kb = pg ? q >> 5 : q >> 8, nb = pg ? q & 31 : q & 255, ldw = pg ? D : NIN;
          const float* W = wo ? Wo : pg ? Wp : Wi; const float* g = wo ? nullptr : pg ? gpi : gmx; unsigned* cmax = (unsigned*)(ws + WS_CMAX) + (wo ? NIN + D : pg ? NIN : 0);
          f32x4 v[8]; float gs[8];
#pragma unroll
          for (int i = 0; i < 8; ++i) { const int kk = 64 * kb + kr + 8 * i; v[i] = *(const GAS f32x4*)(W + (size_t)kk * ldw + 32 * nb + 4 * c4); gs[i] = g ? g[kk] : 1.0f; }
          f32x4 mx = {0.f, 0.f, 0.f, 0.f};
#pragma unroll
          for (int i = 0; i < 8; ++i)
#pragma unroll
              for (int j = 0; j < 4; ++j) mx[j] = fmaxf(mx[j], fabsf(v[i][j] * gs[i]));
#pragma unroll
          for (int o = 8; o < 64; o <<= 1)
#pragma unroll
              for (int j = 0; j < 4; ++j) mx[j] = fmaxf(mx[j], __shfl_xor(mx[j], o));
          if (kr == 0) {
#pragma unroll
              for (int j = 0; j < 4; ++j) atomicMax(&cmax[32 * nb + 4 * c4 + j], __float_as_uint(mx[j])); } } }
    constexpr int I0 = 0, I1 = 512, I5 = 128, I6 = 8192;
    constexpr int NITEMS = I0 + 4 * I1 + I5 + 3 * I6;
    for (int it = gw; it < NITEMS; it += NGW) {
        int r = it;
        if (r < I1) { p0_transpose_item(F.in[I_WOC], D, nullptr, (bf16*)(ws + W_OC), D, 64 * (r >> 5), 32 * (r & 31), 32 * (r & 31), scr, lane); continue; } r -= I1;
        if (r < I1) { p0_transpose_item(F.in[I_WOR], D, nullptr, (bf16*)(ws + W_OR), D, 64 * (r >> 5), 32 * (r & 31), 32 * (r & 31), scr, lane, 64.f); continue; } r -= I1;
        if (r < I1) { continue; } r -= I1;
        if (r < I1) { continue; } r -= I1;
        if (r < I5) { p0_transpose_item(F.in[I_WPP], D, nullptr, (bf16*)(ws + W_PP), PLE, 64 * (r >> 5), 32 * (r & 31), 32 * (r & 31), scr, lane); continue; } r -= I5;
        if (r < I6) { const int e = r >> 8, q = r & 255, kb = q >> 4, nb = q & 15, n0 = 32 * nb;
            p0_transpose_item(F.in[I_WG] + (size_t)e * D * DE, DE, F.in[I_GMOE], (bf16*)(ws + W_GU + (size_t)e * 1024 * 1024), D, 64 * kb, n0, 256 * (n0 >> 7) + (n0 & 127), scr, lane, 32.f); continue; } r -= I6;
        if (r < I6) { const int e = r >> 8, q = r & 255, kb = q >> 4, nb = q & 15, n0 = 32 * nb;
            p0_transpose_item(F.in[I_WU] + (size_t)e * D * DE, DE, F.in[I_GMOE], (bf16*)(ws + W_GU + (size_t)e * 1024 * 1024), D, 64 * kb, n0, 256 * (n0 >> 7) + 128 + (n0 & 127), scr, lane, 32.f); continue; } r -= I6;
        { const int e = r >> 8, q = r & 255, kb = q >> 5, nb = q & 31;
            p0_transpose_item(F.in[I_WD] + (size_t)e * DE * D, D, nullptr, (bf16*)(ws + W_DN + (size_t)e * 1024 * 512), DE, 64 * kb, 32 * nb, 32 * nb, scr, lane, 16.f); }
    }
    const int gt = F.vcu * NTHR + F.tid(), NGT = F.G * NTHR;
    for (int it = gt; it < 256 * 128; it += NGT) {
        const int row = it >> 7, k0 = (it & 127) * 8;
        const bool isre = row < 32, isrg = (row >= 128 && row < 132), valid = isre || isrg;
        const float* src = isre ? F.in[I_WRE] + row : F.in[I_WRG] + (isrg ? row - 128 : 0); const int st = isre ? NE : 4;
        float wv[8];
#pragma unroll
        for (int j = 0; j < 8; ++j) wv[j] = src[(size_t)(k0 + j) * st];
        const f32x4 g0 = *(const GAS f32x4*)(F.in[I_GMOE] + k0), g1 = *(const GAS f32x4*)(F.in[I_GMOE] + k0 + 4);
        const float m = valid ? 1.f : 0.f;
        u32x4 o; o.x = cvt_pk_bf16(wv[0] * g0[0] * m, wv[1] * g0[1] * m); o.y = cvt_pk_bf16(wv[2] * g0[2] * m, wv[3] * g0[3] * m);
        o.z = cvt_pk_bf16(wv[4] * g1[0] * m, wv[5] * g1[1] * m); o.w = cvt_pk_bf16(wv[6] * g1[2] * m, wv[7] * g1[3] * m);
        *(GAS u32x4*)((bf16*)(ws + W_R) + (size_t)row * D + k0) = o;
    }
    for (int it = gt; it < SEQ * 32; it += NGT) {
        const int pos = it >> 5, i = it & 31; float s, c; sincos_acc(__fmul_rn((float)pos, c_inv_freq[i]), s, c);
        ((GAS f32x2*)(ws + WS_ROPE))[it] = (f32x2){c, s};
    }
    { const float* p = F.in[I_P]; bf16* pb = (bf16*)(ws + WS_PB); constexpr size_t NIT = (size_t)T * PLE / 8;
      for (size_t it0 = gt; it0 < NIT; it0 += (size_t)NGT * 4) { f32x4 a[4], b[4];
#pragma unroll
          for (int q = 0; q < 4; ++q) { const size_t it = it0 + (size_t)q * NGT; if (it < NIT) { a[q] = ((const GAS f32x4*)p)[2 * it]; b[q] = ((const GAS f32x4*)p)[2 * it + 1]; } }
#pragma unroll
          for (int q = 0; q < 4; ++q) { const size_t it = it0 + (size_t)q * NGT; if (it < NIT) ((GAS u32x4*)pb)[it] = pack8(a[q], b[q]); } } }
    { const float* x = F.in[I_X]; bf16* xh = (bf16*)(ws + WS_A);
      for (int m0 = gw; m0 < T; m0 += NGW * 4) {
          f32x4 v[4][4]; float ss[4], mxa[4];
#pragma unroll
          for (int q = 0; q < 4; ++q) { const int m = m0 + q * NGW; const GAS f32x4* xr = (const GAS f32x4*)(x + (size_t)(m < T ? m : m0) * D) + lane;
#pragma unroll
              for (int j = 0; j < 4; ++j) v[q][j] = xr[64 * j]; }
#pragma unroll
          for (int q = 0; q < 4; ++q) { float s = 0.f, mx = 0.f;
#pragma unroll
              for (int j = 0; j < 4; ++j) { s += (v[q][j].x * v[q][j].x + v[q][j].y * v[q][j].y) + (v[q][j].z * v[q][j].z + v[q][j].w * v[q][j].w);
                  mx = fmaxf(fmaxf(mx, fmaxf(fabsf(v[q][j].x), fabsf(v[q][j].y))), fmaxf(fabsf(v[q][j].z), fabsf(v[q][j].w))); }
              ss[q] = s; mxa[q] = mx; }
#pragma unroll
          for (int q = 0; q < 4; ++q) { const int m = m0 + q * NGW; const float rms = sqrtf(wave_sum(ss[q]) * (1.f / D) + EPS), rstd = 1.0f / rms;
              float mx = mxa[q];
#pragma unroll
              for (int o = 1; o < 64; o <<= 1) mx = fmaxf(mx, __shfl_xor(mx, o));
              mx = fmaxf(mx, 1e-30f); const float qs = 127.0f / mx;
              if (m < T) { if (lane == 0) { ((float*)(ws + WS_RSTD2))[m] = rms;
                                            ((float*)(ws + WS_SSQ3))[m] = mx * rstd * (1.0f / 127.0f); }
 GAS u32x2* o8 = (GAS u32x2*)(xh + (size_t)m * D) + lane; GAS unsigned* o4 = (GAS unsigned*)(ws + WS_S + (size_t)m * D) + lane;
#pragma unroll
                  for (int j = 0; j < 4; ++j) { u32x2 o; o.x = cvt_pk_bf16(v[q][j].x * rstd, v[q][j].y * rstd); o.y = cvt_pk_bf16(v[q][j].z * rstd, v[q][j].w * rstd); o8[64 * j] = o;
                      const unsigned w8 = ((unsigned)(int)__builtin_rintf(v[q][j].x * qs) & 0xffu) | (((unsigned)(int)__builtin_rintf(v[q][j].y * qs) & 0xffu) << 8) | (((unsigned)(int)__builtin_rintf(v[q][j].z * qs) & 0xffu) << 16) | ((unsigned)(int)__builtin_rintf(v[q][j].w * qs) << 24);
                      o4[64 * j] = w8; } } }
      } }
}

__device__ __forceinline__ unsigned cu_off(int t, int ch) {
    return (unsigned)((((t >> 4) * 8 + (t & 7)) * 32 + (ch >> 5)) * 64 + ((t >> 3) & 1) * 32 + (ch & 31));
}
__device__ __forceinline__ void dequant_i8_r(Acc& acc, const float (&ra)[2][4], const float* sbp);
__device__ __forceinline__ void dequant_i8(Acc& acc, const float* sa, const float* sbp, int row0) {
    float ra[2][4];
#pragma unroll
    for (int ai = 0; ai < 2; ++ai)
#pragma unroll
        for (int m = 0; m < 4; ++m) ra[ai][m] = sa[(unsigned)(row0 + ai * 128 + m * 16)];
    dequant_i8_r(acc, ra, sbp);
}
__device__ __forceinline__ void dequant_i8_r(Acc& acc, const float (&ra)[2][4], const float* sbp) {
    f32x4 cb[2][2];
#pragma unroll
    for (int bj = 0; bj < 2; ++bj)
#pragma unroll
        for (int n = 0; n < 2; ++n) cb[bj][n] = *(const GAS f32x4*)(sbp + 32 * bj + 4 * n);
#pragma unroll
    for (int ai = 0; ai < 2; ++ai)
#pragma unroll
        for (int bj = 0; bj < 2; ++bj)
#pragma unroll
            for (int m = 0; m < 4; ++m)
#pragma unroll
                for (int n = 0; n < 2; ++n) { const v4i32 ci = __builtin_bit_cast(v4i32, acc[ai][bj][m][n]);
                    acc[ai][bj][m][n] = (f32x4){(float)ci[0], (float)ci[1], (float)ci[2], (float)ci[3]} * cb[bj][n] * ra[ai][m]; }
}
struct EpiG1 {
    static constexpr bool ADJ = true; static constexpr bool FP8 = false; static constexpr bool I8 = true;
    const float* sa; const float* sb;
    __device__ __forceinline__ void dequant(Acc& acc, const Unit& u, int wr, int wc, int fr, int fq) const { dequant_i8(acc, sa, sb + (u.pn + pn0) * 256 + wc * 64 + 8 * fq, u.pm * 256 + wr * 64 + fr); }
    bf16 *cu, *ypre, *q, *k, *v, *sg, *mc, *mr; const f32x2* rope; const LAS float* cw; int pn0;
    template <int ACT, int STRIDE = D> __device__ __forceinline__ void plain(const Acc& acc, bf16* dst, unsigned off0, int fr, int fq) const {
#pragma unroll
        for (int ai = 0; ai < 2; ++ai)
#pragma unroll
            for (int m = 0; m < 4; ++m) { u32x4 o[2];
#pragma unroll
                for (int bj = 0; bj < 2; ++bj) { f32x4 v0 = acc[ai][bj][m][0], v1 = acc[ai][bj][m][1];
                    if (ACT == 1) {
#pragma unroll
                        for (int j = 0; j < 4; ++j) { v0[j] = siluf_(v0[j]); v1[j] = siluf_(v1[j]); } }
                    if (ACT == 2) {
#pragma unroll
                        for (int j = 0; j < 4; ++j) { v0[j] = sigmoidf_(v0[j]); v1[j] = sigmoidf_(v1[j]); } }
                    o[bj] = pack8(v0, v1); }
                st_lines(dst, off0 + (unsigned)(ai * 128 + m * 16) * STRIDE, o[0], o[1], fr, fq); }
    }
    __device__ __forceinline__ void operator()(const Acc& acc, const Unit& u, int wr, int wc, int fr, int fq) const {
        const int row0 = u.pm * 256 + wr * 64 + fr, pn = u.pn + pn0;
        if (pn < 8) {
#pragma unroll
            for (int ai = 0; ai < 2; ++ai)
#pragma unroll
                for (int m = 0; m < 4; ++m) { const size_t rowo = (size_t)(((u.pm * 16 + ai * 8 + wr * 4 + m) * 8 + (fr & 7)) * 32 + pn * 4 + wc) * 64 + (fr >> 3) * 32 + 8 * fq;
                    st16_wt(cu, rowo, pack8(acc[ai][0][m][0] * acc[ai][1][m][0], acc[ai][0][m][1] * acc[ai][1][m][1])); }
        } else if (pn < 12) {
            const int chw = (pn - 8) * 256 + wc * 64 + 8 * fq;
            u32x4 cv[2][2][3];
#define G1_CLOAD(slot, q) do { int r_ = row0 + ((q) >> 2) * 128 + ((q) & 3) * 16; asm volatile("" : "+v"(r_)); const int pos_ = r_ & (SEQ - 1);     \
                _Pragma("unroll") for (int bj = 0; bj < 2; ++bj) _Pragma("unroll") for (int d = 0; d < 3; ++d) \
                    cv[slot][bj][d] = *(const GAS u32x4*)(cu + cu_off(pos_ >= d ? r_ - d : r_, chw + 32 * bj)); } while (0)
            G1_CLOAD(0, 0);
#pragma unroll
            for (int q = 0; q < 8; ++q) {
                if (q + 1 < 8) { if ((q & 1) == 0) G1_CLOAD(1, q + 1); else G1_CLOAD(0, q + 1); }
                const int ai = q >> 2, m = q & 3, sl = q & 1, r = row0 + ai * 128 + m * 16, pos = r & (SEQ - 1);
                const float k1 = pos >= 1 ? 1.f : 0.f, k2 = pos >= 2 ? 1.f : 0.f;
                u32x4 res[2];
#pragma unroll
                for (int bj = 0; bj < 2; ++bj) { const LAS f32x4* wp = (const LAS f32x4*)(cw + chw + 32 * bj);
                    f32x4 c0a, c0b, c1a, c1b, c2a, c2b; unpack8(cv[sl][bj][0], c0a, c0b); unpack8(cv[sl][bj][1], c1a, c1b); unpack8(cv[sl][bj][2], c2a, c2b);
                    const f32x4 ya = acc[ai][bj][m][0] * (wp[0] * (c2a * k2) + wp[D / 4] * (c1a * k1) + wp[2 * D / 4] * c0a);
                    const f32x4 yb = acc[ai][bj][m][1] * (wp[1] * (c2b * k2) + wp[D / 4 + 1] * (c1b * k1) + wp[2 * D / 4 + 1] * c0b);
                    res[bj] = pack8(ya, yb); }
                st_lines(ypre, (unsigned)r * D + (pn - 8) * 256 + wc * 64, res[0], res[1], fr, fq);
            }
#undef G1_CLOAD
        }
        else if (pn < 16) {
            const bool isk = pn >= 14; const int head = ((pn - 12) & 1) * 4 + wc; bf16* dst = isk ? k : q;
            const float lg = lg2_gamma(head);
#pragma unroll
            for (int ai = 0; ai < 2; ++ai) {
                f32x4 cs[4][4];
#pragma unroll
                for (int m = 0; m < 4; ++m) { const int pos = (row0 + ai * 128 + m * 16) & (SEQ - 1); const GAS f32x4* rp = (const GAS f32x4*)(rope + (size_t)pos * 32 + 8 * fq);
#pragma unroll
                    for (int j = 0; j < 4; ++j) cs[m][j] = rp[j]; }
#pragma unroll
                for (int m = 0; m < 4; ++m) { const int r = row0 + ai * 128 + m * 16, pos = r & (SEQ - 1); const float e = (float)((pos & (CH - 1)) + 1) * lg;
                    const float sc = isk ? 0.125f * exp2f(-e) : exp2f(e);
                    f32x4 o1[2], o2[2];
#pragma unroll
                    for (int n = 0; n < 2; ++n) { const f32x4 cs0 = cs[m][2 * n], cs1 = cs[m][2 * n + 1];
                        const f32x4 a = acc[ai][0][m][n], b = acc[ai][1][m][n];
                        o1[n] = (f32x4){(a[0] * cs0[0] - b[0] * cs0[1]) * sc, (a[1] * cs0[2] - b[1] * cs0[3]) * sc, (a[2] * cs1[0] - b[2] * cs1[1]) * sc, (a[3] * cs1[2] - b[3] * cs1[3]) * sc};
                        o2[n] = (f32x4){(a[0] * cs0[1] + b[0] * cs0[0]) * sc, (a[1] * cs0[3] + b[1] * cs0[2]) * sc, (a[2] * cs1[1] + b[2] * cs1[0]) * sc, (a[3] * cs1[3] + b[3] * cs1[2]) * sc}; }
                    st_lines(dst, (unsigned)r * 512u + head * 64, pack8(o1[0], o1[1]), pack8(o2[0], o2[1]), fr, fq); } }
        } else if (pn < 20) plain<1>(acc, sg, (unsigned)row0 * D + (pn - 16) * 256 + wc * 64, fr, fq);
        else if (pn < 24) plain<0>(acc, v, (unsigned)row0 * D + (pn - 20) * 256 + wc * 64, fr, fq);
        else { unsigned char* g8 = (unsigned char*)(pn < 28 ? mc : mr); const int tile = u.pm * 4 + ((pn - 24) & 3);
#pragma unroll
            for (int ai = 0; ai < 2; ++ai)
#pragma unroll
                for (int m = 0; m < 4; ++m) { u32x4 o; f32x4 t;
#pragma unroll
                    for (int j = 0; j < 4; ++j) t[j] = sigmoidf_(acc[ai][0][m][0][j]); o.x = q8x4(t);
#pragma unroll
                    for (int j = 0; j < 4; ++j) t[j] = sigmoidf_(acc[ai][0][m][1][j]); o.y = q8x4(t);
#pragma unroll
                    for (int j = 0; j < 4; ++j) t[j] = sigmoidf_(acc[ai][1][m][0][j]); o.z = q8x4(t);
#pragma unroll
                    for (int j = 0; j < 4; ++j) t[j] = sigmoidf_(acc[ai][1][m][1][j]); o.w = q8x4(t);
                    *(GAS u32x4*)(g8 + gate8_off(tile, wr * 4 + wc, ai * 4 + m, fq * 16 + fr)) = o; } }
    }
};
constexpr float MIXED_MARGIN = 1.5f;
template <int MODE, bool F8 = false> struct EpiGate {
    static constexpr bool ADJ = true; static constexpr bool FP8 = F8; static constexpr int BSC = 0x7c7c7c7c;
    const bf16* gate; const bf16* prev; bf16* out; int variant; bf16* dead; float* scl; unsigned* rmax;
    __device__ __forceinline__ void operator()(const Acc& acc, const Unit& u, int wr, int wc, int fr, int fq) const {
        const unsigned tbase = (unsigned)(u.pm * 4 + u.pn) * 65536u + (unsigned)(wr * 64 + fr) * 256u + wc * 64, rbase = (unsigned)(u.pm * 256 + wr * 64 + fr) * D + u.pn * 256 + wc * 64;
        if constexpr (MODE == 0) {
            u32x4 gt[2][4];
#pragma unroll
            for (int ai = 0; ai < 2; ++ai)
#pragma unroll
                for (int m = 0; m < 4; ++m) gt[ai][m] = *(const GAS u32x4*)((const unsigned char*)gate + gate8_off(u.pm * 4 + u.pn, wr * 4 + wc, ai * 4 + m, fq * 16 + fr));
#pragma unroll
            for (int ai = 0; ai < 2; ++ai)
#pragma unroll
                for (int m = 0; m < 4; ++m) {
                    q64_store((unsigned char*)out, scl, ((u.pm * 4 + u.pn) * 8 + wr * 4 + wc) * 8 + ai * 4 + m, fr, fq,
                              acc[ai][0][m][0] * dq8x4(gt[ai][m].x), acc[ai][0][m][1] * dq8x4(gt[ai][m].y), acc[ai][1][m][0] * dq8x4(gt[ai][m].z), acc[ai][1][m][1] * dq8x4(gt[ai][m].w), rmax + (u.pm * 256 + ai * 128 + wr * 64 + m * 16 + fr)); }
        } else {
#pragma unroll
        for (int ai = 0; ai < 2; ++ai) {
            u32x4 gt[4], pv[4]; float ps[4], qs[4];
#pragma unroll
            for (int m = 0; m < 4; ++m) { const int blk = ((u.pm * 4 + u.pn) * 8 + wr * 4 + wc) * 8 + ai * 4 + m;
                qs[m] = 127.0f / (MIXED_MARGIN * fmaxf(__uint_as_float(rmax[(unsigned)(u.pm * 256 + ai * 128 + wr * 64 + m * 16 + fr)]), 1e-30f));
                gt[m] = *(const GAS u32x4*)((const unsigned char*)gate + gate8_off(u.pm * 4 + u.pn, wr * 4 + wc, ai * 4 + m, fq * 16 + fr));
                pv[m] = *(const GAS u32x4*)((const unsigned char*)prev + ((size_t)blk * 64 + fq * 16 + fr) * 16); ps[m] = scl[(size_t)blk * 16 + fr]; }
#pragma unroll
            for (int m = 0; m < 4; ++m) { f32x4 p[2][2]; q64_unpack(pv[m], ps[m], p[0][0], p[0][1], p[1][0], p[1][1]);
#pragma unroll
                for (int bj = 0; bj < 2; ++bj) {
                    const f32x4 v0 = (acc[ai][bj][m][0] * dq8x4(bj ? gt[m].z : gt[m].x) + p[bj][0]) * qs[m], v1 = (acc[ai][bj][m][1] * dq8x4(bj ? gt[m].w : gt[m].y) + p[bj][1]) * qs[m];
                    unsigned lo = 0u, hi = 0u;
#pragma unroll
                    for (int e = 0; e < 4; ++e) { lo |= ((unsigned)(int)__builtin_rintf(fminf(fmaxf(v0[e], -127.f), 127.f)) & 0xffu) << (8 * e); hi |= ((unsigned)(int)__builtin_rintf(fminf(fmaxf(v1[e], -127.f), 127.f)) & 0xffu) << (8 * e); }
                    *(GAS u32x2*)((unsigned char*)out + (unsigned)(u.pm * 256 + ai * 128 + wr * 64 + m * 16 + fr) * (unsigned)D + u.pn * 256 + wc * 64 + bj * 32 + 8 * fq) = (u32x2){lo, hi}; } } }
        }
    }
};
struct EpiRes {
    static constexpr bool ADJ = true; static constexpr bool FP8 = false; static constexpr bool I8 = true;
    const float* rms; bf16* xb1; float* ssq; unsigned char* x8; const unsigned* rmax; const float* sb;
    __device__ __forceinline__ void dequant(Acc& acc, const Unit& u, int wr, int wc, int fr, int fq) const {
        float ra[2][4];
#pragma unroll
        for (int ai = 0; ai < 2; ++ai)
#pragma unroll
            for (int m = 0; m < 4; ++m) ra[ai][m] = (MIXED_MARGIN / 127.0f) * fmaxf(__uint_as_float(rmax[(unsigned)(u.pm * 256 + ai * 128 + wr * 64 + m * 16 + fr)]), 1e-30f);
        dequant_i8_r(acc, ra, sb + u.pn * 256 + wc * 64 + 8 * fq);
    }
    __device__ __forceinline__ void operator()(const Acc& acc, const Unit& u, int wr, int wc, int fr, int fq) const {
        const int row0 = u.pm * 256 + wr * 64 + fr; const unsigned cg = u.pn * 256 + wc * 64;
#pragma unroll
        for (int ai = 0; ai < 2; ++ai) {
            u32x4 xv[4][2]; float rm[4];
#pragma unroll
            for (int m = 0; m < 4; ++m) { const unsigned r = (unsigned)(row0 + ai * 128 + m * 16); rm[m] = rms[r];
#pragma unroll
                for (int bj = 0; bj < 2; ++bj) xv[m][bj] = *(const GAS u32x4*)(xb1 + r * (unsigned)D + cg + bj * 32 + 8 * fq); }
#pragma unroll
            for (int m = 0; m < 4; ++m) { const unsigned r = (unsigned)(row0 + ai * 128 + m * 16); float s = 0.f; u32x4 o[2];
#pragma unroll
                for (int bj = 0; bj < 2; ++bj) { f32x4 x0, x1; unpack8(xv[m][bj], x0, x1);
                    const f32x4 v0 = x0 * rm[m] + acc[ai][bj][m][0], v1 = x1 * rm[m] + acc[ai][bj][m][1];
                    o[bj] = pack8(v0, v1);
                    *(GAS u32x2*)(x8 + r * (unsigned)D + cg + bj * 32 + 8 * fq) = pack8_fp8(v0, v1);
                    s += (v0[0] * v0[0] + v0[1] * v0[1]) + (v0[2] * v0[2] + v0[3] * v0[3]) + (v1[0] * v1[0] + v1[1] * v1[1]) + (v1[2] * v1[2] + v1[3] * v1[3]); }
                st_lines(xb1, r * (unsigned)D + cg, o[0], o[1], fr, fq);
                s = fq_sum(s, fr, fq);
                if (fq == 0) ssq[r * 16u + (unsigned)(u.pn * 4 + wc)] = s; } }
    }
};
struct EpiRoute {
    static constexpr bool ADJ = false; static constexpr bool FP8 = false;
    const float* ssq; const float* brg; const float* bre; float* rstd2; u32x4* lists; unsigned* gcnt; LAS int* hs;
    __device__ __forceinline__ void operator()(const Acc& acc, const Unit& u, int wr, int wc, int fr, int fq) const {
        if (wc != 0) return;
        const int row0 = u.pm * 256 + wr * 64 + fr, lane = fq * 16 + fr;
        LAS int* hist = hs + wr * 64; LAS int* bs = hist + 32;
        float be[8], bg4[4];
#pragma unroll
        for (int j = 0; j < 8; ++j) be[j] = bre[8 * fq + j];
#pragma unroll
        for (int j = 0; j < 4; ++j) bg4[j] = brg[j];
        f32x4 pqa[2][4];
#pragma unroll
        for (int ai = 0; ai < 2; ++ai)
#pragma unroll
            for (int m = 0; m < 4; ++m) pqa[ai][m] = *(const GAS f32x4*)(ssq + (size_t)(row0 + ai * 128 + m * 16) * 16 + 4 * fq);
        int ee0[8], ee1[8], rk0[8], rk1[8]; float ww0[8], ww1[8], rsq[8]; bool own[8];
#pragma unroll
        for (int ai = 0; ai < 2; ++ai)
#pragma unroll
            for (int m = 0; m < 4; ++m) { const int q = ai * 4 + m, r = row0 + ai * 128 + m * 16;
                const f32x4 pq = pqa[ai][m]; float s = (pq[0] + pq[1]) + (pq[2] + pq[3]);
                s = fq_sum(s, fr, fq);
                const float rs = 1.0f / sqrtf(s * (1.f / D) + EPS);
                float el[8], gl[4];
#pragma unroll
                for (int j = 0; j < 8; ++j) el[j] = acc[ai][0][m][j >> 2][j & 3] * rs + be[j];
#pragma unroll
                for (int j = 0; j < 4; ++j) gl[j] = __shfl(acc[ai][1][m][0][j] * rs + bg4[j], fr);
                int grp = 0; float best = gl[0];
#pragma unroll
                for (int j = 1; j < 4; ++j) if (gl[j] > best) { best = gl[j]; grp = j; }
                float den = 0.f;
#pragma unroll
                for (int j = 0; j < 4; ++j) den += __expf(gl[j] - best);
                const float gw = 1.0f / den;
                int i1 = 0; float l1 = el[0];
#pragma unroll
                for (int j = 1; j < 8; ++j) if (el[j] > l1) { l1 = el[j]; i1 = j; }
                int i2 = -1; float l2 = -3.0e38f;
#pragma unroll
                for (int j = 0; j < 8; ++j) if (j != i1 && el[j] > l2) { l2 = el[j]; i2 = j; }
                const float w0 = 1.0f / (1.0f + __expf(l2 - l1)), w1 = 1.0f - w0;
                rsq[q] = rs; own[q] = (fq == grp); ee0[q] = grp * 8 + i1; ee1[q] = grp * 8 + i2; ww0[q] = w0 * gw; ww1[q] = w1 * gw; rk0[q] = 0; rk1[q] = 0;
                if (own[q]) { rstd2[r] = rs; rk0[q] = atomicAdd((int*)&hist[ee0[q]], 1); rk1[q] = atomicAdd((int*)&hist[ee1[q]], 1); } }
        asm volatile("s_waitcnt lgkmcnt(0)" ::: "memory");
        if (lane < 32) { const int c = hist[lane]; hist[lane] = 0; bs[lane] = (int)__hip_atomic_fetch_add(gcnt + lane, (unsigned)c, RLX_AGENT); }
        asm volatile("s_waitcnt vmcnt(0) lgkmcnt(0)" ::: "memory");
#pragma unroll
        for (int q = 0; q < 8; ++q) if (own[q]) { const unsigned tok = (unsigned)(row0 + (q >> 2) * 128 + (q & 3) * 16);
            lists[(size_t)ee0[q] * T + bs[ee0[q]] + rk0[q]] = (u32x4){tok * 2u, __float_as_uint(ww0[q]), __float_as_uint(rsq[q]), 0u};
            lists[(size_t)ee1[q] * T + bs[ee1[q]] + rk1[q]] = (u32x4){tok * 2u + 1u, __float_as_uint(ww1[q]), __float_as_uint(rsq[q]), 0u}; }
        asm volatile("s_waitcnt lgkmcnt(0)" ::: "memory");
    }
};
template <bool GATH, bool TILED = false> struct MoeSched {
    static constexpr bool GATHER = GATH, ATILED = TILED;
    const LAS int* tb; const LAS int* cn; const LAS int* te; const u32x4* lists; const char* A; const char* B; size_t bstride; int K, G, c;
    __device__ bool next(int i, Unit& u) const {
        const int U = i * G + c; if (U >= tb[32] * 4) return false;
        const int rt = U >> 2;
        u.pm = rt; u.pn = U & 3; u.aux = te[rt]; return true;
    }
    __device__ __forceinline__ void ptrs(const Unit& u, const char*& a, const char*& b) const {
        a = GATH ? A : A + (size_t)u.pm * 256 * K * 2; b = B + (size_t)u.aux * bstride + (size_t)u.pn * 256 * K * 2; }
    __device__ __forceinline__ void goff(const Unit& u, int R0, int R1, int C0, int C1, unsigned (&vo)[2][2]) const {
        const int e = u.aux, n = cn[e], base = (u.pm - tb[e]) * 256; const u32x4* L = lists + (size_t)e * T;
        const int i00 = base + R0, i01 = base + R1, i10 = base + 128 + R0, i11 = base + 128 + R1;
        const unsigned l00 = L[i00 < n ? i00 : 0].x, l01 = L[i01 < n ? i01 : 0].x, l10 = L[i10 < n ? i10 : 0].x, l11 = L[i11 < n ? i11 : 0].x;
        const unsigned t00 = (i00 < n) ? (l00 >> 1) : 0u, t01 = (i01 < n) ? (l01 >> 1) : 0u, t10 = (i10 < n) ? (l10 >> 1) : 0u, t11 = (i11 < n) ? (l11 >> 1) : 0u;
        vo[0][0] = (t00 * (unsigned)(D / 2) + (unsigned)C0) * 2u; vo[0][1] = (t01 * (unsigned)(D / 2) + (unsigned)C1) * 2u;
        vo[1][0] = (t10 * (unsigned)(D / 2) + (unsigned)C0) * 2u; vo[1][1] = (t11 * (unsigned)(D / 2) + (unsigned)C1) * 2u;
    }
};
struct EpiHid {
    static constexpr bool ADJ = false; static constexpr bool FP8 = true; static constexpr int BSC = 0x7f7f7f7f;
    const LAS int* tb; const LAS int* cn; const u32x4* lists; bf16* hid;
    __device__ __forceinline__ void operator()(const Acc& acc, const Unit& u, int wr, int wc, int fr, int fq) const {
        const int e = u.aux, n = cn[e], base = (u.pm - tb[e]) * 256; const u32x4* L = lists + (size_t)e * T;
        float rsa[2][4];
#pragma unroll
        for (int ai = 0; ai < 2; ++ai)
#pragma unroll
            for (int m = 0; m < 4; ++m) { const int idx = base + ai * 128 + wr * 64 + m * 16 + fr; const float r = __uint_as_float(L[idx < n ? idx : 0].z) * (1.0f / 32.0f); rsa[ai][m] = (idx < n) ? r : 0.f; }
#pragma unroll
        for (int ai = 0; ai < 2; ++ai)
#pragma unroll
            for (int m = 0; m < 4; ++m) { const float rs = rsa[ai][m];
                f32x4 h0, h1;
#pragma unroll
                for (int j = 0; j < 4; ++j) { h0[j] = siluf_(rs * acc[ai][0][m][0][j]) * (rs * acc[ai][1][m][0][j]); h1[j] = siluf_(rs * acc[ai][0][m][1][j]) * (rs * acc[ai][1][m][1][j]); }
                *(GAS u32x2*)((unsigned char*)hid + (size_t)(u.pm * 256 + ai * 128 + wr * 64 + m * 16 + fr) * DE + u.pn * 128 + wc * 32 + 8 * fq) = pack8_fp8(h0, h1); }
    }
};
struct EpiDown {
    static constexpr bool ADJ = true; static constexpr bool FP8 = true; static constexpr int BSC = 0x7f7f7f7f;
    const LAS int* tb; const LAS int* cn; const u32x4* lists; bf16* Y;
    __device__ __forceinline__ void operator()(const Acc& acc, const Unit& u, int wr, int wc, int fr, int fq) const {
        const int e = u.aux, n = cn[e], base = (u.pm - tb[e]) * 256; const u32x4* L = lists + (size_t)e * T;
        u32x4 ent[2][4];
#pragma unroll
        for (int ai = 0; ai < 2; ++ai)
#pragma unroll
            for (int m = 0; m < 4; ++m) { const int idx = base + ai * 128 + wr * 64 + m * 16 + fr; ent[ai][m] = L[idx < n ? idx : 0]; }
#pragma unroll
        for (int ai = 0; ai < 2; ++ai)
#pragma unroll
            for (int m = 0; m < 4; ++m) { const int idx = base + ai * 128 + wr * 64 + m * 16 + fr; const bool ok = idx < n;
                const u32x4 en = ent[ai][m]; const float w = __uint_as_float(en.y);
                unsigned char* dst = (unsigned char*)Y + (size_t)(en.x & 1u) * ((size_t)T * D) + (size_t)(en.x >> 1) * D + u.pn * 256 + wc * 64 + 8 * fq;
                if (ok) { *(GAS u32x2*)dst = pack8_fp8(acc[ai][0][m][0] * w, acc[ai][0][m][1] * w); *(GAS u32x2*)(dst + 32) = pack8_fp8(acc[ai][1][m][0] * w, acc[ai][1][m][1] * w); } }
    }
};
struct EpiPP {
    static constexpr bool ADJ = true; static constexpr bool FP8 = false;
    bf16* pp; float* ssq; const float* gpost; float* pscl;
    __device__ __forceinline__ void operator()(const Acc& acc, const Unit& u, int wr, int wc, int fr, int fq) const {
        const int row0 = u.pm * 256 + wr * 64 + fr; const unsigned cg = u.pn * 256 + wc * 64;
        f32x4 gp[2][2];
#pragma unroll
        for (int bj = 0; bj < 2; ++bj) { const GAS f32x4* g = (const GAS f32x4*)(gpost + cg + bj * 32 + 8 * fq); gp[bj][0] = g[0]; gp[bj][1] = g[1]; }
#pragma unroll
        for (int ai = 0; ai < 2; ++ai)
#pragma unroll
            for (int m = 0; m < 4; ++m) { const int r = row0 + ai * 128 + m * 16; float s = 0.f;
#pragma unroll
                for (int bj = 0; bj < 2; ++bj) { const f32x4 v0 = acc[ai][bj][m][0], v1 = acc[ai][bj][m][1];
                    s += (v0[0] * v0[0] + v0[1] * v0[1]) + (v0[2] * v0[2] + v0[3] * v0[3]) + (v1[0] * v1[0] + v1[1] * v1[1]) + (v1[2] * v1[2] + v1[3] * v1[3]); }
                q64_store((unsigned char*)pp, pscl, ((u.pm * 4 + u.pn) * 8 + wr * 4 + wc) * 8 + ai * 4 + m, fr, fq, acc[ai][0][m][0] * gp[0][0], acc[ai][0][m][1] * gp[0][1], acc[ai][1][m][0] * gp[1][0], acc[ai][1][m][1] * gp[1][1]);
                s = fq_sum(s, fr, fq);
                if (fq == 0) ssq[(size_t)r * 16 + u.pn * 4 + wc] = s; }
    }
};
struct EpiPle {
    static constexpr bool ADJ = true; static constexpr bool FP8 = false; static constexpr bool I8 = true;
    const bf16* x2; const float* rstd3; const bf16* pp; const float* rstdp; bf16* x3; float* ssq3; const float* sa; const float* sb; const float* pscl; float* scl3;
    __device__ __forceinline__ void dequant(Acc& acc, const Unit& u, int wr, int wc, int fr, int fq) const { dequant_i8(acc, sa, sb + u.pn * 256 + wc * 64 + 8 * fq, u.pm * 256 + wr * 64 + fr); }
    __device__ __forceinline__ void operator()(const Acc& acc, const Unit& u, int wr, int wc, int fr, int fq) const {
        const int row0 = u.pm * 256 + wr * 64 + fr; const unsigned cg = u.pn * 256 + wc * 64;
#pragma unroll
        for (int ai = 0; ai < 2; ++ai) {
            float r3[4], rpa[4], psc[4]; u32x4 xv[4][2], pv[4];
#pragma unroll
            for (int m = 0; m < 4; ++m) { const unsigned r = (unsigned)(row0 + ai * 128 + m * 16); const int blk = ((u.pm * 4 + u.pn) * 8 + wr * 4 + wc) * 8 + ai * 4 + m; r3[m] = rstd3[r]; rpa[m] = rstdp[r];
                pv[m] = *(const GAS u32x4*)((const unsigned char*)pp + ((unsigned)blk * 64u + (unsigned)(fq * 16 + fr)) * 16u); psc[m] = pscl[(unsigned)blk * 16u + (unsigned)fr];
#pragma unroll
                for (int bj = 0; bj < 2; ++bj) { const unsigned ro = r * (unsigned)D + cg + bj * 32 + 8 * fq; xv[m][bj] = *(const GAS u32x4*)(x2 + ro); } }
#pragma unroll
            for (int m = 0; m < 4; ++m) { const int r = row0 + ai * 128 + m * 16;
                const float rp = rpa[m], rg = r3[m]; float s = 0.f; f32x4 xo[2][2]; f32x4 pq[2][2]; q64_unpack(pv[m], psc[m], pq[0][0], pq[0][1], pq[1][0], pq[1][1]);
#pragma unroll
                for (int bj = 0; bj < 2; ++bj) { f32x4 v0, v1; const f32x4 p0 = pq[bj][0], p1 = pq[bj][1]; unpack8(xv[m][bj], v0, v1);
#pragma unroll
                    for (int j = 0; j < 4; ++j) { v0[j] += sigmoidf_(rg * acc[ai][bj][m][0][j]) * (p0[j] * rp); v1[j] += sigmoidf_(rg * acc[ai][bj][m][1][j]) * (p1[j] * rp); }
                    xo[bj][0] = v0; xo[bj][1] = v1;
                    s += (v0[0] * v0[0] + v0[1] * v0[1]) + (v0[2] * v0[2] + v0[3] * v0[3]) + (v1[0] * v1[0] + v1[1] * v1[1]) + (v1[2] * v1[2] + v1[3] * v1[3]); }
                q64_store((unsigned char*)x3, scl3, ((u.pm * 4 + u.pn) * 8 + wr * 4 + wc) * 8 + ai * 4 + m, fr, fq, xo[0][0], xo[0][1], xo[1][0], xo[1][1]);
                s = fq_sum(s, fr, fq);
                if (fq == 0) ssq3[(size_t)r * 16 + u.pn * 4 + wc] = s; } }
    }
};

__device__ __forceinline__ void conv_pass(Frame& F, const bf16* cu, const bf16* bg, bf16* ypre) {
    const int gw = F.vcu * NWAVES + F.wave, NGW = F.G * NWAVES, lane = F.lane();
    const float* cw = F.in[I_CONVW];
    for (int un = gw; un < (T / 64) * 2; un += NGW) {
        const int hc = un & 1, t0 = (un >> 1) * 64, ch = hc * 512 + lane * 8;
        f32x4 w0a = *(const GAS f32x4*)(cw + ch), w0b = *(const GAS f32x4*)(cw + ch + 4), w1a = *(const GAS f32x4*)(cw + D + ch), w1b = *(const GAS f32x4*)(cw + D + ch + 4),
              w2a = *(const GAS f32x4*)(cw + 2 * D + ch), w2b = *(const GAS f32x4*)(cw + 2 * D + ch + 4);
        f32x4 p2a = {0.f, 0.f, 0.f, 0.f}, p2b = p2a, p1a = p2a, p1b = p2a;
        if ((t0 & (SEQ - 1)) != 0) { unpack8(*(const GAS u32x4*)(cu + cu_off(t0 - 2, ch)), p2a, p2b); unpack8(*(const GAS u32x4*)(cu + cu_off(t0 - 1, ch)), p1a, p1b); }
        for (int i0 = 0; i0 < 64; i0 += 8) { u32x4 cr[8], br[8];
#pragma unroll
            for (int i = 0; i < 8; ++i) { const size_t ro = (size_t)(t0 + i0 + i) * D + ch; cr[i] = *(const GAS u32x4*)(cu + cu_off(t0 + i0 + i, ch)); br[i] = *(const GAS u32x4*)(bg + ro); }
#pragma unroll
            for (int i = 0; i < 8; ++i) { const size_t ro = (size_t)(t0 + i0 + i) * D + ch; f32x4 ca, cb, ba, bb;
                unpack8(cr[i], ca, cb); unpack8(br[i], ba, bb);
                const f32x4 ya = ba * (w0a * p2a + w1a * p1a + w2a * ca), yb = bb * (w0b * p2b + w1b * p1b + w2b * cb);
                *(GAS u32x4*)(ypre + ro) = pack8(ya, yb);
                p2a = p1a; p2b = p1b; p1a = ca; p1b = cb; } }
    }
}
__device__ __forceinline__ void state_scan(Frame& F, const bf16* kk, const bf16* vv, bf16* S) {
    LAS char* lds = (LAS char*)F.lds;
    constexpr int KST = 144, VST = 80, KBUF = 128 * KST, VBUF = 128 * VST;
    const int tid = F.tid(), lane = F.lane(), w = F.wave, g = lane >> 4, li = lane & 15, q4 = li >> 2, p4 = li & 3, vt = w >> 2, dt = w & 3;
    const int krow0 = tid >> 3, kch = tid & 7, vrow = tid >> 2, vch = tid & 3;
    for (int un = F.vcu; un < 64 * 4; un += F.G) {
        const int bh = un >> 2, vq = un & 3, b = bh >> 3, h = bh & 7;
        const float g128 = exp2f(128.0f * lg2_gamma(h));
        const bf16* kbase = kk + (size_t)b * SEQ * 512 + h * 64 + kch * 8; const bf16* vbase = vv + (size_t)b * SEQ * D + h * 128 + vq * 32 + vch * 8;
        f32x4 Sacc = {0.f, 0.f, 0.f, 0.f};
        u32x4 rk[3][2], rv[3];
#define SS_LOAD(slot, c_) do { const size_t t0_ = (size_t)(c_) * CH; rk[slot][0] = *(const GAS u32x4*)(kbase + (t0_ + krow0) * 512); rk[slot][1] = *(const GAS u32x4*)(kbase + (t0_ + krow0 + 64) * 512); \
        rv[slot] = *(const GAS u32x4*)(vbase + (t0_ + vrow) * D); } while (0)
#define SS_PUT(slot, buf) do { *(LAS u32x4*)(lds + (buf) * KBUF + krow0 * KST + kch * 16) = rk[slot][0]; *(LAS u32x4*)(lds + (buf) * KBUF + (krow0 + 64) * KST + kch * 16) = rk[slot][1]; \
        *(LAS u32x4*)(lds + 2 * KBUF + (buf) * VBUF + vrow * VST + vch * 16) = rv[slot]; } while (0)
#define SS_STEP(slot, c_) do { const int c = (c_); \
        { u32x2 o; o.x = cvt_pk_bf16(Sacc[0], Sacc[1]); o.y = cvt_pk_bf16(Sacc[2], Sacc[3]); \
          *(GAS u32x2*)(S + ((size_t)((bh * NCH + c) * 4 + vq) * 2048 + (size_t)(((16 * dt + li) >> 2) * 2 + vt) * 64 + (li & 3) * 16 + 4 * g)) = o; } \
        if (c + 3 < NCH - 1) SS_LOAD(slot, c + 3);             \
        lds_barrier(); \
        { const int cb = c & 1; const LAS char* kb = lds + cb * KBUF; const LAS char* vb = lds + 2 * KBUF + cb * VBUF; f32x4 a4 = Sacc; \
          _Pragma("unroll") for (int s = 0; s < 4; ++s) { const int r0 = 32 * s + 8 * g + q4; \
            const s16x4 alo = tr_read(vb + r0 * VST + (16 * vt + 4 * p4) * 2), ahi = tr_read(vb + (r0 + 4) * VST + (16 * vt + 4 * p4) * 2); \
            const s16x4 blo = tr_read(kb + r0 * KST + (16 * dt + 4 * p4) * 2), bhi = tr_read(kb + (r0 + 4) * KST + (16 * dt + 4 * p4) * 2); \
            const bf16x8 af = __builtin_shufflevector(alo, ahi, 0, 1, 2, 3, 4, 5, 6, 7), bf = __builtin_shufflevector(blo, bhi, 0, 1, 2, 3, 4, 5, 6, 7); \
            a4 = __builtin_amdgcn_mfma_f32_16x16x32_bf16(af, bf, a4, 0, 0, 0); } \
          Sacc = a4 * g128; } \
        if (c + 1 < NCH - 1) SS_PUT(((slot) + 1) % 3, (c + 1) & 1); } while (0)
        __syncthreads();
        SS_LOAD(0, 0); SS_LOAD(1, 1); SS_LOAD(2, 2);
        SS_PUT(0, 0);
        for (int c3 = 0; c3 < NCH - 1; c3 += 3) { SS_STEP(0, c3); SS_STEP(1, c3 + 1); SS_STEP(2, c3 + 2); }
        { u32x2 o; o.x = cvt_pk_bf16(Sacc[0], Sacc[1]); o.y = cvt_pk_bf16(Sacc[2], Sacc[3]);
          *(GAS u32x2*)(S + ((size_t)((bh * NCH + (NCH - 1)) * 4 + vq) * 2048 + (size_t)(((16 * dt + li) >> 2) * 2 + vt) * 64 + (li & 3) * 16 + 4 * g)) = o; }
#undef SS_LOAD
#undef SS_PUT
#undef SS_STEP
    }
    __syncthreads();
}

__device__ __forceinline__ void ret_out(Frame& F, const bf16* qq, const bf16* kk, const bf16* vv, const bf16* S, const bf16* sgs, bf16* og) {
    LAS char* lds = (LAS char*)F.lds;
    constexpr int VST = 288, KST = 144, KOFF = 192 * VST, OST = 272, OOFF = KOFF + 128 * KST;
    constexpr int NU = NB * NH * NCH;
    const int tid = F.tid(), lane = F.lane(), w = F.wave, g = lane >> 4, li = lane & 15, q4 = li >> 2, p4 = li & 3;
    const float* gret = F.in[I_GRET];
    LAS char* const obuf = lds + OOFF + w * (16 * OST);
    u32x4 pv[4], ps[2], pk[2]; bf16x8 pq[2];
#define RO_PREFETCH(un_) do { const int bh_ = (un_) >> 6, c_ = (un_) & 63, b_ = bh_ >> 3, h_ = bh_ & 7; const size_t t0_ = (size_t)b_ * SEQ + (size_t)c_ * CH; \
        _Pragma("unroll") for (int j = 0; j < 4; ++j) { const int piece = tid + 512 * j, row = piece >> 4, ch = piece & 15; pv[j] = *(const GAS u32x4*)(vv + (t0_ + row) * D + h_ * 128 + ch * 8); } \
        _Pragma("unroll") for (int j = 0; j < 2; ++j) { const int piece = tid + 512 * j, row = piece >> 4, ch = piece & 15; \
            ps[j] = (c_ > 0) ? *(const GAS u32x4*)(S + ((size_t)((bh_ * NCH + c_) * 4 + (ch >> 2)) * 2048 + (size_t)((row >> 2) * 2 + ((ch >> 1) & 1)) * 64 + (row & 3) * 16 + (ch & 1) * 8)) : (u32x4){0u, 0u, 0u, 0u}; } \
        _Pragma("unroll") for (int j = 0; j < 2; ++j) { const int piece = tid + 512 * j, row = piece >> 3, ch = piece & 7; pk[j] = *(const GAS u32x4*)(kk + (t0_ + row) * 512 + h_ * 64 + ch * 8); } \
        _Pragma("unroll") for (int s_ = 0; s_ < 2; ++s_) pq[s_] = *(const GAS bf16x8*)(qq + (t0_ + 16 * w + li) * 512 + h_ * 64 + 32 * s_ + 8 * g); } while (0)
    int un = blockIdx.x;
    if (un < NU) RO_PREFETCH(un);
    for (; un < NU; un += F.G) {
        const int bh = un >> 6, c = un & 63, b = bh >> 3, h = bh & 7;
        const size_t tok0 = (size_t)b * SEQ + (size_t)c * CH;
        bf16x8 qf[2]; qf[0] = pq[0]; qf[1] = pq[1];
        lds_barrier();
#pragma unroll
        for (int j = 0; j < 4; ++j) { const int piece = tid + 512 * j, row = piece >> 4, ch = piece & 15; *(LAS u32x4*)(lds + row * VST + ch * 16) = pv[j]; }
#pragma unroll
        for (int j = 0; j < 2; ++j) { const int piece = tid + 512 * j, row = piece >> 4, ch = piece & 15; *(LAS u32x4*)(lds + (128 + row) * VST + ch * 16) = ps[j]; }
#pragma unroll
        for (int j = 0; j < 2; ++j) { const int piece = tid + 512 * j, row = piece >> 3, ch = piece & 7; *(LAS u32x4*)(lds + KOFF + row * KST + ch * 16) = pk[j]; }
        if (un + F.G < NU) RO_PREFETCH(un + F.G);
        u32x4 sgv[4];
#pragma unroll
        for (int j = 0; j < 4; ++j) { const int piece = lane + 64 * j, row = piece >> 4, ch = piece & 15; sgv[j] = *(const GAS u32x4*)(sgs + (tok0 + 16 * w + row) * D + h * 128 + ch * 8); }
        lds_barrier();
        f32x4 pt[8];
#pragma unroll
        for (int t = 0; t < 8; ++t) {
            pt[t] = (f32x4){0.f, 0.f, 0.f, 0.f};
            if (t <= w) {
                const bf16x8 k0 = *(const LAS bf16x8*)(lds + KOFF + (16 * t + li) * KST + (8 * g) * 2), k1 = *(const LAS bf16x8*)(lds + KOFF + (16 * t + li) * KST + (32 + 8 * g) * 2);
                pt[t] = __builtin_amdgcn_mfma_f32_16x16x32_bf16(k0, qf[0], pt[t], 0, 0, 0);
                pt[t] = __builtin_amdgcn_mfma_f32_16x16x32_bf16(k1, qf[1], pt[t], 0, 0, 0);
                if (t == w) {
#pragma unroll
                    for (int r = 0; r < 4; ++r) if (4 * g + r > li) pt[t][r] = 0.f; }
            }
        }
        f32x4 acc[8];
#pragma unroll
        for (int n = 0; n < 8; ++n) acc[n] = (f32x4){0.f, 0.f, 0.f, 0.f};
#pragma unroll
        for (int s2 = 0; s2 < 4; ++s2) {
            if (2 * s2 <= w) {
                u32x4 pw; pw.x = cvt_pk_bf16(pt[2 * s2][0], pt[2 * s2][1]); pw.y = cvt_pk_bf16(pt[2 * s2][2], pt[2 * s2][3]);
                pw.z = cvt_pk_bf16(pt[2 * s2 + 1][0], pt[2 * s2 + 1][1]); pw.w = cvt_pk_bf16(pt[2 * s2 + 1][2], pt[2 * s2 + 1][3]);
                const bf16x8 pa = __builtin_bit_cast(bf16x8, pw);
#pragma unroll
                for (int n = 0; n < 8; ++n) {
                    const s16x4 lo = tr_read(lds + (32 * s2 + 4 * g + q4) * VST + (16 * n + 4 * p4) * 2), hi = tr_read(lds + (32 * s2 + 16 + 4 * g + q4) * VST + (16 * n + 4 * p4) * 2);
                    const bf16x8 vf = __builtin_shufflevector(lo, hi, 0, 1, 2, 3, 4, 5, 6, 7);
                    acc[n] = __builtin_amdgcn_mfma_f32_16x16x32_bf16(vf, pa, acc[n], 0, 0, 0);
                }
            }
        }
        if (c > 0) {
#pragma unroll
            for (int s = 0; s < 2; ++s)
#pragma unroll
                for (int n = 0; n < 8; ++n) {
                    const s16x4 lo = tr_read(lds + (128 + 32 * s + 8 * g + q4) * VST + (16 * n + 4 * p4) * 2), hi = tr_read(lds + (128 + 32 * s + 8 * g + 4 + q4) * VST + (16 * n + 4 * p4) * 2);
                    const bf16x8 sf = __builtin_shufflevector(lo, hi, 0, 1, 2, 3, 4, 5, 6, 7);
                    acc[n] = __builtin_amdgcn_mfma_f32_16x16x32_bf16(sf, qf[s], acc[n], 0, 0, 0);
                }
        }
        float ssum = 0.f;
#pragma unroll
        for (int n = 0; n < 8; ++n) ssum += (acc[n][0] * acc[n][0] + acc[n][1] * acc[n][1]) + (acc[n][2] * acc[n][2] + acc[n][3] * acc[n][3]);
        ssum += __shfl_xor(ssum, 16); ssum += __shfl_xor(ssum, 32);
        const float rs = 1.0f / sqrtf(ssum * (1.f / DV) + EPS);
#pragma unroll
        for (int n = 0; n < 8; ++n) { const f32x4 gr = *(const GAS f32x4*)(gret + h * 128 + 16 * n + 4 * g); const f32x4 o = acc[n] * gr * rs;
            u32x2 pk2; pk2.x = cvt_pk_bf16(o[0], o[1]); pk2.y = cvt_pk_bf16(o[2], o[3]);
            *(LAS u32x2*)(obuf + li * OST + (16 * n + 4 * g) * 2) = pk2; }
        asm volatile("s_waitcnt lgkmcnt(0)" ::: "memory");
#pragma unroll
        for (int j = 0; j < 4; ++j) { const int piece = lane + 64 * j, row = piece >> 4, ch = piece & 15;
            const u32x4 ov = *(const LAS u32x4*)(obuf + row * OST + ch * 16);
            f32x4 o0, o1, s0, s1; unpack8(ov, o0, o1); unpack8(sgv[j], s0, s1);
            *(GAS u32x2*)((unsigned char*)og + (size_t)(tok0 + 16 * w + row) * D + h * 128 + ch * 8) = pack8_fp8(o0 * s0, o1 * s1); }
        asm volatile("s_waitcnt lgkmcnt(0)" ::: "memory");
    }
#undef RO_PREFETCH
    __syncthreads();
}

__device__ __forceinline__ void moe_tables(Frame& F, unsigned* gcnt) {
    LAS int* tb = (LAS int*)(F.lds + TB_OFF); LAS int* cn = (LAS int*)(F.lds + CN_OFF);
    __syncthreads();
    if (F.tid() < 32) cn[F.tid()] = (int)__hip_atomic_load(gcnt + F.tid(), RLX_AGENT);
    __syncthreads();
    if (F.tid() == 0) { int a = 0; for (int e = 0; e < 32; ++e) { tb[e] = a; a += (cn[e] + 255) >> 8; } tb[32] = a; }
    __syncthreads();
    { LAS int* te = (LAS int*)(F.lds + TE_OFF); for (int t = F.tid(); t < tb[32]; t += NTHR) { int e = 0; while (e < 31 && tb[e + 1] <= t) ++e; te[t] = e; } }
    __syncthreads();
}
__device__ __forceinline__ void combine_pass(Frame& F, bf16* xb, const bf16* Y, float* rstd3, const float* ssqp, float* rstdp, unsigned char* x8, float* sa2) {
    const int gw = F.vcu * NWAVES + F.wave, NGW = F.G * NWAVES, lane = F.lane();
    for (int m = gw; m < T; m += NGW) {
        GAS u32x4* xr = (GAS u32x4*)(xb + (size_t)m * D) + lane; const GAS u32x2* y0 = (const GAS u32x2*)((const unsigned char*)Y + (size_t)m * D) + lane; const GAS u32x2* y1 = (const GAS u32x2*)((const unsigned char*)Y + (size_t)T * D + (size_t)m * D) + lane;
        u32x4 xa[2]; u32x2 ya[2], yb[2];
#pragma unroll
        for (int j = 0; j < 2; ++j) { xa[j] = xr[64 * j]; ya[j] = y0[64 * j]; yb[j] = y1[64 * j]; }
        float s = 0.f; f32x4 v[2][2];
#pragma unroll
        for (int j = 0; j < 2; ++j) { f32x4 a0, a1, b0, b1; unpack8(xa[j], v[j][0], v[j][1]); unpack8_fp8(ya[j], a0, a1); unpack8_fp8(yb[j], b0, b1);
            v[j][0] += (a0 + b0) * (1.0f / 16.0f); v[j][1] += (a1 + b1) * (1.0f / 16.0f);
#pragma unroll
            for (int q = 0; q < 2; ++q) s += (v[j][q][0] * v[j][q][0] + v[j][q][1] * v[j][q][1]) + (v[j][q][2] * v[j][q][2] + v[j][q][3] * v[j][q][3]); }
        s = wave_sum(s);
        float mx = 0.f;
#pragma unroll
        for (int j = 0; j < 2; ++j)
#pragma unroll
            for (int q = 0; q < 2; ++q)
#pragma unroll
                for (int e = 0; e < 4; ++e) mx = fmaxf(mx, fabsf(v[j][q][e]));
#pragma unroll
        for (int o = 1; o < 64; o <<= 1) mx = fmaxf(mx, __shfl_xor(mx, o));
        mx = fmaxf(mx, 1e-30f); const float qs = 127.0f / mx;
#pragma unroll
        for (int j = 0; j < 2; ++j) { xr[64 * j] = pack8(v[j][0], v[j][1]); unsigned lo = 0u, hi = 0u;
#pragma unroll
            for (int e = 0; e < 4; ++e) { lo |= ((unsigned)(int)__builtin_rintf(v[j][0][e] * qs) & 0xffu) << (8 * e); hi |= ((unsigned)(int)__builtin_rintf(v[j][1][e] * qs) & 0xffu) << (8 * e); }
            ((GAS u32x2*)(x8 + (size_t)m * D))[lane + 64 * j] = (u32x2){lo, hi}; }
        if (lane == 0) sa2[m] = mx * (1.0f / 127.0f);
        const float sp = wave_sum(lane < 16 ? ssqp[(size_t)m * 16 + lane] : 0.f);
        if (lane == 0) { rstd3[m] = 1.0f / sqrtf(s * (1.f / D) + EPS); rstdp[m] = 1.0f / sqrtf(sp * (1.f / D) + EPS); }
    }
}
__device__ __forceinline__ void final_pass(Frame& F, const unsigned char* x3q, const float* scl3, const float* ssq3, float* out) {
    const int gw = F.vcu * NWAVES + F.wave, NGW = F.G * NWAVES, lane = F.lane(), fr = lane & 15, fq = lane >> 4;
    const float* gf = F.in[I_GFIN]; LAS float* tl = (LAS float*)(F.lds + F.wave * 16384);
    for (int rg = gw; rg < T / 16; rg += NGW) {
        const int pm = rg >> 4, ai = (rg >> 3) & 1, wr = (rg >> 2) & 1, m = rg & 3; const unsigned r = (unsigned)(pm * 256 + ai * 128 + wr * 64 + m * 16 + fr);
        const f32x4 pr = *(const GAS f32x4*)(ssq3 + r * 16u + 4u * (unsigned)fq);
        const float ssum = fq_sum((pr[0] + pr[1]) + (pr[2] + pr[3]), fr, fq), rstd = 1.0f / sqrtf(ssum * (1.f / D) + EPS);
        const unsigned rbase = (unsigned)(pm * 256 + ai * 128 + wr * 64 + m * 16);
#pragma unroll 1
        for (int half = 0; half < 2; ++half) {
        u32x4 wv[8]; float scv[8];
#pragma unroll
        for (int c8 = 0; c8 < 8; ++c8) { const int cgp = half * 8 + c8, pn = cgp >> 2, wc = cgp & 3; const unsigned blk = (unsigned)(((pm * 4 + pn) * 8 + wr * 4 + wc) * 8 + ai * 4 + m);
            wv[c8] = *(const GAS u32x4*)(x3q + (blk * 64u + (unsigned)lane) * 16u); scv[c8] = scl3[blk * 16u + (unsigned)fr]; }
#pragma unroll
        for (int c8 = 0; c8 < 8; ++c8) { const int cgp = half * 8 + c8, pn = cgp >> 2, wc = cgp & 3;
            f32x4 a0, a1, b0, b1; q64_unpack(wv[c8], scv[c8] * rstd, a0, a1, b0, b1);
            LAS f32x4* wp = (LAS f32x4*)(tl + (c8 & 1) * (16 * 68) + fr * 68 + 8 * fq); wp[0] = a0; wp[1] = a1; wp[8] = b0; wp[9] = b1;
            asm volatile("s_waitcnt lgkmcnt(0)" ::: "memory");
            const unsigned c0 = (unsigned)(pn * 256 + wc * 64 + 4 * (lane & 15)); const f32x4 g = *(const GAS f32x4*)(gf + c0);
#pragma unroll
            for (int k = 0; k < 4; ++k) { const int row = 4 * k + (lane >> 4); const f32x4 v = *(const LAS f32x4*)(tl + (c8 & 1) * (16 * 68) + row * 68 + 4 * (lane & 15));
                *(GAS f32x4*)(out + (rbase + (unsigned)row) * (unsigned)D + c0) = v * g; } }
        }
    }
}

constexpr int N_PHASES = 16;
#ifndef STAG_ON
#define STAG_ON 0
#endif
#define STAG(t) (STAG_ON ? (t) : 0)
__global__ void __launch_bounds__(NTHR, 2) hyb_fwd(Args args) {
    extern __shared__ __attribute__((aligned(16))) unsigned char lds_raw[];
    Frame F;
    F.lds = (LAS unsigned char*)lds_raw;
    F.wave = __builtin_amdgcn_readfirstlane((int)(threadIdx.x >> 6));
    F.G = gridDim.x; { const int bx = blockIdx.x; F.vcu = (F.G % 8 == 0) ? (bx % 8) * (F.G / 8) + bx / 8 : bx; }
#pragma unroll
    for (int i = 0; i < 22; ++i) F.in[i] = args.in[i];
    F.ws = args.ws; F.out = (unsigned char*)args.out;
    unsigned char* ws = args.ws;
    volatile LAS unsigned* MISC = (volatile LAS unsigned*)(F.lds + MISC_OFF);
    for (int u = F.tid(); u < (LDS_BYTES - RING_BYTES) / 4; u += NTHR) ((LAS unsigned*)(F.lds + RING_BYTES))[u] = 0u;
    __syncthreads();
    unsigned* ctl = (unsigned*)(ws + WS_CTL);
    const int lo = args.ph_lo, hi = args.ph_hi;
    const bool multi = (hi - lo) > 1;
    XcdBarrier bar; bar.bar = ctl + CW_BAR + args.li * XCD_BAR_WORDS; bar.x = 0; bar.st = nullptr;
    if (multi) bar = xcd_barrier_post(ctl + CW_BAR + args.li * XCD_BAR_WORDS, MISC + 8, F.wave);
#define IN(k) (lo <= (k) && (k) < hi)
#define SEAM(k) do { if (IN(k) && IN((k) + 1)) xcd_barrier(bar, F.wave); } while (0)

    bf16* const bufA = (bf16*)(ws + WS_A);
    bf16* const cu = (bf16*)F.out; bf16* const ypre = (bf16*)F.out + (size_t)T * D;
    bf16* const og = (bf16*)F.out;
    bf16* const Yb = (bf16*)F.out;
    unsigned char* const x8 = (unsigned char*)(ws + WS_Q);
    bf16* const qb = (bf16*)(ws + WS_Q); bf16* const kb = (bf16*)(ws + WS_K); bf16* const vb = (bf16*)(ws + WS_V); bf16* const sgb = (bf16*)(ws + WS_SG);
    bf16* const mcb = (bf16*)(ws + WS_MC); bf16* const mixc = (bf16*)(ws + WS_MC + 64 * MiB);
    bf16* const mrb = (bf16*)(ws + WS_MR + 64 * MiB); bf16* const Sb = (bf16*)(ws + WS_S);
    bf16* const mixed = (bf16*)(ws + WS_V); bf16* const ppb = (bf16*)(ws + WS_SG);
    bf16* const x3b = (bf16*)(ws + WS_V); float* const rstd3 = (float*)(ws + WS_SSQ1); float* const rstdp = (float*)(ws + WS_SSQ1 + (size_t)T * 4); bf16* const hid = (bf16*)(ws + WS_MC);
    float* const ssq1 = (float*)(ws + WS_SSQ1); float* const ssqp = (float*)(ws + WS_SSQP); float* const ssq3 = (float*)(ws + WS_SSQ3);
    u32x4* const route = (u32x4*)(ws + WS_ROUTE); u32x4* const lists = (u32x4*)(ws + WS_LIST); float* const rstd2 = (float*)(ws + WS_RSTD2);
    unsigned* const gcnt = ctl + CW_CNT;
    const LAS int* tb = (const LAS int*)(F.lds + TB_OFF); const LAS int* cn = (const LAS int*)(F.lds + CN_OFF); const LAS int* te = (const LAS int*)(F.lds + TE_OFF);

    if (IN(0)) { p0_prologue(F); if (multi) xcd_barrier(bar, F.wave); p0_quant_win(F); } SEAM(0);
    if (IN(1)) { pg8::StaticOrder S; S.init(ws + WS_S, ws + W_IN, T, 2048, D / 2, F.G, (int)blockIdx.x);
        EpiG1 E{(const float*)(ws + WS_SSQ3), (const float*)(ws + WS_SB), cu, ypre, qb, kb, vb, sgb, mcb, mrb, (const f32x2*)(ws + WS_ROPE), (const LAS float*)(F.lds + CWL_OFF), 0};
        pg8::gemm_phase(F.lds, F.wave, D / 2, S, E, args.noepi, (F.vcu & 1) ? STAG(1700) : 0); } SEAM(1);
    if (IN(2)) { { LAS float* cwl = (LAS float*)(F.lds + CWL_OFF); for (int i = F.tid(); i < 3 * D; i += NTHR) cwl[i] = F.in[I_CONVW][i]; __syncthreads(); }
        pg8::StaticOrder S; S.init(ws + WS_S, ws + W_IN + (size_t)2048 * D, T, NIN - 2048, D / 2, F.G, (int)blockIdx.x);
        EpiG1 E{(const float*)(ws + WS_SSQ3), (const float*)(ws + WS_SB), cu, ypre, qb, kb, vb, sgb, mcb, mrb, (const f32x2*)(ws + WS_ROPE), (const LAS float*)(F.lds + CWL_OFF), 8};
        pg8::gemm_phase(F.lds, F.wave, D / 2, S, E, args.noepi); } SEAM(2);
    if (IN(3)) { state_scan(F, kb, vb, Sb); } SEAM(3);
    if (IN(4)) { ret_out(F, qb, kb, vb, Sb, sgb, og); }
    if (IN(5)) { pg8::StaticOrder S; S.init(ypre, ws + W_OC, T, D, D, F.G, (int)blockIdx.x);
        EpiGate<0> E{mcb, nullptr, mixc, args.noepi, vb, (float*)(ws + WS_MR), (unsigned*)(ws + WS_RMAX)};
        pg8::gemm_phase(F.lds, F.wave, D, S, E, args.noepi, (F.vcu & 1) ? STAG(2000) : 0); } SEAM(5);
    if (IN(6)) { pg8::StaticOrder S; S.init(og, ws + W_OR, T, D, D / 2, F.G, (int)blockIdx.x);
        EpiGate<1, true> E{mrb, mixc, mixed, args.noepi, vb, (float*)(ws + WS_MR), (unsigned*)(ws + WS_RMAX)};
        pg8::gemm_phase(F.lds, F.wave, D / 2, S, E, args.noepi, (F.vcu & 1) ? STAG(2000) : 0); } SEAM(6);
    if (IN(7)) { pg8::StaticOrder S; S.init(mixed, ws + W_O, T, D, D / 2, F.G, (int)blockIdx.x);
        EpiRes E{(const float*)(ws + WS_RSTD2), bufA, ssq1, x8, (const unsigned*)(ws + WS_RMAX), (const float*)(ws + WS_SB) + NIN + D};
        pg8::gemm_phase(F.lds, F.wave, D / 2, S, E, args.noepi, (F.vcu & 1) ? STAG(2500) : 0); }
    SEAM(7);
    if (IN(8)) { pg8::StaticOrder S; S.init(bufA, ws + W_R, T, 256, D, F.G, (int)blockIdx.x);
        EpiRoute E{ssq1, F.in[I_BRG], F.in[I_BRE], rstd2, lists, gcnt, (LAS int*)(F.lds + HS_OFF)};
        pg8::gemm_phase(F.lds, F.wave, D, S, E, args.noepi); }
    if (IN(13)) { pg8::StaticOrder S; S.init(ws + WS_PB, ws + W_PP, T, D, PLE, F.G, (int)blockIdx.x);
        EpiPP E{ppb, ssqp, F.in[I_GPOST], (float*)(ws + WS_SG + 64 * MiB)};
        pg8::gemm_phase(F.lds, F.wave, PLE, S, E); }
    SEAM(9);
    if (IN(10)) { moe_tables(F, gcnt);
        MoeSched<true> S{tb, cn, te, lists, (const char*)x8, (const char*)(ws + W_GU), (size_t)1024 * 1024, D / 2, F.G, F.vcu};
        EpiHid E{tb, cn, lists, hid};
        pg8::gemm_phase(F.lds, F.wave, D / 2, S, E, args.noepi, (F.vcu & 1) ? STAG(2000) : 0); } SEAM(10);
    if (IN(11)) { moe_tables(F, gcnt);
        MoeSched<false> S{tb, cn, te, lists, (const char*)hid, (const char*)(ws + W_DN), (size_t)1024 * 512, DE / 2, F.G, F.vcu};
        EpiDown E{tb, cn, lists, Yb};
        pg8::gemm_phase(F.lds, F.wave, DE / 2, S, E); } SEAM(11);
    if (IN(12)) { combine_pass(F, bufA, Yb, rstd3, ssqp, rstdp, x8, rstd3 + 2 * T); } SEAM(12);
    if (IN(14)) { pg8::StaticOrder S; S.init(x8, ws + W_PG, T, D, D / 2, F.G, (int)blockIdx.x);
        EpiPle E{bufA, rstd3, ppb, rstdp, x3b, ssq3, rstd3 + 2 * T, (const float*)(ws + WS_SB) + NIN, (const float*)(ws + WS_SG + 64 * MiB), (float*)(ws + WS_V + 64 * MiB)};
        pg8::gemm_phase(F.lds, F.wave, D / 2, S, E, args.noepi, (F.vcu & 1) ? STAG(2500) : 0); } SEAM(14);
    if (IN(15)) { final_pass(F, (const unsigned char*)x3b, (const float*)(ws + WS_V + 64 * MiB), ssq3, (float*)F.out); }
#undef IN
#undef SEAM
}

extern "C" void kernel_launch(void* const* d_in, const int* in_sizes, int n_in, void* d_out, int out_size, void* d_ws, size_t ws_size, hipStream_t stream) {
    static int grid = 0;
    if (grid == 0) {
        if (n_in != 22 || in_sizes[0] != T * D || out_size != T * D || ws_size < WS_END) { fprintf(stderr, "kernel_launch: unexpected shapes / workspace (ws %zu, need %zu)\n", ws_size, (size_t)WS_END); grid = -1; return; }
        int dev = 0, cus = 0, per_cu = 0;
        if (hipGetDevice(&dev) != hipSuccess || hipDeviceGetAttribute(&cus, hipDeviceAttributeMultiprocessorCount, dev) != hipSuccess) { grid = -1; return; }
        if (hipFuncSetAttribute((const void*)hyb_fwd, hipFuncAttributeMaxDynamicSharedMemorySize, LDS_BYTES) != hipSuccess) { fprintf(stderr, "kernel_launch: hipFuncSetAttribute failed\n"); grid = -1; return; }
        if (hipOccupancyMaxActiveBlocksPerMultiprocessor(&per_cu, (const void*)hyb_fwd, NTHR, LDS_BYTES) != hipSuccess || per_cu < 1) { fprintf(stderr, "kernel_launch: occupancy query says %d\n", per_cu); }
        (void)hipGetLastError();
        grid = cus;
    }
    if (grid < 0) return;
    if (hipMemsetAsync((char*)d_ws + WS_CTL, 0, CTL_ZERO_BYTES, stream) != hipSuccess) return;
    Args a{};
    for (int i = 0; i < 22; ++i) a.in[i] = (const float*)d_in[i];
    a.out = (float*)d_out; a.ws = (unsigned char*)d_ws;
#if defined(PROBE_DUP)
    a.ph_lo = 0; a.ph_hi = PROBE_DUP + 1; hipLaunchKernelGGL(hyb_fwd, dim3(grid), dim3(NTHR), LDS_BYTES, stream, a);
    for (int rep = 0; rep < PROBE_REPS; ++rep) { a.li = 1; a.noepi = PROBE_NOEPI; a.ph_lo = PROBE_DUP; a.ph_hi = PROBE_DUP + 1; hipLaunchKernelGGL(hyb_fwd, dim3(grid), dim3(NTHR), LDS_BYTES, stream, a);
#if defined(PROBE_INTER)
        a.noepi = 0; a.ph_lo = PROBE_INTER; a.ph_hi = PROBE_INTER + 1; hipLaunchKernelGGL(hyb_fwd, dim3(grid), dim3(NTHR), LDS_BYTES, stream, a);
#endif
    }
    a.li = 2; a.noepi = 0; a.ph_lo = PROBE_DUP + 1; a.ph_hi = N_PHASES; hipLaunchKernelGGL(hyb_fwd, dim3(grid), dim3(NTHR), LDS_BYTES, stream, a);
#else
    a.ph_lo = 0; a.ph_hi = N_PHASES;
    hipLaunchKernelGGL(hyb_fwd, dim3(grid), dim3(NTHR), LDS_BYTES, stream, a);
#endif
}
```
